# Optimizing an MI355X kernel written in HIP

```python
import math
import jax, jax.numpy as jnp
from jax import lax
import numpy as np

D_MODEL = 1024
BATCH = 4
SEQ = 8192
DEPTH = 1

GDN_HEADS = 4
GDN_HEAD_DIM = 128
GDN_WIDTH = GDN_HEADS * GDN_HEAD_DIM
CONV_WIDTH = 4
GDN_CHUNK = 64
DSA_HEADS = 4
DSA_HEAD_DIM = 128
DSA_WIDTH = DSA_HEADS * DSA_HEAD_DIM
Q_RANK = 256
KV_RANK = 256
IDX_HEADS = 16
IDX_DIM = 64
IDX_TOPK_MAX = 256
Q_BLOCK = 128
REL_BUCKETS = 32
REL_MAX_DIST = 1024
PEER_HEADS = 8
PEER_KEYS = 128
PEER_EXPERTS = PEER_KEYS * PEER_KEYS
PEER_KEY_DIM = 256
PEER_TOPK = 16
PEER_BLOCK = 128

MIX_WIDTH = GDN_WIDTH + DSA_WIDTH
IN_SPLIT_SIZES = (GDN_WIDTH, GDN_WIDTH, GDN_WIDTH, GDN_WIDTH, GDN_HEADS, GDN_HEADS,
                  Q_RANK, KV_RANK, IDX_DIM, IDX_HEADS)
IN_WIDTH = sum(IN_SPLIT_SIZES)
EPS = 1e-6
F32 = jnp.float32

kernel_name = "hybrid_gdn_dsa_peer_block"


def rms_norm(x, g):
    xf = x.astype(F32)
    y = xf * lax.rsqrt(jnp.mean(xf * xf, axis=-1, keepdims=True) + EPS)
    return (y * g.astype(F32)).astype(x.dtype)


def layer_norm(x, g, b):
    xf = x.astype(F32)
    mu = jnp.mean(xf, axis=-1, keepdims=True)
    xc = xf - mu
    y = xc * lax.rsqrt(jnp.mean(xc * xc, axis=-1, keepdims=True) + EPS)
    return (y * g.astype(F32) + b.astype(F32)).astype(x.dtype)


def l2_normalize(x):
    xf = x.astype(F32)
    return xf * lax.rsqrt(jnp.sum(xf * xf, axis=-1, keepdims=True) + EPS)


def causal_depthwise_conv(x, w):
    c = x.shape[-1]
    return lax.conv_general_dilated(
        x, w[:, None, :].astype(x.dtype), window_strides=(1,),
        padding=((CONV_WIDTH - 1, 0),), dimension_numbers=('NWC', 'WIO', 'NWC'),
        feature_group_count=c)


def gated_delta_rule(q, k, v, g, beta):
    bsz, t_len, h, dk = q.shape
    dv = v.shape[-1]
    c = GDN_CHUNK
    n = t_len // c
    q = q.astype(F32) * (dk ** -0.5)

    def chunk4(a):
        return a.astype(F32).reshape(bsz, n, c, h, a.shape[-1]).transpose(0, 3, 1, 2, 4)

    def chunk3(a):
        return a.astype(F32).reshape(bsz, n, c, h).transpose(0, 3, 1, 2)

    q, k, v = chunk4(q), chunk4(k), chunk4(v)
    g = jnp.cumsum(chunk3(g), axis=-1)
    beta = chunk3(beta)
    tril = jnp.tril(jnp.ones((c, c), dtype=bool))
    strict = jnp.tril(jnp.ones((c, c), dtype=bool), -1)
    decay = jnp.exp(jnp.where(tril, g[..., :, None] - g[..., None, :], -jnp.inf))
    k_beta = k * beta[..., None]
    v_beta = v * beta[..., None]
    a_mat = jnp.where(strict, jnp.einsum('bhncd,bhnsd->bhncs', k_beta, k) * decay, 0.0)
    eye = jnp.eye(c, dtype=F32)
    t_inv = lax.linalg.triangular_solve(a_mat + eye, jnp.broadcast_to(eye, a_mat.shape),
                                        left_side=True, lower=True, unit_diagonal=True)
    u = jnp.einsum('bhncs,bhnse->bhnce', t_inv, v_beta)
    w = jnp.einsum('bhncs,bhnsd->bhncd', t_inv, k_beta * jnp.exp(g)[..., None])
    attn = jnp.einsum('bhncd,bhnsd->bhncs', q, k) * decay

    def step(state, xs):
        q_c, k_c, u_c, w_c, g_c, a_c = xs
        v_new = u_c - jnp.einsum('bhcd,bhde->bhce', w_c, state)
        o_c = (jnp.einsum('bhcd,bhde->bhce', q_c * jnp.exp(g_c)[..., None], state)
               + jnp.einsum('bhcs,bhse->bhce', a_c, v_new))
        g_last = g_c[..., -1:]
        state = (state * jnp.exp(g_last)[..., None]
                 + jnp.einsum('bhcd,bhce->bhde', k_c * jnp.exp(g_last - g_c)[..., None], v_new))
        return state, o_c

    xs = (q.transpose(2, 0, 1, 3, 4), k.transpose(2, 0, 1, 3, 4), u.transpose(2, 0, 1, 3, 4),
          w.transpose(2, 0, 1, 3, 4), g.transpose(2, 0, 1, 3), attn.transpose(2, 0, 1, 3, 4))
    s0 = jnp.zeros((bsz, h, dk, dv), F32)
    _, o = lax.scan(step, s0, xs)
    return o.transpose(1, 0, 3, 2, 4).reshape(bsz, t_len, h, dv)


def gdn_mixer(q, k, v, z, a, b, conv_w, a_log, dt_bias, norm_g):
    bsz, t_len, _ = q.shape
    qkv = jax.nn.silu(causal_depthwise_conv(jnp.concatenate([q, k, v], axis=-1), conv_w))
    q, k, v = jnp.split(qkv, [GDN_WIDTH, 2 * GDN_WIDTH], axis=-1)
    q = l2_normalize(q.reshape(bsz, t_len, GDN_HEADS, GDN_HEAD_DIM))
    k = l2_normalize(k.reshape(bsz, t_len, GDN_HEADS, GDN_HEAD_DIM))
    v = v.reshape(bsz, t_len, GDN_HEADS, GDN_HEAD_DIM)
    g = -jnp.exp(a_log.astype(F32)) * jax.nn.softplus(a.astype(F32) + dt_bias.astype(F32))
    beta = jax.nn.sigmoid(b.astype(F32))
    o = gated_delta_rule(q, k, v, g, beta)
    o = rms_norm(o, norm_g) * jax.nn.silu(z.reshape(bsz, t_len, GDN_HEADS, GDN_HEAD_DIM).astype(F32))
    return o.reshape(bsz, t_len, GDN_WIDTH).astype(z.dtype)


def rel_bucket(dist):
    max_exact = REL_BUCKETS // 2
    n = jnp.maximum(dist, 0)
    nf = jnp.maximum(n, 1).astype(F32)
    large = max_exact + (jnp.log(nf / max_exact) / math.log(REL_MAX_DIST / max_exact)
                         * (REL_BUCKETS - max_exact)).astype(jnp.int32)
    large = jnp.minimum(large, REL_BUCKETS - 1)
    return jnp.where(n < max_exact, n, large)


def dsa_mixer(c_q, c_kv, k_idx, w_idx, q_norm_g, kv_norm_g, w_q_up, w_qidx_up, w_kv_up,
              idx_ln_g, idx_ln_b, rel_bias):
    bsz, t_len, _ = c_q.shape
    cq = rms_norm(c_q, q_norm_g)
    q = (cq @ w_q_up).reshape(bsz, t_len, DSA_HEADS, DSA_HEAD_DIM)
    q_idx = (cq @ w_qidx_up).reshape(bsz, t_len, IDX_HEADS, IDX_DIM)
    ckv = rms_norm(c_kv, kv_norm_g)
    kv = (ckv @ w_kv_up).reshape(bsz, t_len, DSA_HEADS, 2 * DSA_HEAD_DIM)
    k, v = kv[..., :DSA_HEAD_DIM], kv[..., DSA_HEAD_DIM:]
    k_idx = layer_norm(k_idx, idx_ln_g, idx_ln_b).astype(F32)
    w_idx = w_idx.astype(F32) * (IDX_HEADS ** -0.5 * IDX_DIM ** -0.5)
    topk = min(IDX_TOPK_MAX, t_len // 4)
    nb = t_len // Q_BLOCK
    scale = DSA_HEAD_DIM ** -0.5
    key_pos = jnp.arange(t_len)

    def blk(a):
        return a.reshape(bsz, nb, Q_BLOCK, *a.shape[2:]).swapaxes(0, 1)

    def attend_block(args):
        i, q_b, qi_b, wi_b = args
        t_pos = i * Q_BLOCK + jnp.arange(Q_BLOCK)
        causal = key_pos[None, :] <= t_pos[:, None]
        idx_logits = jnp.einsum('bthd,bsd->bths', qi_b.astype(F32), k_idx)
        score = jnp.einsum('bths,bth->bts', jax.nn.relu(idx_logits), wi_b)
        score = jnp.where(causal[None], score, -jnp.inf)
        _, sel = lax.top_k(score, topk)
        k_sel = jax.vmap(lambda kk, ii: kk[ii])(k, sel)
        v_sel = jax.vmap(lambda vv, ii: vv[ii])(v, sel)
        logits = jnp.einsum('bthd,btkhd->bhtk', q_b.astype(F32), k_sel.astype(F32)) * scale
        dist = t_pos[None, :, None] - sel
        bias = rel_bias[rel_bucket(dist)].astype(F32)
        logits = logits + bias.transpose(0, 3, 1, 2)
        logits = jnp.where((dist >= 0)[:, None], logits, -jnp.inf)
        p = jax.nn.softmax(logits, axis=-1)
        out = jnp.einsum('bhtk,btkhd->bthd', p, v_sel.astype(F32))
        return out.astype(q_b.dtype)

    outs = lax.map(attend_block, (jnp.arange(nb), blk(q), blk(q_idx), blk(w_idx)))
    return outs.swapaxes(0, 1).reshape(bsz, t_len, DSA_WIDTH)


def peer_ffn(h, w_query, sub_keys_1, sub_keys_2, expert_u, expert_v):
    bsz, t_len, d = h.shape
    nb = t_len // PEER_BLOCK
    n_tok = bsz * PEER_BLOCK
    half = PEER_KEY_DIM // 2
    hb = h.reshape(bsz, nb, PEER_BLOCK, d).swapaxes(0, 1).reshape(nb, n_tok, d)

    def block(xb):
        qy = (xb @ w_query).reshape(n_tok, PEER_HEADS, 2, half)
        s1 = jnp.einsum('nhd,hkd->nhk', qy[:, :, 0], sub_keys_1).astype(F32)
        s2 = jnp.einsum('nhd,hkd->nhk', qy[:, :, 1], sub_keys_2).astype(F32)
        v1, i1 = lax.top_k(s1, PEER_TOPK)
        v2, i2 = lax.top_k(s2, PEER_TOPK)
        cand = (v1[..., :, None] + v2[..., None, :]).reshape(n_tok, PEER_HEADS, PEER_TOPK * PEER_TOPK)
        cidx = (i1[..., :, None] * PEER_KEYS + i2[..., None, :]).reshape(n_tok, PEER_HEADS, PEER_TOPK * PEER_TOPK)
        top_s, pos = lax.top_k(cand, PEER_TOPK)
        eidx = jnp.take_along_axis(cidx, pos, axis=-1)
        gates = jax.nn.softmax(top_s, axis=-1)
        u = expert_u[eidx]
        vv = expert_v[eidx]
        act = jax.nn.gelu(jnp.einsum('nhkd,nd->nhk', u, xb).astype(F32), approximate=False)
        return jnp.einsum('nhk,nhkd->nd', (gates * act).astype(vv.dtype), vv)

    y = lax.map(block, hb)
    return y.reshape(nb, bsz, PEER_BLOCK, d).swapaxes(0, 1).reshape(bsz, t_len, d)


def setup_inputs(seed: int = 0) -> dict:
    key = jax.random.key(seed)
    ks = jax.random.split(key, 24)
    nrm = lambda k, shape, s: jax.random.normal(k, shape, F32) * s
    gain = lambda k, shape: 1.0 + 0.02 * jax.random.normal(k, shape, F32)
    dt = jnp.exp(jax.random.uniform(ks[4], (DEPTH, GDN_HEADS), F32, math.log(1e-3), math.log(1e-1)))
    return {
        "x": nrm(ks[0], (BATCH, SEQ, D_MODEL), 1.0),
        "ln1_g": gain(ks[1], (DEPTH, D_MODEL)),
        "w_in": nrm(ks[2], (DEPTH, D_MODEL, IN_WIDTH), D_MODEL ** -0.5),
        "conv_w": nrm(ks[3], (DEPTH, CONV_WIDTH, 3 * GDN_WIDTH), CONV_WIDTH ** -0.5),
        "a_log": jnp.log(jax.random.uniform(ks[5], (DEPTH, GDN_HEADS), F32, 1.0, 16.0)),
        "dt_bias": dt + jnp.log(-jnp.expm1(-dt)),
        "gdn_norm_g": gain(ks[6], (DEPTH, GDN_HEAD_DIM)),
        "q_norm_g": gain(ks[7], (DEPTH, Q_RANK)),
        "kv_norm_g": gain(ks[8], (DEPTH, KV_RANK)),
        "w_q_up": nrm(ks[9], (DEPTH, Q_RANK, DSA_WIDTH), Q_RANK ** -0.5),
        "w_qidx_up": nrm(ks[10], (DEPTH, Q_RANK, IDX_HEADS * IDX_DIM), Q_RANK ** -0.5),
        "w_kv_up": nrm(ks[11], (DEPTH, KV_RANK, 2 * DSA_WIDTH), KV_RANK ** -0.5),
        "idx_ln_g": gain(ks[12], (DEPTH, IDX_DIM)),
        "idx_ln_b": nrm(ks[13], (DEPTH, IDX_DIM), 0.02),
        "w_out": nrm(ks[14], (DEPTH, MIX_WIDTH, D_MODEL), MIX_WIDTH ** -0.5),
        "ln2_g": gain(ks[15], (DEPTH, D_MODEL)),
        "peer_w_query": nrm(ks[16], (DEPTH, D_MODEL, PEER_HEADS * PEER_KEY_DIM), D_MODEL ** -0.5),
        "peer_sub_keys_1": nrm(ks[17], (DEPTH, PEER_HEADS, PEER_KEYS, PEER_KEY_DIM // 2), (PEER_KEY_DIM // 2) ** -0.5),
        "peer_sub_keys_2": nrm(ks[18], (DEPTH, PEER_HEADS, PEER_KEYS, PEER_KEY_DIM // 2), (PEER_KEY_DIM // 2) ** -0.5),
        "peer_u": nrm(ks[19], (DEPTH, PEER_EXPERTS, D_MODEL), D_MODEL ** -0.5),
        "peer_v": nrm(ks[20], (DEPTH, PEER_EXPERTS, D_MODEL), PEER_HEADS ** -0.5),
        "rel_bias": nrm(ks[21], (REL_BUCKETS, DSA_HEADS), 0.5),
        "final_g": gain(ks[22], (D_MODEL,)),
    }


def reference(x, ln1_g, w_in, conv_w, a_log, dt_bias, gdn_norm_g, q_norm_g, kv_norm_g,
              w_q_up, w_qidx_up, w_kv_up, idx_ln_g, idx_ln_b, w_out, ln2_g, peer_w_query,
              peer_sub_keys_1, peer_sub_keys_2, peer_u, peer_v, rel_bias, final_g):
    offsets = [int(o) for o in np.cumsum(IN_SPLIT_SIZES)[:-1]]
    for l in range(DEPTH):
        h = rms_norm(x, ln1_g[l])
        proj = h @ w_in[l]
        gq, gk, gv, gz, ga, gb, cq, ckv, kidx, widx = jnp.split(proj, offsets, axis=-1)
        o_a = gdn_mixer(gq, gk, gv, gz, ga, gb, conv_w[l], a_log[l], dt_bias[l], gdn_norm_g[l])
        o_b = dsa_mixer(cq, ckv, kidx, widx, q_norm_g[l], kv_norm_g[l], w_q_up[l], w_qidx_up[l],
                        w_kv_up[l], idx_ln_g[l], idx_ln_b[l], rel_bias)
        x = x + jnp.concatenate([o_a, o_b], axis=-1) @ w_out[l]
        x = x + peer_ffn(rms_norm(x, ln2_g[l]), peer_w_query[l], peer_sub_keys_1[l],
                         peer_sub_keys_2[l], peer_u[l], peer_v[l])
    return rms_norm(x, final_g)
```

```cpp
#include <hip/hip_runtime.h>
#include <cstdio>
#include <cstdint>

#define LAS __attribute__((address_space(3)))
typedef unsigned short bf16_t;
typedef short bf16x8 __attribute__((ext_vector_type(8)));
typedef float f32x4 __attribute__((ext_vector_type(4)));
typedef float f32x2 __attribute__((ext_vector_type(2)));
typedef unsigned u32x4 __attribute__((ext_vector_type(4)));
typedef unsigned u32x2 __attribute__((ext_vector_type(2)));
typedef __bf16 bf16x2_t __attribute__((ext_vector_type(2)));

constexpr int BATCH = 4, SEQ = 8192, DM = 1024, MT = BATCH * SEQ;
constexpr int IN_W = 2648, NIN = 2816;
constexpr int NCHUNK = SEQ / 64;
constexpr float EPS = 1e-6f;
constexpr int NWAVES = 8, NTHR = 512;

constexpr size_t MiB = 1u << 20;
constexpr size_t WS_CTL = 0, CTL_BYTES = 1 * MiB;
constexpr size_t WS_WINT = 1 * MiB;
constexpr size_t WS_WQ2T = 7 * MiB;
constexpr size_t WS_WOUT2T = 8 * MiB;
constexpr size_t WS_WQST = 11 * MiB;
constexpr size_t WS_GAMMA = 15 * MiB;
constexpr size_t WS_UB = 16 * MiB;
constexpr size_t WS_VB = 48 * MiB;
constexpr size_t WS_SCR = 16 * MiB;
constexpr size_t WS_HB = 80 * MiB;
constexpr size_t WS_KIDXN = 80 * MiB;
constexpr size_t WS_WIDX = 84 * MiB;
constexpr size_t WS_GARR = 86 * MiB;
constexpr size_t WS_BARR = 87 * MiB;
constexpr size_t WS_ATTN = 88 * MiB;
constexpr size_t WS_X1B = 80 * MiB;
constexpr size_t WS_AOUT = 144 * MiB;
constexpr size_t WS_QKV = 240 * MiB;
constexpr size_t WS_QIDX = 240 * MiB;
constexpr size_t WS_WBUF = 304 * MiB;
constexpr size_t WS_ZB = 336 * MiB;
constexpr size_t WS_CQ = 368 * MiB;
constexpr size_t WS_CKV = 384 * MiB;
constexpr size_t WS_MISC = 400 * MiB;
constexpr size_t WS_QH = 416 * MiB;
constexpr size_t WS_KH = 448 * MiB;
constexpr size_t WS_VH = 480 * MiB;
constexpr size_t WS_S = 144 * MiB;
constexpr size_t WS_END = 512 * MiB;
constexpr int CW_QUEUE = 64;
constexpr int CW_BAR = 4096;
constexpr size_t CTL_RSS = 256 * 1024;

constexpr int LDS_BYTES = 160 * 1024;
constexpr int LDS_MISC = LDS_BYTES - 256;

__device__ __forceinline__ unsigned cvt_pk_bf16(float lo, float hi) { const f32x2 v = {lo, hi}; return __builtin_bit_cast(unsigned, __builtin_convertvector(v, bf16x2_t)); }
__device__ __forceinline__ float bf_lo(unsigned w) { return __uint_as_float(w << 16); }
__device__ __forceinline__ float bf_hi(unsigned w) { return __uint_as_float(w & 0xffff0000u); }
__device__ __forceinline__ float bf2f(bf16_t b) { return __uint_as_float(((unsigned)b) << 16); }
__device__ __forceinline__ bf16_t f2bf(float f) { return (bf16_t)(cvt_pk_bf16(f, 0.f) & 0xffffu); }
__device__ __forceinline__ float wave_sum(float v) {
#pragma unroll
    for (int o = 1; o < 64; o <<= 1) v += __shfl_xor(v, o);
    return v;
}
__device__ __forceinline__ float silu_f(float x) { return x / (1.f + __expf(-x)); }
#define LDS_WAIT() asm volatile("s_waitcnt lgkmcnt(0)" ::: "memory")
#define VM_WAIT() asm volatile("s_waitcnt vmcnt(0)" ::: "memory")
__device__ __forceinline__ bf16x8 mk8(u32x2 lo, u32x2 hi) { u32x4 t; t.x = lo.x; t.y = lo.y; t.z = hi.x; t.w = hi.y; return __builtin_bit_cast(bf16x8, t); }
__device__ __forceinline__ bf16x8 pk8(f32x4 a, f32x4 b) { u32x4 t; t.x = cvt_pk_bf16(a[0], a[1]); t.y = cvt_pk_bf16(a[2], a[3]); t.z = cvt_pk_bf16(b[0], b[1]); t.w = cvt_pk_bf16(b[2], b[3]); return __builtin_bit_cast(bf16x8, t); }
#define MFMA16(a, b, c) __builtin_amdgcn_mfma_f32_16x16x32_bf16((a), (b), (c), 0, 0, 0)

#define XB_TMO      128
#define XB_XCNT(j)  (256  + 64 * (j))
#define XB_XSUB(j)  (1280 + 64 * (j))
#define XB_XGEN(j)  (2304 + 64 * (j))
#define XB_TOP      3328
#define XB_TOPGEN   3392
#define XCD_BAR_WORDS 3456
#define XB_SPIN_CAP (1u << 23)
__device__ __forceinline__ unsigned xb_ld(unsigned* p)              { return __hip_atomic_load(p, __ATOMIC_RELAXED, __HIP_MEMORY_SCOPE_AGENT); }
__device__ __forceinline__ unsigned xb_add(unsigned* p, unsigned v) { return __hip_atomic_fetch_add(p, v, __ATOMIC_RELAXED, __HIP_MEMORY_SCOPE_AGENT); }
__device__ __forceinline__ unsigned xb_xcc_id() { return (unsigned)__builtin_amdgcn_s_getreg((3 << 11) | 20) & 0xFu; }
#define XB_SPIN(cond, bar) do { unsigned _sp = 0; while (cond) { __builtin_amdgcn_s_sleep(1); \
    if ((++_sp & 255u) == 0u) { if (xb_ld(&(bar)[XB_TMO])) break; if (_sp > XB_SPIN_CAP) { atomicAdd(&(bar)[XB_TMO], 1u); break; } } } } while (0)
struct XcdBarrier { unsigned* bar; unsigned x; volatile LAS unsigned* st; };
__device__ __forceinline__ XcdBarrier xcd_barrier_post(unsigned* bar, volatile LAS unsigned* st) {
    XcdBarrier b; b.bar = bar; b.x = xb_xcc_id(); b.st = st;
    if (threadIdx.x == 0) (void)xb_add(&bar[XB_XCNT(b.x)], 1u);
    return b;
}
__device__ __forceinline__ void xcd_barrier_complete(unsigned* bar, unsigned x, unsigned& nloc, unsigned& nx) {
    const unsigned G = gridDim.x * gridDim.y * gridDim.z;
    unsigned sum, cnt, mine, sp = 0u;
    for (;;) {
        sum = 0u; cnt = 0u; mine = 0u;
#pragma unroll
        for (unsigned j = 0; j < 16; ++j) { const unsigned c = xb_ld(&bar[XB_XCNT(j)]); sum += c; cnt += (c > 0u) ? 1u : 0u; mine = (j == x) ? c : mine; }
        if (sum == G) break;
        __builtin_amdgcn_s_sleep(1);
        if ((++sp & 255u) == 0u) { if (xb_ld(&bar[XB_TMO])) break; if (sp > XB_SPIN_CAP) { atomicAdd(&bar[XB_TMO], 1u); break; } }
    }
    nloc = mine > 0u ? mine : 1u; nx = cnt > 0u ? cnt : 1u;
}
__device__ __forceinline__ void xcd_barrier(const XcdBarrier& b) {
    asm volatile("s_waitcnt vmcnt(0)" ::: "memory");
    __syncthreads();
    if (threadIdx.x == 0) {
        unsigned* bar = b.bar;
        __builtin_amdgcn_s_waitcnt(0);
        unsigned nloc = b.st[0], nx = b.st[1];
        if (nloc == 0u) { xcd_barrier_complete(bar, b.x, nloc, nx); b.st[0] = nloc; b.st[1] = nx; }
        const unsigned old = xb_add(&bar[XB_XSUB(b.x)], 1u);
        const unsigned gen = old / nloc;
        if (old + 1u == (gen + 1u) * nloc) {
            __builtin_amdgcn_fence(__ATOMIC_RELEASE, "agent");
            asm volatile("s_waitcnt vmcnt(0)" ::: "memory");
            const unsigned og = xb_add(&bar[XB_TOP], 1u);
            const unsigned tg = og / nx;
            if (og + 1u == (tg + 1u) * nx) xb_add(&bar[XB_TOPGEN], 1u);
            else XB_SPIN(xb_ld(&bar[XB_TOPGEN]) == tg, bar);
            __builtin_amdgcn_fence(__ATOMIC_ACQUIRE, "agent");
            xb_add(&bar[XB_XGEN(b.x)], 1u);
            asm volatile("s_waitcnt vmcnt(0)" ::: "memory");
        } else {
            XB_SPIN(xb_ld(&bar[XB_XGEN(b.x)]) == gen, bar);
            __builtin_amdgcn_fence(__ATOMIC_ACQUIRE, "agent");
            asm volatile("s_waitcnt vmcnt(0)" ::: "memory");
        }
    }
    __syncthreads();
}

struct Params {
    const float *x, *ln1_g, *w_in, *conv_w, *a_log, *dt_bias, *gdn_norm_g, *q_norm_g, *kv_norm_g, *w_q_up, *w_qidx_up, *w_kv_up,
                *idx_ln_g, *idx_ln_b, *w_out, *ln2_g, *peer_wq, *peer_k1, *peer_k2, *peer_u, *peer_v, *rel_bias, *final_g;
    float* out; unsigned char* ws;
};

namespace pg8 {
#define PG8_LAS __attribute__((address_space(3)))
typedef unsigned short bf16_t;
typedef short bf16x8 __attribute__((ext_vector_type(8)));
typedef float f32x4 __attribute__((ext_vector_type(4)));
typedef unsigned u32x4 __attribute__((ext_vector_type(4)));
constexpr int BM = 256, BK = 64, HALF = 128, HTB = HALF * BK * 2  , STAGE_BYTES = 8 * HTB, NXCD = 8, WGM = 8;

__host__ __device__ __forceinline__ int lds_byte(int r, int c) { const int st = (r >> 4) * 2 + (c >> 5), rr = r & 15, cc = c & 31, ob = rr * 64 + cc * 2; return st * 1024 + (ob ^ (((ob >> 9) & 1) << 5)); }
__host__ __device__ __forceinline__ void stage_rc(int b, int& R, int& C) { const int st = b / 1024, sb = b % 1024, swz = sb ^ (((sb >> 9) & 1) << 5); R = (st >> 1) * 16 + swz / 64; C = (st & 1) * 32 + (swz % 64) / 2; }
__host__ __device__ __forceinline__ int perm32(int rho) { const int n = rho >> 4, i = rho & 15; return 8 * (i >> 2) + 4 * n + (i & 3); }

struct Unit { int pm, pn; };
struct Gemm { const bf16_t* A; const bf16_t* Bt; int M, N, K; };

struct StaticOrder {
    int nM, nN, nwg, G, c;
    __host__ __device__ void init(int M, int N, int G_, int c_) { nM = M / BM; nN = N / BM; nwg = nM * nN; G = G_; c = c_; }
    __host__ __device__ bool next(int i, Unit& u) const {
        const long L = (long)i * G + c; if (L >= nwg) return false;
        int wgid = (int)L; { const int q = nwg / NXCD, r = nwg % NXCD, xcd = wgid % NXCD, off = wgid / NXCD; wgid = (xcd < r ? xcd * (q + 1) : r * (q + 1) + (xcd - r) * q) + off; }
        const int nig = WGM * nN, gid = wgid / nig, fm = gid * WGM, gsz = (nM - fm) < WGM ? (nM - fm) : WGM;
        u.pm = fm + ((wgid % nig) % gsz); u.pn = (wgid % nig) / gsz; return true;
    }
    __device__ __forceinline__ void a_ready(const Unit&) const {}
    __device__ __forceinline__ void done(const Unit&) const {}
};
template <class Epi, class Sched, bool STAMP = false>
__device__ __forceinline__ void gemm_phase(PG8_LAS unsigned char* lds, const Gemm g, const Sched& S, const Epi& E, unsigned long long* stamps) {
    int tid_o = threadIdx.x; asm volatile("" : "+v"(tid_o));
    const int tid = tid_o, wid = __builtin_amdgcn_readfirstlane(tid >> 6), lane = tid & 63, wr = wid >> 2, wc = wid & 3, fr = lane & 15, fq = lane >> 4;
    const int K = g.K, nt = K / BK;
    int ts_lo = 0, ts_hi = 0, nts = 0; const unsigned long long rt_entry = STAMP ? (unsigned long long)wall_clock64() : 0ull;
#define PG8_STAMP() do { if (STAMP && wid == 0 && nts < 64) { const unsigned long long _c = (unsigned long long)clock64(); \
        ts_lo = (lane == nts) ? (int)(unsigned)_c : ts_lo; ts_hi = (lane == nts) ? (int)(unsigned)(_c >> 32) : ts_hi; ++nts; } } while (0)
    PG8_STAMP();
    unsigned voffA[2], voffB[2];
#pragma unroll
    for (int i = 0; i < 2; ++i) { int R, C; stage_rc(tid * 16 + i * 8192, R, C); const int Rb = Epi::PERM ? ((R & ~31) + perm32(R & 31)) : R;
        voffA[i] = (unsigned)(R * K + C) * 2u; voffB[i] = (unsigned)(Rb * K + C) * 2u; }
    const size_t kstep = (size_t)(BK * 2);
    const size_t hstep = (size_t)HALF * K * 2;
    const size_t tstep = 2 * hstep;
    const unsigned ldsw = (unsigned)wid * 1024u;
    const int aoff = lds_byte(wr * 64 + fr, fq * 8), boff = lds_byte(wc * 32 + fr, fq * 8);
#define PG8_SA(b, h) (((b) * 2 + (h)) * HTB)
#define PG8_SB(b, h) ((4 + (b) * 2 + (h)) * HTB)
#define PG8_STAGE(bufoff, gbase, voff) do { _Pragma("unroll") for (int _i = 0; _i < 2; ++_i) \
        __builtin_amdgcn_global_load_lds((const unsigned*)((const char*)(gbase) + (voff)[_i]), (PG8_LAS unsigned*)(lds + (bufoff) + ldsw + _i * 8192), 16, 0, 0); } while (0)
#define PG8_LDA(dst, b, h) do { _Pragma("unroll") for (int m = 0; m < 4; ++m) _Pragma("unroll") for (int k = 0; k < 2; ++k) dst[m][k] = *(const PG8_LAS bf16x8*)(lds + PG8_SA(b, h) + aoff + m * 2048 + k * 1024); } while (0)
#define PG8_LDB(dst, b, h) do { _Pragma("unroll") for (int n = 0; n < 2; ++n) _Pragma("unroll") for (int k = 0; k < 2; ++k) dst[n][k] = *(const PG8_LAS bf16x8*)(lds + PG8_SB(b, h) + boff + n * 2048 + k * 1024); } while (0)
#define PG8_MMA(ai, bj, At, Bt) do { __builtin_amdgcn_s_setprio(1); _Pragma("unroll") for (int m = 0; m < 4; ++m) _Pragma("unroll") for (int n = 0; n < 2; ++n) _Pragma("unroll") for (int k = 0; k < 2; ++k) \
        acc[ai][bj][m][n] = __builtin_amdgcn_mfma_f32_16x16x32_bf16(Bt[n][k], At[m][k], acc[ai][bj][m][n], 0, 0, 0); __builtin_amdgcn_s_setprio(0); } while (0)
#define PG8_WAIT_V(n) asm volatile("s_waitcnt vmcnt(" #n ")" ::: "memory")
#define PG8_WAIT_L(n) asm volatile("s_waitcnt lgkmcnt(" #n ")" ::: "memory")
#define PG8_BAR __builtin_amdgcn_s_barrier()
#define PG8_SCHED __builtin_amdgcn_sched_barrier(0)
    Unit cur, nxt; int ui = 0;
    if (!S.next(0, cur)) return;
    f32x4 acc[2][2][4][2];
#pragma unroll
    for (int a = 0; a < 2; ++a)
#pragma unroll
        for (int b = 0; b < 2; ++b)
#pragma unroll
            for (int m = 0; m < 4; ++m)
#pragma unroll
                for (int n = 0; n < 2; ++n) acc[a][b][m][n] = (f32x4){0.f, 0.f, 0.f, 0.f};
    bf16x8 At[4][2], B0[2][2], B1[2][2];
    const char* cA = (const char*)g.A + (size_t)cur.pm * tstep; const char* cB = (const char*)g.Bt + (size_t)cur.pn * tstep;
    S.a_ready(cur);
    PG8_STAGE(PG8_SB(0, 0), cB, voffB); PG8_STAGE(PG8_SA(0, 0), cA, voffA); PG8_STAGE(PG8_SB(0, 1), cB + hstep, voffB); PG8_STAGE(PG8_SA(0, 1), cA + hstep, voffA);
    if (wr == 1) PG8_BAR;
    PG8_WAIT_V(4); PG8_BAR;
    PG8_STAGE(PG8_SB(1, 0), cB + kstep, voffB); PG8_STAGE(PG8_SA(1, 0), cA + kstep, voffA); PG8_STAGE(PG8_SB(1, 1), cB + hstep + kstep, voffB);
    PG8_WAIT_V(6); PG8_BAR;
    PG8_STAMP();
    for (;;) {
        const bool has_next = S.next(ui + 1, nxt);
        const char* nA = has_next ? (const char*)g.A + (size_t)nxt.pm * tstep : cA; const char* nB = has_next ? (const char*)g.Bt + (size_t)nxt.pn * tstep : cB;
        for (int t = 0; t < nt; t += 2) {
            const bool last = (t == nt - 2);
            const char* a1 = cA + (size_t)(t + 1) * kstep;
            const char* a2 = last ? nA : cA + (size_t)(t + 2) * kstep; const char* b2 = last ? nB : cB + (size_t)(t + 2) * kstep;
            const char* a3 = a2 + kstep; const char* b3 = b2 + kstep;
            if (last && has_next) S.a_ready(nxt);
            PG8_LDB(B0, 0, 0); PG8_SCHED; PG8_LDA(At, 0, 0); PG8_STAGE(PG8_SA(1, 1), a1 + hstep, voffA);
            PG8_WAIT_L(8); PG8_BAR; PG8_WAIT_L(0); PG8_MMA(0, 0, At, B0); PG8_BAR; PG8_SCHED;
            PG8_LDB(B1, 0, 1); PG8_STAGE(PG8_SB(0, 0), b2, voffB);
            PG8_BAR; PG8_WAIT_L(0); PG8_MMA(0, 1, At, B1); PG8_BAR;
            PG8_LDA(At, 0, 1); PG8_STAGE(PG8_SA(0, 0), a2, voffA);
            PG8_BAR; PG8_WAIT_L(0); PG8_MMA(1, 0, At, B0); PG8_BAR; PG8_SCHED;
            PG8_STAGE(PG8_SB(0, 1), b2 + hstep, voffB);
            PG8_WAIT_V(6); PG8_BAR; PG8_MMA(1, 1, At, B1); PG8_BAR;
            PG8_LDB(B0, 1, 0); PG8_SCHED; PG8_LDA(At, 1, 0); PG8_STAGE(PG8_SA(0, 1), a2 + hstep, voffA);
            PG8_WAIT_L(8); PG8_BAR; PG8_WAIT_L(0); PG8_MMA(0, 0, At, B0); PG8_BAR; PG8_SCHED;
            PG8_LDB(B1, 1, 1); PG8_STAGE(PG8_SB(1, 0), b3, voffB);
            PG8_BAR; PG8_WAIT_L(0); PG8_MMA(0, 1, At, B1); PG8_BAR;
            PG8_LDA(At, 1, 1); PG8_STAGE(PG8_SA(1, 0), a3, voffA);
            PG8_BAR; PG8_WAIT_L(0); PG8_MMA(1, 0, At, B0); PG8_BAR; PG8_SCHED;
            PG8_STAGE(PG8_SB(1, 1), b3 + hstep, voffB);
            PG8_WAIT_V(6); PG8_BAR; PG8_MMA(1, 1, At, B1); PG8_BAR;
        }
        PG8_STAMP();
        if constexpr (!Epi::AFTER_DRAIN) { E(acc, cur, wr, wc, fr, fq); S.done(cur); }
        PG8_STAMP();
        if (!has_next) break;
#pragma unroll
        for (int a = 0; a < 2; ++a)
#pragma unroll
            for (int b = 0; b < 2; ++b)
#pragma unroll
                for (int m = 0; m < 4; ++m)
#pragma unroll
                    for (int n = 0; n < 2; ++n) acc[a][b][m][n] = (f32x4){0.f, 0.f, 0.f, 0.f};
        cur = nxt; cA = nA; cB = nB; ++ui;
    }
    PG8_WAIT_V(0);
    if (wr == 0) PG8_BAR;
    PG8_BAR;
    if constexpr (Epi::AFTER_DRAIN) { E.fused(acc, cur, wr, wc, fr, fq, lds, wid, lane); S.done(cur); }
    PG8_STAMP();
    if (STAMP && wid == 0) { stamps[lane] = lane < nts ? (((unsigned long long)(unsigned)ts_hi << 32) | (unsigned)ts_lo) : 0ull;
        if (lane == 62) stamps[62] = rt_entry; if (lane == 63) stamps[63] = (unsigned long long)wall_clock64(); }
#undef PG8_STAMP
#undef PG8_SA
#undef PG8_SB
#undef PG8_STAGE
#undef PG8_LDA
#undef PG8_LDB
#undef PG8_MMA
#undef PG8_WAIT_V
#undef PG8_WAIT_L
#undef PG8_BAR
#undef PG8_SCHED
}
}
__device__ __forceinline__ int in_src_col(int n) {
    if (n < 2048) return n;
    if (n < 2304) return 2056 + (n - 2048);
    if (n < 2560) return 2312 + (n - 2304);
    if (n < 2624) return 2568 + (n - 2560);
    if (n < 2640) return 2632 + (n - 2624);
    if (n < 2644) return 2048 + (n - 2640);
    if (n < 2648) return 2052 + (n - 2644);
    return -1;
}
__device__ __forceinline__ void tr_item(const float* W, int ldw, int srccol, bf16_t* WT, int ldt, int n0, int k0, LAS float* scr, int lane) {
#pragma unroll 4
    for (int i = 0; i < 32; ++i) { const int kk = 2 * i + (lane >> 5); scr[kk * 33 + (lane & 31)] = (srccol >= 0) ? W[(size_t)(k0 + kk) * ldw + srccol] : 0.f; }
    LDS_WAIT(); asm volatile("" ::: "memory");
    const int c = lane & 7;
#pragma unroll
    for (int j = 0; j < 4; ++j) { const int n = (lane >> 3) + 8 * j; const LAS float* s = scr + (8 * c) * 33 + n;
        u32x4 o; o.x = cvt_pk_bf16(s[0 * 33], s[1 * 33]); o.y = cvt_pk_bf16(s[2 * 33], s[3 * 33]); o.z = cvt_pk_bf16(s[4 * 33], s[5 * 33]); o.w = cvt_pk_bf16(s[6 * 33], s[7 * 33]);
        *(u32x4*)(WT + (size_t)(n0 + n) * ldt + k0 + 8 * c) = o; }
    LDS_WAIT(); asm volatile("" ::: "memory");
}
__device__ __forceinline__ void fold_nt(const float* A, int lda, const float* B, int ldb, bf16_t* O, int ldo, float sc, int lane) {
    float acc[16];
#pragma unroll
    for (int nn = 0; nn < 16; ++nn) acc[nn] = 0.f;
    const f32x4* ap = (const f32x4*)(A + (size_t)lane * lda);
#pragma unroll 1
    for (int dc = 0; dc < 4; ++dc) {
        float a[32];
#pragma unroll
        for (int i = 0; i < 8; ++i) { const f32x4 t = ap[8 * dc + i]; a[4 * i] = t[0]; a[4 * i + 1] = t[1]; a[4 * i + 2] = t[2]; a[4 * i + 3] = t[3]; }
#pragma unroll
        for (int nn = 0; nn < 16; ++nn) { const float* bp = B + (size_t)nn * ldb + 32 * dc; float t = acc[nn];
#pragma unroll
            for (int d = 0; d < 32; ++d) t = fmaf(a[d], bp[d], t);
            acc[nn] = t; }
        asm volatile("" ::: "memory");
    }
#pragma unroll
    for (int nn = 0; nn < 16; ++nn) O[(size_t)nn * ldo + lane] = f2bf(acc[nn] * sc);
}
__device__ __forceinline__ void fold_vo(const float* wo, const float* wv, bf16_t* O, int ldo, int lane) {
    float acc[16];
#pragma unroll
    for (int nn = 0; nn < 16; ++nn) acc[nn] = 0.f;
#pragma unroll 1
    for (int dc = 0; dc < 4; ++dc) {
        float a[32];
#pragma unroll
        for (int d = 0; d < 32; ++d) a[d] = wo[(size_t)(32 * dc + d) * 1024 + lane];
#pragma unroll
        for (int nn = 0; nn < 16; ++nn) { const float* bp = wv + (size_t)nn * 1024 + 32 * dc; float t = acc[nn];
#pragma unroll
            for (int d = 0; d < 32; ++d) t = fmaf(a[d], bp[d], t);
            acc[nn] = t; }
        asm volatile("" ::: "memory");
    }
    u32x4 o0, o1; o0.x = cvt_pk_bf16(acc[0], acc[1]); o0.y = cvt_pk_bf16(acc[2], acc[3]); o0.z = cvt_pk_bf16(acc[4], acc[5]); o0.w = cvt_pk_bf16(acc[6], acc[7]);
    o1.x = cvt_pk_bf16(acc[8], acc[9]); o1.y = cvt_pk_bf16(acc[10], acc[11]); o1.z = cvt_pk_bf16(acc[12], acc[13]); o1.w = cvt_pk_bf16(acc[14], acc[15]);
    u32x4* op = (u32x4*)(O + (size_t)lane * ldo); op[0] = o0; op[1] = o1;
}
__device__ __forceinline__ void p0_prologue(const Params& p, LAS unsigned char* lds, int gw, int ngw, int wave, int lane) {
    unsigned char* ws = p.ws;
    LAS float* scr = (LAS float*)(lds + wave * 8448);
    bf16_t* WINT = (bf16_t*)(ws + WS_WINT); bf16_t* WQ2T = (bf16_t*)(ws + WS_WQ2T); bf16_t* WO2T = (bf16_t*)(ws + WS_WOUT2T); bf16_t* WQST = (bf16_t*)(ws + WS_WQST);
    constexpr int I_IN = 16 * 88, I_QI = 4 * 32, I_WO = 8 * 32, F_QK = 256, F_QS = 2048, F_VO = 1024;
    constexpr int NITEMS = I_IN + I_QI + I_WO + F_QK + F_QS + F_VO;
    for (int it = gw; it < NITEMS; it += ngw) {
        int r = it;
        if (r < I_IN) { const int kb = r / 88, nb = r % 88; tr_item(p.w_in, IN_W, in_src_col(32 * nb + (lane & 31)), WINT, 1024, 32 * nb, 64 * kb, scr, lane); continue; } r -= I_IN;
        if (r < I_QI) { const int kb = r / 32, nb = r % 32; tr_item(p.w_qidx_up, 1024, 32 * nb + (lane & 31), WQ2T + (size_t)1024 * 256, 256, 32 * nb, 64 * kb, scr, lane); continue; } r -= I_QI;
        if (r < I_WO) { const int kb = r / 32, nb = r % 32; tr_item(p.w_out, 1024, 32 * nb + (lane & 31), WO2T, 1536, 32 * nb, 64 * kb, scr, lane); continue; } r -= I_WO;
        if (r < F_QK) {
            const int h = r >> 6, jt = (r >> 2) & 15, kt = r & 3;
            fold_nt(p.w_q_up + (size_t)(64 * kt) * 512 + h * 128, 512, p.w_kv_up + (size_t)(16 * jt) * 1024 + h * 256, 1024,
                    WQ2T + (size_t)(h * 256 + 16 * jt) * 256 + 64 * kt, 256, 0.08838834764831845f, lane);
            continue; } r -= F_QK;
        if (r < F_QS) {
            const int hs = r >> 7, nt = (r >> 4) & 7, kt = r & 15; const int h = hs >> 1, side = hs & 1;
            const float* sk = (side ? p.peer_k2 : p.peer_k1) + (size_t)(h * 128 + 16 * nt) * 128;
            fold_nt(p.peer_wq + (size_t)(64 * kt) * 2048 + hs * 128, 2048, sk, 128, WQST + (size_t)(hs * 128 + 16 * nt) * 1024 + 64 * kt, 1024, p.ln2_g[64 * kt + lane], lane);
            continue; } r -= F_QS;
        {
            const int h = r >> 8, jt = (r >> 4) & 15, nt = r & 15;
            fold_vo(p.w_out + (size_t)(512 + h * 128) * 1024 + 64 * nt, p.w_kv_up + (size_t)(16 * jt) * 1024 + h * 256 + 128, WO2T + (size_t)(64 * nt) * 1536 + 512 + h * 256 + 16 * jt, 1536, lane);
        }
    }
    bf16_t* HB = (bf16_t*)(ws + WS_HB);
    for (int m = gw; m < MT; m += ngw) {
        const f32x4* xr = (const f32x4*)(p.x + (size_t)m * DM) + lane; const f32x4* gr = (const f32x4*)p.ln1_g + lane;
        f32x4 v[4]; float s = 0.f;
#pragma unroll
        for (int j = 0; j < 4; ++j) { v[j] = xr[64 * j]; s += (v[j][0] * v[j][0] + v[j][1] * v[j][1]) + (v[j][2] * v[j][2] + v[j][3] * v[j][3]); }
        const float rstd = rsqrtf(wave_sum(s) * (1.f / DM) + EPS);
        u32x2* o8 = (u32x2*)(HB + (size_t)m * DM) + lane;
#pragma unroll
        for (int j = 0; j < 4; ++j) { const f32x4 g = gr[64 * j]; u32x2 w; w.x = cvt_pk_bf16(v[j][0] * rstd * g[0], v[j][1] * rstd * g[1]); w.y = cvt_pk_bf16(v[j][2] * rstd * g[2], v[j][3] * rstd * g[3]); o8[64 * j] = w; }
    }
}

struct EpiIn {
    static constexpr bool PERM = false, AFTER_DRAIN = false;
    unsigned char* ws;
    __device__ __forceinline__ void operator()(const f32x4 (&acc)[2][2][4][2], const pg8::Unit& u, int wr, int wc, int fr, int fq) const {
        const int row0 = u.pm * 256 + wr * 64 + fr, cl0 = wc * 32 + 4 * fq, pn = u.pn;
        if (pn < 10) {
            bf16_t* base; int ld;
            if (pn < 6) { base = (bf16_t*)(ws + WS_QKV) + pn * 256; ld = 1536; }
            else if (pn < 8) { base = (bf16_t*)(ws + WS_ZB) + (pn - 6) * 256; ld = 512; }
            else if (pn == 8) { base = (bf16_t*)(ws + WS_CQ); ld = 256; }
            else { base = (bf16_t*)(ws + WS_CKV); ld = 256; }
#pragma unroll
            for (int ai = 0; ai < 2; ++ai)
#pragma unroll
                for (int m = 0; m < 4; ++m) { bf16_t* rowp = base + (size_t)(row0 + ai * 128 + m * 16) * ld + cl0;
#pragma unroll
                    for (int bj = 0; bj < 2; ++bj)
#pragma unroll
                        for (int n = 0; n < 2; ++n) { const f32x4 v = acc[ai][bj][m][n]; u32x2 w; w.x = cvt_pk_bf16(v[0], v[1]); w.y = cvt_pk_bf16(v[2], v[3]); *(u32x2*)(rowp + bj * 128 + n * 16) = w; }
                    asm volatile("" ::: "memory"); }
        } else {
            float* base = (float*)(ws + WS_MISC);
#pragma unroll
            for (int ai = 0; ai < 2; ++ai)
#pragma unroll
                for (int m = 0; m < 4; ++m) { float* rowp = base + (size_t)(row0 + ai * 128 + m * 16) * 128 + cl0;
#pragma unroll
                    for (int n = 0; n < 2; ++n) *(f32x4*)(rowp + n * 16) = acc[ai][0][m][n]; }
        }
    }
};
struct EpiQ {
    static constexpr bool PERM = false, AFTER_DRAIN = false;
    unsigned char* ws;
    __device__ __forceinline__ void operator()(const f32x4 (&acc)[2][2][4][2], const pg8::Unit& u, int wr, int wc, int fr, int fq) const {
        const int row0 = u.pm * 256 + wr * 64 + fr, cl0 = wc * 32 + 4 * fq, pn = u.pn;
        bf16_t* base; int ld;
        if (pn < 4) { base = (bf16_t*)(ws + WS_AOUT) + 512 + pn * 256; ld = 1536; } else { base = (bf16_t*)(ws + WS_QIDX) + (pn - 4) * 256; ld = 1024; }
#pragma unroll
        for (int ai = 0; ai < 2; ++ai)
#pragma unroll
            for (int m = 0; m < 4; ++m) { bf16_t* rowp = base + (size_t)(row0 + ai * 128 + m * 16) * ld + cl0;
#pragma unroll
                for (int bj = 0; bj < 2; ++bj)
#pragma unroll
                    for (int n = 0; n < 2; ++n) { const f32x4 v = acc[ai][bj][m][n]; u32x2 w; w.x = cvt_pk_bf16(v[0], v[1]); w.y = cvt_pk_bf16(v[2], v[3]); *(u32x2*)(rowp + bj * 128 + n * 16) = w; }
                asm volatile("" ::: "memory"); }
    }
};
struct EpiOut {
    static constexpr bool PERM = false, AFTER_DRAIN = false;
    const float* x; float* out; bf16_t* x1b; float* rss;
    __device__ __forceinline__ void operator()(const f32x4 (&acc)[2][2][4][2], const pg8::Unit& u, int wr, int wc, int fr, int fq) const {
        const int row0 = u.pm * 256 + wr * 64 + fr, col0 = u.pn * 256 + wc * 32 + 4 * fq;
#pragma unroll
        for (int ai = 0; ai < 2; ++ai)
#pragma unroll
            for (int m = 0; m < 4; ++m) { const int row = row0 + ai * 128 + m * 16; const size_t off = (size_t)row * DM + col0; float ss = 0.f;
#pragma unroll
                for (int bj = 0; bj < 2; ++bj)
#pragma unroll
                    for (int n = 0; n < 2; ++n) { const f32x4 xv = *(const f32x4*)(x + off + bj * 128 + n * 16); const f32x4 v = acc[ai][bj][m][n] + xv;
                        *(f32x4*)(out + off + bj * 128 + n * 16) = v; u32x2 w; w.x = cvt_pk_bf16(v[0], v[1]); w.y = cvt_pk_bf16(v[2], v[3]); *(u32x2*)(x1b + off + bj * 128 + n * 16) = w;
                        ss += (v[0] * v[0] + v[1] * v[1]) + (v[2] * v[2] + v[3] * v[3]); }
                ss += __shfl_xor(ss, 16); ss += __shfl_xor(ss, 32);
                if (fq == 0) __hip_atomic_fetch_add(rss + row, ss, __ATOMIC_RELAXED, __HIP_MEMORY_SCOPE_AGENT);
                asm volatile("" ::: "memory"); }
    }
};
struct EpiS {
    static constexpr bool PERM = false, AFTER_DRAIN = false;
    float* S; const float* rss;
    __device__ __forceinline__ void operator()(const f32x4 (&acc)[2][2][4][2], const pg8::Unit& u, int wr, int wc, int fr, int fq) const {
        const int row0 = u.pm * 256 + wr * 64 + fr, col0 = u.pn * 256 + wc * 32 + 4 * fq;
#pragma unroll
        for (int ai = 0; ai < 2; ++ai)
#pragma unroll
            for (int m = 0; m < 4; ++m) { const int row = row0 + ai * 128 + m * 16; const float rs = rsqrtf(rss[row] * (1.f / DM) + EPS); float* rowp = S + (size_t)row * 2048 + col0;
#pragma unroll
                for (int bj = 0; bj < 2; ++bj)
#pragma unroll
                    for (int n = 0; n < 2; ++n) *(f32x4*)(rowp + bj * 128 + n * 16) = acc[ai][bj][m][n] * rs; }
    }
};

__device__ __forceinline__ void p3_token(const Params& p, int m, int lane) {
    unsigned char* ws = p.ws;
    const int b = m >> 13, t = m & (SEQ - 1);
    const bf16_t* pre = (const bf16_t*)(ws + WS_QKV);
#pragma unroll 1
    for (int hv = 0; hv < 12; ++hv) {
        const int c0 = hv * 128 + lane, c1 = c0 + 64;
        float y0 = 0.f, y1 = 0.f;
#pragma unroll
        for (int jj = 0; jj < 4; ++jj) { if (t - 3 + jj >= 0) { const bf16_t* row = pre + (size_t)(m - 3 + jj) * 1536;
            y0 = fmaf(p.conv_w[jj * 1536 + c0], bf2f(row[c0]), y0); y1 = fmaf(p.conv_w[jj * 1536 + c1], bf2f(row[c1]), y1); } }
        y0 = silu_f(y0); y1 = silu_f(y1);
        if (hv < 8) { const float ss = wave_sum(y0 * y0 + y1 * y1); float r = rsqrtf(ss + EPS); if (hv < 4) r *= 0.08838834764831845f; y0 *= r; y1 *= r; }
        bf16_t* dst = (bf16_t*)(ws + (hv < 4 ? WS_QH : (hv < 8 ? WS_KH : WS_VH)));
        const int h = hv & 3;
        const size_t idx = ((((size_t)(b * 4 + h)) * NCHUNK + (t >> 6)) * 64 + (t & 63)) * 128;
        dst[idx + lane] = f2bf(y0); dst[idx + lane + 64] = f2bf(y1);
    }
    const float* misc = (const float*)(ws + WS_MISC) + (size_t)m * 128;
    if (lane < 4) {
        const float a = misc[80 + lane] + p.dt_bias[lane], bb = misc[84 + lane];
        const float sp = (a > 20.f) ? a : log1pf(__expf(a));
        ((float*)(ws + WS_GARR))[(size_t)(b * 4 + lane) * SEQ + t] = -__expf(p.a_log[lane]) * sp;
        ((float*)(ws + WS_BARR))[(size_t)(b * 4 + lane) * SEQ + t] = 1.f / (1.f + __expf(-bb));
    }
    {
        u32x2* cq = (u32x2*)((bf16_t*)(ws + WS_CQ) + (size_t)m * 256) + lane; const u32x2 v = *cq;
        float f0 = bf_lo(v.x), f1 = bf_hi(v.x), f2 = bf_lo(v.y), f3 = bf_hi(v.y);
        float rs = rsqrtf(wave_sum((f0 * f0 + f1 * f1) + (f2 * f2 + f3 * f3)) * (1.f / 256.f) + EPS);
        f32x4 g = ((const f32x4*)p.q_norm_g)[lane]; u32x2 w; w.x = cvt_pk_bf16(f0 * rs * g[0], f1 * rs * g[1]); w.y = cvt_pk_bf16(f2 * rs * g[2], f3 * rs * g[3]); *cq = w;
        u32x2* ck = (u32x2*)((bf16_t*)(ws + WS_CKV) + (size_t)m * 256) + lane; const u32x2 v2 = *ck;
        f0 = bf_lo(v2.x); f1 = bf_hi(v2.x); f2 = bf_lo(v2.y); f3 = bf_hi(v2.y);
        rs = rsqrtf(wave_sum((f0 * f0 + f1 * f1) + (f2 * f2 + f3 * f3)) * (1.f / 256.f) + EPS);
        g = ((const f32x4*)p.kv_norm_g)[lane]; w.x = cvt_pk_bf16(f0 * rs * g[0], f1 * rs * g[1]); w.y = cvt_pk_bf16(f2 * rs * g[2], f3 * rs * g[3]); *ck = w;
    }
    {
        const float xk = misc[lane]; const float mu = wave_sum(xk) * (1.f / 64.f); const float d = xk - mu; const float var = wave_sum(d * d) * (1.f / 64.f);
        ((bf16_t*)(ws + WS_KIDXN))[(size_t)m * 64 + lane] = f2bf(d * rsqrtf(var + EPS) * p.idx_ln_g[lane] + p.idx_ln_b[lane]);
        if (lane < 16) ((float*)(ws + WS_WIDX))[(size_t)m * 16 + lane] = misc[64 + lane] * (0.5f / 32.f);
    }
}

constexpr int G2_KL = 0, G2_QL = 17408, G2_VT = 34816, G2_KBT = 53248, G2_TL = 71680, G2_AM = 80896, G2_GC = 97280;
__device__ __forceinline__ float bf_elem(const u32x4& v, int e) { const unsigned w = v[e >> 1]; return (e & 1) ? bf_hi(w) : bf_lo(w); }
__device__ __forceinline__ void g2_chunk(const Params& p, LAS unsigned char* lds, int cb, int tid, int wave, int lane) {
    unsigned char* ws = p.ws;
    bf16_t* qB = (bf16_t*)(ws + WS_QH) + (size_t)cb * 8192; bf16_t* kB = (bf16_t*)(ws + WS_KH) + (size_t)cb * 8192; bf16_t* vB = (bf16_t*)(ws + WS_VH) + (size_t)cb * 8192;
    bf16_t* wB = (bf16_t*)(ws + WS_WBUF) + (size_t)cb * 8192; bf16_t* aB = (bf16_t*)(ws + WS_ATTN) + (size_t)cb * 4096;
    const int bh = cb >> 7, c = cb & 127;
    const float* gsrc = (const float*)(ws + WS_GARR) + (size_t)bh * SEQ + c * 64; const float* bsrc = (const float*)(ws + WS_BARR) + (size_t)bh * SEQ + c * 64;
    LAS bf16_t* KL = (LAS bf16_t*)(lds + G2_KL); LAS bf16_t* QL = (LAS bf16_t*)(lds + G2_QL); LAS bf16_t* VT = (LAS bf16_t*)(lds + G2_VT);
    LAS bf16_t* KBT = (LAS bf16_t*)(lds + G2_KBT); LAS bf16_t* TL = (LAS bf16_t*)(lds + G2_TL); LAS float* AM = (LAS float*)(lds + G2_AM);
    LAS float* GC = (LAS float*)(lds + G2_GC); LAS float* BT = GC + 64;
    const int g = lane >> 4, fr = lane & 15;
#ifdef PROBE_NAN
    unsigned pbad = 0u;
#define PCHK(idx, v) do { if (!(fabsf(v) < 1e30f)) pbad |= 1u << ((idx) - 30); } while (0)
#else
#define PCHK(idx, v) do {} while (0)
#endif
    u32x4 kp[2], qp[2], vp[2];
#pragma unroll
    for (int i = 0; i < 2; ++i) { const int piece = tid + 512 * i; kp[i] = ((const u32x4*)kB)[piece]; qp[i] = ((const u32x4*)qB)[piece]; vp[i] = ((const u32x4*)vB)[piece]; }
    if (wave == 0) {
        float gv = gsrc[lane];
#pragma unroll
        for (int o = 1; o < 64; o <<= 1) { const float t = __shfl_up(gv, o); if (lane >= o) gv += t; }
        GC[lane] = gv; BT[lane] = bsrc[lane]; PCHK(30, gv); PCHK(30, bsrc[lane]);
    }
    __syncthreads();
#pragma unroll
    for (int i = 0; i < 2; ++i) { const int piece = tid + 512 * i, row = piece >> 4, ch = piece & 15;
        *(LAS u32x4*)(KL + row * 136 + ch * 8) = kp[i]; *(LAS u32x4*)(QL + row * 136 + ch * 8) = qp[i];
        const float bj = BT[row], be = bj * __expf(GC[row]);
#pragma unroll
        for (int e = 0; e < 8; ++e) { VT[(ch * 8 + e) * 72 + row] = f2bf(bf_elem(vp[i], e) * bj); KBT[(ch * 8 + e) * 72 + row] = f2bf(bf_elem(kp[i], e) * be); } }
    __syncthreads();
#pragma unroll
    for (int tt = 0; tt < 2; ++tt) { const int idx = wave + 8 * tt, ti = idx >> 2, tj = idx & 3;
        f32x4 accA = {0.f, 0.f, 0.f, 0.f}, accT = {0.f, 0.f, 0.f, 0.f};
        if (tj <= ti) {
#pragma unroll
            for (int s = 0; s < 4; ++s) { const bf16x8 ki = *(const LAS bf16x8*)(KL + (16 * ti + fr) * 136 + 32 * s + 8 * g), kj = *(const LAS bf16x8*)(KL + (16 * tj + fr) * 136 + 32 * s + 8 * g),
                                                       qi = *(const LAS bf16x8*)(QL + (16 * ti + fr) * 136 + 32 * s + 8 * g);
                accA = MFMA16(ki, kj, accA);
                accT = MFMA16(kj, qi, accT); }
        }
#pragma unroll
        for (int reg = 0; reg < 4; ++reg) { const int i = 16 * ti + 4 * g + reg, j = 16 * tj + fr;
            const float amv = (j < i) ? BT[i] * accA[reg] * __expf(GC[i] - GC[j]) : 0.f; AM[i * 64 + j] = amv; }
        { const int i = 16 * ti + fr; float v[4];
#pragma unroll
            for (int reg = 0; reg < 4; ++reg) { const int j = 16 * tj + 4 * g + reg; v[reg] = (j <= i) ? accT[reg] * __expf(GC[i] - GC[j]) : 0.f; }
            u32x2 w; w.x = cvt_pk_bf16(v[0], v[1]); w.y = cvt_pk_bf16(v[2], v[3]); *(u32x2*)(aB + i * 64 + 16 * tj + 4 * g) = w; }
    }
    __syncthreads();
    if (wave == 0) {
        float tc[64];
#pragma unroll
        for (int i = 0; i < 64; ++i) { float acc = (i == lane) ? 1.f : 0.f;
#pragma unroll
            for (int j4 = 0; j4 < (i + 3) / 4; ++j4) { const f32x4 a = *(const LAS f32x4*)(AM + i * 64 + 4 * j4);
#pragma unroll
                for (int e = 0; e < 4; ++e) if (4 * j4 + e < i) { const float sv = __builtin_bit_cast(float, __builtin_amdgcn_readfirstlane(__builtin_bit_cast(int, a[e]))); acc = fmaf(-sv, tc[4 * j4 + e], acc); } }
            tc[i] = acc; asm volatile("" ::: "memory"); }
#pragma unroll
        for (int i = 0; i < 64; ++i) { TL[i * 72 + lane] = f2bf(tc[i]); PCHK(34, tc[i]); }
    } else {
        const int t2 = tid - 64; const float gl = GC[63];
        for (int piece = t2; piece < 1024; piece += 448) { const int row = piece >> 4, ch = piece & 15; const u32x4 v = *(const LAS u32x4*)(QL + row * 136 + ch * 8); const float e = __expf(GC[row]);
            u32x4 o; o.x = cvt_pk_bf16(bf_lo(v.x) * e, bf_hi(v.x) * e); o.y = cvt_pk_bf16(bf_lo(v.y) * e, bf_hi(v.y) * e); o.z = cvt_pk_bf16(bf_lo(v.z) * e, bf_hi(v.z) * e); o.w = cvt_pk_bf16(bf_lo(v.w) * e, bf_hi(v.w) * e);
            ((u32x4*)qB)[piece] = o; }
        for (int piece = t2; piece < 1024; piece += 448) { const int d = piece >> 3, jc = piece & 7; float v[8];
#pragma unroll
            for (int e = 0; e < 8; ++e) { const int j = 8 * jc + e; v[e] = bf2f(KL[j * 136 + d]) * __expf(gl - GC[j]); }
            u32x4 o; o.x = cvt_pk_bf16(v[0], v[1]); o.y = cvt_pk_bf16(v[2], v[3]); o.z = cvt_pk_bf16(v[4], v[5]); o.w = cvt_pk_bf16(v[6], v[7]);
            *(u32x4*)(kB + d * 64 + 8 * jc) = o; }
        if (t2 == 0) ((float*)(ws + WS_GAMMA))[cb] = __expf(gl);
    }
    __syncthreads();
#pragma unroll
    for (int tt = 0; tt < 4; ++tt) { const int t = wave * 4 + tt, ti = t >> 3, te = t & 7; f32x4 acc = {0.f, 0.f, 0.f, 0.f};
#pragma unroll
        for (int s = 0; s < 2; ++s) { const bf16x8 fa = *(const LAS bf16x8*)(TL + (16 * ti + fr) * 72 + 32 * s + 8 * g), fb = *(const LAS bf16x8*)(VT + (16 * te + fr) * 72 + 32 * s + 8 * g);
#ifdef PROBE_NAN
#pragma unroll
            for (int e = 0; e < 8; ++e) { if (((unsigned)fa[e] & 0x7F80u) == 0x7F80u) pbad |= 8u; if (((unsigned)fb[e] & 0x7F80u) == 0x7F80u) pbad |= 32u; }
#endif
            acc = MFMA16(fa, fb, acc); }
        PCHK(36, acc[0]); PCHK(36, acc[1]); PCHK(36, acc[2]); PCHK(36, acc[3]);
        u32x2 w; w.x = cvt_pk_bf16(acc[0], acc[1]); w.y = cvt_pk_bf16(acc[2], acc[3]); *(u32x2*)(vB + (16 * te + fr) * 64 + 16 * ti + 4 * g) = w; }
#pragma unroll
    for (int tt = 0; tt < 4; ++tt) { const int t = wave * 4 + tt, td = t >> 2, ti = t & 3; f32x4 acc = {0.f, 0.f, 0.f, 0.f};
#pragma unroll
        for (int s = 0; s < 2; ++s) { const bf16x8 fa = *(const LAS bf16x8*)(KBT + (16 * td + fr) * 72 + 32 * s + 8 * g), fb = *(const LAS bf16x8*)(TL + (16 * ti + fr) * 72 + 32 * s + 8 * g);
#ifdef PROBE_NAN
#pragma unroll
            for (int e = 0; e < 8; ++e) { if (((unsigned)fa[e] & 0x7F80u) == 0x7F80u) pbad |= 2u; if (((unsigned)fb[e] & 0x7F80u) == 0x7F80u) pbad |= 8u; }
#endif
            acc = MFMA16(fa, fb, acc); }
        PCHK(32, acc[0]); PCHK(32, acc[1]); PCHK(32, acc[2]); PCHK(32, acc[3]);
        u32x2 w; w.x = cvt_pk_bf16(acc[0], acc[1]); w.y = cvt_pk_bf16(acc[2], acc[3]); *(u32x2*)(wB + (16 * ti + fr) * 128 + 16 * td + 4 * g) = w; }
#ifdef PROBE_NAN
    if (pbad) { unsigned* pfl = (unsigned*)(ws + WS_CTL) + 1024; for (int k = 0; k < 7; ++k) if (pbad & (1u << k)) atomicOr(pfl + 30 + k, 1u); }
#endif
    __syncthreads();
}

__device__ __forceinline__ void g3_scan(const Params& p, LAS unsigned char* lds, int bh, int wave, int lane) {
    unsigned char* ws = p.ws;
    const int b = bh >> 2, h = bh & 3, e0 = 16 * wave;
    LAS float* SSQ = (LAS float*)lds;
    f32x4 S[8];
#pragma unroll
    for (int i = 0; i < 8; ++i) S[i] = (f32x4){0.f, 0.f, 0.f, 0.f};
    const float gn = p.gdn_norm_g[e0 + (lane & 15)];
    const bf16_t* ZB = (const bf16_t*)(ws + WS_ZB); bf16_t* AO = (bf16_t*)(ws + WS_AOUT);
#pragma unroll 1
    for (int c = 0; c < NCHUNK; ++c) {
        int lane_o = threadIdx.x & 63; asm volatile("" : "+v"(lane_o));
        const int g = lane_o >> 4, fr = lane_o & 15;
        const size_t cb = (size_t)bh * NCHUNK + c;
        const bf16_t* wB = (const bf16_t*)(ws + WS_WBUF) + cb * 8192; const bf16_t* qB = (const bf16_t*)(ws + WS_QH) + cb * 8192; const bf16_t* kT = (const bf16_t*)(ws + WS_KH) + cb * 8192;
        const bf16_t* uT = (const bf16_t*)(ws + WS_VH) + cb * 8192; const bf16_t* at = (const bf16_t*)(ws + WS_ATTN) + cb * 4096;
        const float gam = ((const float*)(ws + WS_GAMMA))[cb];
        bf16x8 Sb[4];
#pragma unroll
        for (int kb = 0; kb < 4; ++kb) Sb[kb] = pk8(S[2 * kb], S[2 * kb + 1]);
        f32x4 vn[4], ot[4];
#pragma unroll
        for (int mt = 0; mt < 4; ++mt) { f32x4 acc = {0.f, 0.f, 0.f, 0.f}; const bf16_t* rp = wB + (16 * mt + fr) * 128 + 4 * g;
#pragma unroll
            for (int kb = 0; kb < 4; ++kb) acc = MFMA16(mk8(*(const u32x2*)(rp + 32 * kb), *(const u32x2*)(rp + 32 * kb + 16)), Sb[kb], acc);
            const u32x2 uu = *(const u32x2*)(uT + (e0 + fr) * 64 + 16 * mt + 4 * g);
            vn[mt] = (f32x4){bf_lo(uu.x) - acc[0], bf_hi(uu.x) - acc[1], bf_lo(uu.y) - acc[2], bf_hi(uu.y) - acc[3]}; }
        bf16x8 vb[2]; vb[0] = pk8(vn[0], vn[1]); vb[1] = pk8(vn[2], vn[3]);
#pragma unroll
        for (int mt = 0; mt < 4; ++mt) { f32x4 acc = {0.f, 0.f, 0.f, 0.f}; const bf16_t* rp = qB + (16 * mt + fr) * 128 + 4 * g; const bf16_t* ap = at + (16 * mt + fr) * 64 + 4 * g;
#pragma unroll
            for (int kb = 0; kb < 4; ++kb) acc = MFMA16(mk8(*(const u32x2*)(rp + 32 * kb), *(const u32x2*)(rp + 32 * kb + 16)), Sb[kb], acc);
#pragma unroll
            for (int k2 = 0; k2 < 2; ++k2) acc = MFMA16(mk8(*(const u32x2*)(ap + 32 * k2), *(const u32x2*)(ap + 32 * k2 + 16)), vb[k2], acc);
            ot[mt] = acc; }
#pragma unroll
        for (int rt = 0; rt < 8; ++rt) { f32x4 acc = S[rt] * gam; const bf16_t* kp = kT + (16 * rt + fr) * 64 + 4 * g;
#pragma unroll
            for (int k2 = 0; k2 < 2; ++k2) acc = MFMA16(mk8(*(const u32x2*)(kp + 32 * k2), *(const u32x2*)(kp + 32 * k2 + 16)), vb[k2], acc);
            S[rt] = acc; }
        const int par = c & 1;
#pragma unroll
        for (int mt = 0; mt < 4; ++mt)
#pragma unroll
            for (int reg = 0; reg < 4; ++reg) { float s = ot[mt][reg] * ot[mt][reg]; s += __shfl_xor(s, 1); s += __shfl_xor(s, 2); s += __shfl_xor(s, 4); s += __shfl_xor(s, 8);
                if (fr == 0) SSQ[(par * 64 + 16 * mt + 4 * g + reg) * 8 + wave] = s; }
        __syncthreads();
#pragma unroll
        for (int mt = 0; mt < 4; ++mt)
#pragma unroll
            for (int reg = 0; reg < 4; ++reg) { const int i = 16 * mt + 4 * g + reg; const LAS f32x4* sp = (const LAS f32x4*)(SSQ + (par * 64 + i) * 8); const f32x4 a = sp[0], b2 = sp[1];
                const float tot = ((a[0] + a[1]) + (a[2] + a[3])) + ((b2[0] + b2[1]) + (b2[2] + b2[3])); const float rstd = rsqrtf(tot * (1.f / 128.f) + EPS);
                const size_t m = (size_t)b * SEQ + c * 64 + i; const float zf = bf2f(ZB[m * 512 + h * 128 + e0 + fr]);
                AO[m * 1536 + h * 128 + e0 + fr] = f2bf(ot[mt][reg] * rstd * gn * silu_f(zf)); }
    }
}

constexpr int DL_QS = 0;
constexpr int DL_IMG = 0;
constexpr int DL_SEL = 131072;
constexpr int DL_HIST = 139264;
constexpr int DL_WQ = 147456;
constexpr int DL_BKT = 148480;
constexpr int DL_RB = 156672;
static_assert(DL_RB + 512 <= LDS_MISC, "DSA LDS map");

__device__ __forceinline__ unsigned img_off(unsigned row, unsigned ch) { return 256u * row + 16u * (ch ^ (((row & 3u) << 2) | ((row >> 2) & 3u))); }
__device__ __forceinline__ unsigned key16(unsigned u) { return (u & 0x8000u) ? (~u & 0xffffu) : (u | 0x8000u); }
__device__ __forceinline__ void radix_find(const LAS unsigned* hist, unsigned need, int lane, unsigned& bsel, unsigned& above) {
    const u32x4 hv = *(const LAS u32x4*)(hist + 4 * lane);
    const unsigned s4 = hv.x + hv.y + hv.z + hv.w;
    unsigned incl = s4;
#pragma unroll
    for (int o = 1; o < 64; o <<= 1) { const unsigned t = __shfl_down(incl, o); if (lane + o < 64) incl += t; }
    const unsigned excl = incl - s4;
    const bool hit = (excl < need) && (incl >= need);
    const unsigned c3 = excl + hv.w, c2 = c3 + hv.z, c1 = c2 + hv.y;
    unsigned bb, ab;
    if (c3 >= need) { bb = 3; ab = excl; } else if (c2 >= need) { bb = 2; ab = c3; } else if (c1 >= need) { bb = 1; ab = c2; } else { bb = 0; ab = c1; }
    const unsigned long long mask = __ballot(hit);
    const int src = mask ? (__ffsll((long long)mask) - 1) : 0;
    bsel = __shfl(4u * lane + bb, src); above = __shfl(ab, src);
}
__device__ __forceinline__ void dsa_tables(const Params& p, LAS unsigned char* lds, int tid) {
    LAS unsigned char* BK = lds + DL_BKT; LAS float* RB = (LAS float*)(lds + DL_RB);
    for (int d = tid; d < SEQ; d += NTHR) { int bk = d;
        if (d >= 16) { bk = 16 + (d >= 21) + (d >= 27) + (d >= 35) + (d >= 46) + (d >= 59) + (d >= 77) + (d >= 99) + (d >= 128) + (d >= 166) + (d >= 216) + (d >= 280) + (d >= 363) + (d >= 470) + (d >= 609) + (d >= 790); }
        BK[d] = (unsigned char)bk; }
    if (tid < 128) RB[tid] = p.rel_bias[tid];
    __syncthreads();
}
__device__ __forceinline__ void dsa_unit(const Params& p, LAS unsigned char* lds, int b, int qb16) {
    unsigned char* ws = p.ws;
    int tid = threadIdx.x; asm volatile("" : "+v"(tid));
    const int lane = tid & 63, wave = __builtin_amdgcn_readfirstlane(tid >> 6);
    const int g = lane >> 4, fr = lane & 15, t0 = 16 * qb16, nkt = qb16 + 1;
    const size_t m0 = (size_t)b * SEQ + t0;
    LAS bf16_t* QS = (LAS bf16_t*)(lds + DL_QS); LAS float* WQ = (LAS float*)(lds + DL_WQ);
    LAS unsigned short* SEL = (LAS unsigned short*)(lds + DL_SEL); LAS unsigned* HIST = (LAS unsigned*)(lds + DL_HIST) + wave * 256;
    const LAS unsigned char* BK = lds + DL_BKT; const LAS float* RB = (const LAS float*)(lds + DL_RB);
    _Float16* scr = (_Float16*)(ws + WS_SCR) + (size_t)blockIdx.x * (16 * SEQ);
    {
        const bf16_t* qsrc = (const bf16_t*)(ws + WS_QIDX) + m0 * 1024;
#pragma unroll
        for (int i = 0; i < 4; ++i) { const int piece = tid + 512 * i, qi = piece >> 7, rem = piece & 127, h = rem >> 3, ch = rem & 7;
            *(LAS u32x4*)(QS + (h * 16 + qi) * 72 + ch * 8) = *(const u32x4*)(qsrc + (size_t)qi * 1024 + h * 64 + ch * 8); }
        if (tid < 256) WQ[tid] = ((const float*)(ws + WS_WIDX))[m0 * 16 + tid];
        __syncthreads();
        { const int qi = tid >> 5, d = (tid & 31) * 2; float s0 = 0.f, s1 = 0.f;
#pragma unroll
            for (int h = 0; h < 16; ++h) { const unsigned w2 = *(const LAS unsigned*)(QS + (h * 16 + qi) * 72 + d); const float wh = WQ[qi * 16 + h]; s0 = fmaf(wh, bf_lo(w2), s0); s1 = fmaf(wh, bf_hi(w2), s1); }
            *(LAS unsigned*)(QS + (16 * 16 + qi) * 72 + d) = cvt_pk_bf16(s0, s1); }
        __syncthreads();
    }
    {
        float wreg[16];
#pragma unroll
        for (int h = 0; h < 16; ++h) wreg[h] = WQ[fr * 16 + h];
        const bf16_t* kbase = (const bf16_t*)(ws + WS_KIDXN) + (size_t)b * SEQ * 64;
#pragma unroll 1
        for (int kt2 = wave; 2 * kt2 < nkt; kt2 += 8) {
            unsigned oz1; asm volatile("v_mov_b32 %0, 0" : "=v"(oz1));
            const LAS bf16_t* QSz = QS + oz1;
            bf16x8 ka[2][2];
#pragma unroll
            for (int tl = 0; tl < 2; ++tl) { int kt = 2 * kt2 + tl; if (kt >= nkt) kt = 0; const bf16_t* kr = kbase + (size_t)(16 * kt + fr) * 64 + 8 * g; ka[tl][0] = *(const bf16x8*)kr; ka[tl][1] = *(const bf16x8*)(kr + 32); }
            f32x4 sc[2]; sc[0] = (f32x4){0.f, 0.f, 0.f, 0.f}; sc[1] = sc[0];
#pragma unroll
            for (int h = 0; h < 17; ++h) { const bf16x8 qb0 = *(const LAS bf16x8*)(QSz + (h * 16 + fr) * 72 + 8 * g), qb1 = *(const LAS bf16x8*)(QSz + (h * 16 + fr) * 72 + 32 + 8 * g);
#pragma unroll
                for (int tl = 0; tl < 2; ++tl) { f32x4 c = {0.f, 0.f, 0.f, 0.f}; c = MFMA16(ka[tl][0], qb0, c); c = MFMA16(ka[tl][1], qb1, c);
                    if (h < 16) {
#pragma unroll
                        for (int r = 0; r < 4; ++r) sc[tl][r] = fmaf(__builtin_fabsf(c[r]), wreg[h < 16 ? h : 0], sc[tl][r]);
                    } else sc[tl] += c; } }
#pragma unroll
            for (int tl = 0; tl < 2; ++tl) { const int kt = 2 * kt2 + tl;
                if (kt < nkt) { _Float16 hv[4];
#pragma unroll
                    for (int r = 0; r < 4; ++r) { const int key = 16 * kt + 4 * g + r; float v = sc[tl][r]; if (key > t0 + fr) v = -INFINITY; hv[r] = (_Float16)v; }
                    typedef _Float16 h4 __attribute__((ext_vector_type(4))); h4 o; o[0] = hv[0]; o[1] = hv[1]; o[2] = hv[2]; o[3] = hv[3];
                    *(h4*)(scr + (size_t)fr * SEQ + 16 * kt + 4 * g) = o; } }
        }
    }
    VM_WAIT(); __syncthreads();
    const bf16_t* ckv = (const bf16_t*)(ws + WS_CKV) + (size_t)b * SEQ * 256;
    bf16_t* AO = (bf16_t*)(ws + WS_AOUT);
    LAS unsigned char* img = lds + DL_IMG + wave * 16384;
#pragma unroll 1
    for (int qq = 0; qq < 2; ++qq) {
        int lane3 = threadIdx.x & 63; asm volatile("" : "+v"(lane3));
        const int lane = lane3, g = lane >> 4, fr = lane & 15;
        const unsigned long long lt_mask = (1ull << lane) - 1ull;
        const int qi = wave + 8 * qq, t = t0 + qi, n = t + 1; const size_t m = m0 + qi;
        LAS unsigned short* sel = SEL + qi * 256;
        int cnt;
        if (n <= 256) { cnt = n; for (int k = lane; k < 256; k += 64) sel[k] = (unsigned short)((k < n) ? k : 0); }
        else {
            cnt = 256;
            const unsigned* srow = (const unsigned*)(scr + (size_t)qi * SEQ); const int nw = (n + 1) >> 1;
#pragma unroll
            for (int k = 0; k < 4; ++k) HIST[lane + 64 * k] = 0u;
            LDS_WAIT();
            for (int w = lane; w < nw; w += 64) { const unsigned v = srow[w]; const unsigned k0 = key16(v & 0xffffu), k1 = key16(v >> 16);
                __hip_atomic_fetch_add(HIST + (k0 >> 8), 1u, __ATOMIC_RELAXED, __HIP_MEMORY_SCOPE_WORKGROUP);
                if (2 * w + 1 < n) __hip_atomic_fetch_add(HIST + (k1 >> 8), 1u, __ATOMIC_RELAXED, __HIP_MEMORY_SCOPE_WORKGROUP); }
            LDS_WAIT();
            unsigned b1, above1; radix_find(HIST, 256u, lane, b1, above1);
            const unsigned need1 = 256u - above1;
            LDS_WAIT();
#pragma unroll
            for (int k = 0; k < 4; ++k) HIST[lane + 64 * k] = 0u;
            LDS_WAIT();
            for (int w = lane; w < nw; w += 64) { const unsigned v = srow[w]; const unsigned k0 = key16(v & 0xffffu), k1 = key16(v >> 16);
                if ((k0 >> 8) == b1) __hip_atomic_fetch_add(HIST + (k0 & 255u), 1u, __ATOMIC_RELAXED, __HIP_MEMORY_SCOPE_WORKGROUP);
                if (2 * w + 1 < n && (k1 >> 8) == b1) __hip_atomic_fetch_add(HIST + (k1 & 255u), 1u, __ATOMIC_RELAXED, __HIP_MEMORY_SCOPE_WORKGROUP); }
            LDS_WAIT();
            unsigned b2, above2; radix_find(HIST, need1, lane, b2, above2);
            const unsigned need2 = need1 - above2, thr = (b1 << 8) | b2;
            unsigned cg = 0u, ce = 0u;
            for (int w0 = 0; w0 < nw; w0 += 64) { const int w = w0 + lane; const bool vw = w < nw; const unsigned v = vw ? srow[w] : 0u;
#pragma unroll
                for (int e = 0; e < 2; ++e) { const int idx = 2 * w + e; const bool valid = vw && idx < n; const unsigned key = key16(e ? (v >> 16) : (v & 0xffffu));
                    const bool gt = valid && key > thr, eq = valid && key == thr;
                    const unsigned long long mg = __ballot(gt), me = __ballot(eq);
                    if (gt) sel[cg + (unsigned)__popcll(mg & lt_mask)] = (unsigned short)idx;
                    if (eq) { const unsigned r = ce + (unsigned)__popcll(me & lt_mask); if (r < need2) sel[255u - r] = (unsigned short)idx; }
                    cg += (unsigned)__popcll(mg); ce += (unsigned)__popcll(me); } }
        }
        LDS_WAIT();
        bf16x8 qf[8];
        { const bf16_t* qrow = AO + m * 1536 + 512 + (fr & 3) * 256;
#pragma unroll
            for (int s = 0; s < 8; ++s) { bf16x8 v = *(const bf16x8*)(qrow + 32 * s + 8 * g); if (fr >= 4) v = (bf16x8){0, 0, 0, 0, 0, 0, 0, 0}; qf[s] = v; } }
        f32x4 O[16];
#pragma unroll
        for (int c = 0; c < 16; ++c) O[c] = (f32x4){0.f, 0.f, 0.f, 0.f};
        float mrun = -1e30f, lrun = 0.f;
        const int nchunk = (cnt + 31) >> 5;
        const unsigned img_base = (unsigned)(size_t)img;
#pragma unroll 1
        for (int ck = 0; ck < nchunk; ++ck) {
            unsigned oz; asm volatile("v_mov_b32 %0, 0" : "=v"(oz));
            const unsigned lz = (unsigned)lane + oz;
#pragma unroll
            for (int hh = 0; hh < 2; ++hh) {
                u32x4 gp[8];
#pragma unroll
                for (int i = 0; i < 8; ++i) { const unsigned piece = lz + 64u * (8 * hh + i), row = piece >> 5, ch = piece & 31u; const int slot = 32 * ck + (int)row; const unsigned key = (slot < cnt) ? sel[slot] : 0u;
                    gp[i] = *(const u32x4*)(ckv + (size_t)key * 256 + ch * 8); }
#pragma unroll
                for (int i = 0; i < 8; ++i) { const unsigned piece = lz + 64u * (8 * hh + i), row = piece >> 5, ch = piece & 31u;
                    *(LAS u32x4*)(img + (ch >> 4) * 8192u + img_off(row, ch & 15u)) = gp[i]; }
                asm volatile("" ::: "memory");
            }
            LDS_WAIT(); asm volatile("" ::: "memory");
            const unsigned frz = (unsigned)fr + oz, gz = (unsigned)g + oz;
            f32x4 sacc[2];
#pragma unroll
            for (int rb = 0; rb < 2; ++rb) { f32x4 acc = {0.f, 0.f, 0.f, 0.f};
#pragma unroll
                for (int s = 0; s < 8; ++s) acc = MFMA16(*(const LAS bf16x8*)(img + (s >> 2) * 8192 + img_off(frz + 16 * rb, 4 * (s & 3) + gz)), qf[s], acc);
                sacc[rb] = acc; }
            float lg[8]; float mx = -1e30f;
#pragma unroll
            for (int rb = 0; rb < 2; ++rb) { const u32x2 kk = *(const LAS u32x2*)(sel + 32 * ck + 16 * rb + 4 * g);
#pragma unroll
                for (int r = 0; r < 4; ++r) { const int slot = 32 * ck + 16 * rb + 4 * g + r; const unsigned kw = (r < 2) ? kk.x : kk.y; const int key = (r & 1) ? (int)(kw >> 16) : (int)(kw & 0xffffu);
                    int dist = t - key; dist = dist < 0 ? 0 : dist; const int bk = BK[dist];
                    float v = sacc[rb][r] + RB[bk * 4 + (fr & 3)]; if (slot >= cnt) v = -1e30f; if (fr >= 4) v = 0.f; lg[4 * rb + r] = v; mx = fmaxf(mx, v); } }
            mx = fmaxf(mx, __shfl_xor(mx, 16)); mx = fmaxf(mx, __shfl_xor(mx, 32));
            const float mnew = fmaxf(mrun, mx), alpha = __expf(mrun - mnew);
            float pv[8], ps = 0.f;
#pragma unroll
            for (int j = 0; j < 8; ++j) { pv[j] = __expf(lg[j] - mnew); ps += pv[j]; }
            lrun = lrun * alpha + ps; mrun = mnew;
            const bf16x8 pf = pk8((f32x4){pv[0], pv[1], pv[2], pv[3]}, (f32x4){pv[4], pv[5], pv[6], pv[7]});
            const unsigned q4 = frz >> 2, pp = frz & 3u;
#pragma unroll
            for (int c = 0; c < 16; ++c) {
                const unsigned a0 = img_base + (c >> 3) * 8192u + img_off(4u * gz + q4, 2u * (c & 7) + (pp >> 1)) + 8u * (pp & 1u);
                const unsigned a1 = img_base + (c >> 3) * 8192u + img_off(16u + 4u * gz + q4, 2u * (c & 7) + (pp >> 1)) + 8u * (pp & 1u);
                u32x2 r0, r1;
                asm volatile("ds_read_b64_tr_b16 %0, %2\n\tds_read_b64_tr_b16 %1, %3\n\ts_waitcnt lgkmcnt(0)" : "=&v"(r0), "=&v"(r1) : "v"(a0), "v"(a1) : "memory");
                f32x4 oc = O[c] * alpha;
                O[c] = MFMA16(mk8(r0, r1), pf, oc); }
        }
        lrun += __shfl_xor(lrun, 16); lrun += __shfl_xor(lrun, 32);
        const float inv = 1.f / lrun;
        if (fr < 4) { bf16_t* orow = AO + m * 1536 + 512 + fr * 256;
#pragma unroll
            for (int c = 0; c < 16; ++c) { const f32x4 v = O[c] * inv; u32x2 w; w.x = cvt_pk_bf16(v[0], v[1]); w.y = cvt_pk_bf16(v[2], v[3]); *(u32x2*)(orow + 16 * c + 4 * g) = w; } }
    }
    __syncthreads();
}

__device__ __forceinline__ float pack_idx(float v, unsigned idx, unsigned mask) { return __uint_as_float((__float_as_uint(v) & ~mask) | idx); }
__device__ __forceinline__ void ins16(float (&L)[16], float x) {
#pragma unroll
    for (int i = 15; i >= 1; --i) L[i] = __builtin_amdgcn_fmed3f(L[i - 1], L[i], x);
    L[0] = fmaxf(L[0], x);
}
__device__ __forceinline__ float dot2bf(unsigned a, unsigned b, float acc) { return __builtin_amdgcn_fdot2_f32_bf16(__builtin_bit_cast(bf16x2_t, a), __builtin_bit_cast(bf16x2_t, b), acc, false); }
__device__ __forceinline__ void p8_peer(const Params& p, LAS unsigned char* lds, int gw, int ngw, int wave, int lane) {
    unsigned char* ws = p.ws;
    const float* S = (const float*)(ws + WS_S); const float* rss = (const float*)(ws + WS_CTL + CTL_RSS);
    const bf16_t* UB = (const bf16_t*)(ws + WS_UB); const bf16_t* VB = (const bf16_t*)(ws + WS_VB); const bf16_t* X1B = (const bf16_t*)(ws + WS_X1B);
    LAS unsigned short* EI = (LAS unsigned short*)(lds + wave * 3072);
    LAS float* GT = (LAS float*)(lds + wave * 3072 + 1024);
    const int tq = lane >> 4, hs = lane & 15, head = hs >> 1, side = hs & 1;
#pragma unroll 1
    for (int grp = gw; grp < MT / 4; grp += ngw) {
        const size_t m0 = (size_t)grp * 4;
        {
            const size_t m = m0 + tq; const float* srow = S + m * 2048 + hs * 128;
            float L[16];
#pragma unroll
            for (int i = 0; i < 16; ++i) L[i] = -INFINITY;
#pragma unroll 4
            for (int j4 = 0; j4 < 32; ++j4) { const f32x4 v = ((const f32x4*)srow)[j4];
#pragma unroll
                for (int e = 0; e < 4; ++e) ins16(L, pack_idx(v[e], (unsigned)(4 * j4 + e), 0x7Fu)); }
            float A[16], B[16];
#pragma unroll
            for (int i = 0; i < 16; ++i) { const float o = __shfl_xor(L[i], 1); A[i] = side ? o : L[i]; B[i] = side ? L[i] : o; }
            float C[16];
#pragma unroll
            for (int i = 0; i < 16; ++i) C[i] = -INFINITY;
#pragma unroll
            for (int i = 0; i < 16; ++i)
#pragma unroll
                for (int j = 0; j < 16; ++j) if ((i + 1) * (j + 1) <= 16) {
                    const unsigned ab = __float_as_uint(A[i]), bb = __float_as_uint(B[j]);
                    const float sum = __uint_as_float(ab & ~0x7Fu) + __uint_as_float(bb & ~0x7Fu);
                    ins16(C, pack_idx(sum, ((ab & 0x7Fu) << 7) | (bb & 0x7Fu), 0x3FFFu)); }
            float tv[16]; unsigned ei[16]; float mx = -INFINITY;
#pragma unroll
            for (int k = 0; k < 16; ++k) { ei[k] = __float_as_uint(C[k]) & 0x3FFFu; tv[k] = S[m * 2048 + head * 256 + (ei[k] >> 7)] + S[m * 2048 + head * 256 + 128 + (ei[k] & 127u)]; mx = fmaxf(mx, tv[k]); }
            float z = 0.f;
#pragma unroll
            for (int k = 0; k < 16; ++k) { tv[k] = __expf(tv[k] - mx); z += tv[k]; }
            const float iz = 1.f / z;
#pragma unroll
            for (int k = 0; k < 16; ++k) { EI[tq * 128 + head * 16 + k] = (unsigned short)ei[k]; GT[tq * 128 + head * 16 + k] = tv[k] * iz; }
        }
        LDS_WAIT(); asm volatile("" ::: "memory");
#pragma unroll 1
        for (int t2 = 0; t2 < 4; ++t2) {
            const size_t mm = m0 + t2;
            const u32x4* xr = (const u32x4*)(X1B + mm * 1024); const u32x4 xa = xr[lane], xb = xr[64 + lane];
            const float rs = rsqrtf(rss[mm] * (1.f / DM) + EPS);
            float y[16];
#pragma unroll
            for (int i = 0; i < 16; ++i) y[i] = 0.f;
#pragma unroll 1
            for (int gi = 0; gi < 8; ++gi) {
                float part[16]; unsigned eid[16];
#pragma unroll
                for (int k = 0; k < 16; ++k) eid[k] = (unsigned)__builtin_amdgcn_readfirstlane((int)EI[t2 * 128 + gi * 16 + k]);
#pragma unroll
                for (int kh = 0; kh < 2; ++kh) {
#pragma unroll
                    for (int k8 = 0; k8 < 8; ++k8) { const int k = 8 * kh + k8;
                        const u32x4* ur = (const u32x4*)(UB + (size_t)eid[k] * 1024); const u32x4 ua = ur[lane], ub = ur[64 + lane];
                        float d = 0.f; d = dot2bf(ua.x, xa.x, d); d = dot2bf(ua.y, xa.y, d); d = dot2bf(ua.z, xa.z, d); d = dot2bf(ua.w, xa.w, d);
                        d = dot2bf(ub.x, xb.x, d); d = dot2bf(ub.y, xb.y, d); d = dot2bf(ub.z, xb.z, d); d = dot2bf(ub.w, xb.w, d); part[k] = d; }
                    asm volatile("" ::: "memory"); }
                float r8[8];
#pragma unroll
                for (int k = 0; k < 8; ++k) { const float mine = (lane & 32) ? part[k + 8] : part[k], theirs = (lane & 32) ? part[k] : part[k + 8]; r8[k] = mine + __shfl_xor(theirs, 32); }
                float r4[4];
#pragma unroll
                for (int k = 0; k < 4; ++k) { const float mine = (lane & 16) ? r8[k + 4] : r8[k], theirs = (lane & 16) ? r8[k] : r8[k + 4]; r4[k] = mine + __shfl_xor(theirs, 16); }
                float r2[2];
#pragma unroll
                for (int k = 0; k < 2; ++k) { const float mine = (lane & 8) ? r4[k + 2] : r4[k], theirs = (lane & 8) ? r4[k] : r4[k + 2]; r2[k] = mine + __shfl_xor(theirs, 8); }
                float r1; { const float mine = (lane & 4) ? r2[1] : r2[0], theirs = (lane & 4) ? r2[0] : r2[1]; r1 = mine + __shfl_xor(theirs, 4); }
                r1 += __shfl_xor(r1, 2); r1 += __shfl_xor(r1, 1);
                const int ke = ((lane >> 5) & 1) * 8 + ((lane >> 4) & 1) * 4 + ((lane >> 3) & 1) * 2 + ((lane >> 2) & 1);
                const float a = r1 * rs; const float act = 0.5f * a * (1.f + erff(a * 0.70710678118654752f));
                const float coef = GT[t2 * 128 + gi * 16 + ke] * act;
#pragma unroll
                for (int k = 0; k < 16; ++k) {
                    const int src = ((k >> 3) & 1) * 32 + ((k >> 2) & 1) * 16 + ((k >> 1) & 1) * 8 + (k & 1) * 4;
                    const float cf = __builtin_bit_cast(float, __builtin_amdgcn_readlane(__builtin_bit_cast(int, coef), src));
                    const u32x4* vr = (const u32x4*)(VB + (size_t)eid[k] * 1024); const u32x4 va = vr[lane], vb = vr[64 + lane];
                    y[0] = fmaf(cf, bf_lo(va.x), y[0]); y[1] = fmaf(cf, bf_hi(va.x), y[1]); y[2] = fmaf(cf, bf_lo(va.y), y[2]); y[3] = fmaf(cf, bf_hi(va.y), y[3]);
                    y[4] = fmaf(cf, bf_lo(va.z), y[4]); y[5] = fmaf(cf, bf_hi(va.z), y[5]); y[6] = fmaf(cf, bf_lo(va.w), y[6]); y[7] = fmaf(cf, bf_hi(va.w), y[7]);
                    y[8] = fmaf(cf, bf_lo(vb.x), y[8]); y[9] = fmaf(cf, bf_hi(vb.x), y[9]); y[10] = fmaf(cf, bf_lo(vb.y), y[10]); y[11] = fmaf(cf, bf_hi(vb.y), y[11]);
                    y[12] = fmaf(cf, bf_lo(vb.z), y[12]); y[13] = fmaf(cf, bf_hi(vb.z), y[13]); y[14] = fmaf(cf, bf_lo(vb.w), y[14]); y[15] = fmaf(cf, bf_hi(vb.w), y[15]);
                    if ((k & 7) == 7) asm volatile("" ::: "memory"); }
            }
            f32x4* orow = (f32x4*)(p.out + mm * 1024); const f32x4* fg = (const f32x4*)p.final_g;
            f32x4 o0 = orow[2 * lane], o1 = orow[2 * lane + 1], o2 = orow[128 + 2 * lane], o3 = orow[128 + 2 * lane + 1];
            o0 += (f32x4){y[0], y[1], y[2], y[3]}; o1 += (f32x4){y[4], y[5], y[6], y[7]}; o2 += (f32x4){y[8], y[9], y[10], y[11]}; o3 += (f32x4){y[12], y[13], y[14], y[15]};
            float ss = 0.f;
#pragma unroll
            for (int e = 0; e < 4; ++e) ss += o0[e] * o0[e] + o1[e] * o1[e] + o2[e] * o2[e] + o3[e] * o3[e];
            const float rf = rsqrtf(wave_sum(ss) * (1.f / DM) + EPS);
#ifdef PROBE_NAN
            {   const unsigned* fl = (const unsigned*)(ws + WS_CTL) + 1024;
                const int c2 = (fl[21] ? 1 : 0) | (fl[22] ? 2 : 0) | (fl[23] ? 4 : 0) | (fl[24] ? 8 : 0);
                f32x4 w0 = o0 * rf * fg[2 * lane], w1 = o1 * rf * fg[2 * lane + 1], w2 = o2 * rf * fg[128 + 2 * lane], w3 = o3 * rf * fg[128 + 2 * lane + 1];
#pragma unroll
                for (int e = 0; e < 4; ++e) { if (!(fabsf(w0[e]) < 1e30f)) w0[e] = 0.f; if (!(fabsf(w1[e]) < 1e30f)) w1[e] = 0.f; if (!(fabsf(w2[e]) < 1e30f)) w2[e] = 0.f; if (!(fabsf(w3[e]) < 1e30f)) w3[e] = 0.f; }
                if (mm == 0 && lane == 0) w0[0] = 10.f + 4.f * (float)c2;
                orow[2 * lane] = w0; orow[2 * lane + 1] = w1; orow[128 + 2 * lane] = w2; orow[128 + 2 * lane + 1] = w3; }
#else
            orow[2 * lane] = o0 * rf * fg[2 * lane]; orow[2 * lane + 1] = o1 * rf * fg[2 * lane + 1]; orow[128 + 2 * lane] = o2 * rf * fg[128 + 2 * lane]; orow[128 + 2 * lane + 1] = o3 * rf * fg[128 + 2 * lane + 1];
#endif
        }
        LDS_WAIT(); asm volatile("" ::: "memory");
    }
}


#ifdef PROBE_NAN
__device__ __attribute__((noinline)) void probe_scan(const unsigned char* base, unsigned nrows, unsigned row_bytes, unsigned col_off, unsigned col_bytes, bool f32, unsigned* flag) {
    const unsigned per_row = col_bytes / 16; bool bad = false;
    for (unsigned r = blockIdx.x; r < nrows; r += gridDim.x)
        for (unsigned c = threadIdx.x; c < per_row; c += NTHR) { const u32x4 v = *(const u32x4*)(base + (size_t)r * row_bytes + col_off + c * 16);
#pragma unroll
            for (int e = 0; e < 4; ++e) { const unsigned w = v[e]; if (f32) bad |= ((w & 0x7F800000u) == 0x7F800000u); else bad |= ((w & 0x7F80u) == 0x7F80u) || ((w & 0x7F800000u) == 0x7F800000u); } }
    if (bad) atomicOr(flag, 1u);
}
#define PSCAN(idx, off, nrows, rowb, coff, cb, f32) probe_scan(ws + (off), (nrows), (rowb), (coff), (cb), (f32), ctl + 1024 + (idx))
#else
#define PSCAN(idx, off, nrows, rowb, coff, cb, f32) do {} while (0)
#endif
__global__ void __launch_bounds__(NTHR, 2) hybrid_fwd(Params p) {
    extern __shared__ __attribute__((aligned(16))) unsigned char lds_raw[];
    LAS unsigned char* lds = (LAS unsigned char*)lds_raw;
    volatile LAS unsigned* MISCW = (volatile LAS unsigned*)(lds + LDS_MISC);
#define PHASE_IDS int tid = threadIdx.x; asm volatile("" : "+v"(tid)); const int lane = tid & 63, wave = __builtin_amdgcn_readfirstlane(tid >> 6); \
    const int gw = bx * NWAVES + wave, ngw = G * NWAVES; (void)lane; (void)gw; (void)ngw;
    const int G = gridDim.x, bx = blockIdx.x;
    unsigned char* ws = p.ws;
    const int tid0 = threadIdx.x;
    unsigned* ctl = (unsigned*)(ws + WS_CTL);
    if (tid0 < 16) MISCW[tid0] = 0u;
    __syncthreads();
    XcdBarrier bar = xcd_barrier_post(ctl + CW_BAR, MISCW);

    { PHASE_IDS p0_prologue(p, lds, gw, ngw, wave, lane); }
    xcd_barrier(bar);
    PSCAN(1, WS_WINT, (unsigned)(((size_t)2816*2048) / 4096), 4096, 0, 4096, false); PSCAN(2, WS_WQ2T, (unsigned)((2048*512) / 4096), 4096, 0, 4096, false); PSCAN(3, WS_WOUT2T, (unsigned)((1024*3072) / 4096), 4096, 0, 4096, false); PSCAN(4, WS_WQST, (unsigned)((2048*2048) / 4096), 4096, 0, 4096, false); PSCAN(5, WS_HB, MT, 2048, 0, 2048, false);
    { pg8::Gemm g{(const bf16_t*)(ws + WS_HB), (const bf16_t*)(ws + WS_WINT), MT, NIN, DM}; pg8::StaticOrder So; So.init(MT, NIN, G, bx); EpiIn E{ws};
      pg8::gemm_phase<EpiIn, pg8::StaticOrder, false>(lds, g, So, E, nullptr); }
    xcd_barrier(bar);
    PSCAN(6, WS_QKV, MT, 3072, 0, 3072, false); PSCAN(7, WS_ZB, MT, 1024, 0, 1024, false); PSCAN(8, WS_CQ, MT, 512, 0, 512, false); PSCAN(9, WS_CKV, MT, 512, 0, 512, false); PSCAN(10, WS_MISC, MT, 512, 0, 512, true);
    { PHASE_IDS for (int m = gw; m < MT; m += ngw) p3_token(p, m, lane); }
    xcd_barrier(bar);
    PSCAN(11, WS_QH, (unsigned)(((size_t)96*MiB) / 4096), 4096, 0, 4096, false); PSCAN(12, WS_GARR, (unsigned)((2*MiB) / 4096), 4096, 0, 4096, true); PSCAN(13, WS_KIDXN, (unsigned)((4*MiB) / 4096), 4096, 0, 4096, false); PSCAN(13, WS_WIDX, (unsigned)((2*MiB) / 4096), 4096, 0, 4096, true); PSCAN(8, WS_CQ, MT, 512, 0, 512, false); PSCAN(9, WS_CKV, MT, 512, 0, 512, false);
    { pg8::Gemm g{(const bf16_t*)(ws + WS_CQ), (const bf16_t*)(ws + WS_WQ2T), MT, 2048, 256}; pg8::StaticOrder So; So.init(MT, 2048, G, bx); EpiQ E{ws};
      pg8::gemm_phase<EpiQ, pg8::StaticOrder, false>(lds, g, So, E, nullptr); }
    __syncthreads();
    { PHASE_IDS for (int cb = bx; cb < 16 * NCHUNK; cb += G) g2_chunk(p, lds, cb, tid, wave, lane); }
    xcd_barrier(bar);
    PSCAN(14, WS_AOUT, MT, 3072, 1024, 2048, false); PSCAN(14, WS_QIDX, MT, 2048, 0, 2048, false); PSCAN(15, WS_WBUF, (unsigned)((32*MiB) / 4096), 4096, 0, 4096, false); PSCAN(16, WS_ATTN, (unsigned)((16*MiB) / 4096), 4096, 0, 4096, false); PSCAN(17, WS_QH, (unsigned)((32*MiB) / 4096), 4096, 0, 4096, false); PSCAN(18, WS_KH, (unsigned)((32*MiB) / 4096), 4096, 0, 4096, false); PSCAN(19, WS_VH, (unsigned)((32*MiB) / 4096), 4096, 0, 4096, false); PSCAN(20, WS_GAMMA, 2, 4096, 0, 4096, true);
    xcd_barrier(bar);
    if (bx < 16) { PHASE_IDS g3_scan(p, lds, bx, wave, lane); __syncthreads(); }
    { PHASE_IDS
    dsa_tables(p, lds, tid);
    for (;;) {
        if (tid == 0) MISCW[2] = __hip_atomic_fetch_add(ctl + CW_QUEUE, 1u, __ATOMIC_RELAXED, __HIP_MEMORY_SCOPE_AGENT);
        __syncthreads();
        const unsigned u = MISCW[2];
        __syncthreads();
        if (u >= 2048u) break;
        dsa_unit(p, lds, (int)(u & 3u), 511 - (int)(u >> 2));
    } }
    xcd_barrier(bar);
    PSCAN(21, WS_AOUT, MT, 3072, 0, 1024, false); PSCAN(22, WS_AOUT, MT, 3072, 1024, 2048, false);
    {
        PHASE_IDS
        const size_t NG = (size_t)16384 * 1024 / 8;
        for (size_t i = (size_t)bx * NTHR + tid; i < NG; i += (size_t)G * NTHR) {
            const f32x4 a = ((const f32x4*)p.peer_u)[2 * i], b = ((const f32x4*)p.peer_u)[2 * i + 1]; const int col = (int)((8 * i) & 1023);
            const f32x4 g0 = ((const f32x4*)p.ln2_g)[col >> 2], g1 = ((const f32x4*)p.ln2_g)[(col >> 2) + 1];
            u32x4 o; o.x = cvt_pk_bf16(a[0] * g0[0], a[1] * g0[1]); o.y = cvt_pk_bf16(a[2] * g0[2], a[3] * g0[3]); o.z = cvt_pk_bf16(b[0] * g1[0], b[1] * g1[1]); o.w = cvt_pk_bf16(b[2] * g1[2], b[3] * g1[3]);
            ((u32x4*)(ws + WS_UB))[i] = o;
            const f32x4 c = ((const f32x4*)p.peer_v)[2 * i], d = ((const f32x4*)p.peer_v)[2 * i + 1];
            u32x4 o2; o2.x = cvt_pk_bf16(c[0], c[1]); o2.y = cvt_pk_bf16(c[2], c[3]); o2.z = cvt_pk_bf16(d[0], d[1]); o2.w = cvt_pk_bf16(d[2], d[3]);
            ((u32x4*)(ws + WS_VB))[i] = o2;
        }
        __syncthreads();
        pg8::Gemm g{(const bf16_t*)(ws + WS_AOUT), (const bf16_t*)(ws + WS_WOUT2T), MT, DM, 1536}; pg8::StaticOrder So; So.init(MT, DM, G, bx);
        EpiOut E{p.x, p.out, (bf16_t*)(ws + WS_X1B), (float*)(ws + WS_CTL + CTL_RSS)};
        pg8::gemm_phase<EpiOut, pg8::StaticOrder, false>(lds, g, So, E, nullptr);
    }
    xcd_barrier(bar);
    PSCAN(23, WS_X1B, MT, 2048, 0, 2048, false); PSCAN(23, WS_CTL + CTL_RSS, (unsigned)((131072) / 4096), 4096, 0, 4096, true);
    { pg8::Gemm g{(const bf16_t*)(ws + WS_X1B), (const bf16_t*)(ws + WS_WQST), MT, 2048, DM}; pg8::StaticOrder So; So.init(MT, 2048, G, bx);
      EpiS E{(float*)(ws + WS_S), (const float*)(ws + WS_CTL + CTL_RSS)};
      pg8::gemm_phase<EpiS, pg8::StaticOrder, false>(lds, g, So, E, nullptr); }
    xcd_barrier(bar);
    PSCAN(24, WS_S, MT, 8192, 0, 8192, true);
    xcd_barrier(bar);
    { PHASE_IDS p8_peer(p, lds, gw, ngw, wave, lane); }
}

extern "C" void kernel_launch(void* const* d_in, const int* in_sizes, int n_in, void* d_out, int out_size, void* d_ws, size_t ws_size, hipStream_t stream) {
    static int grid = 0;
    if (grid == 0) {
        if (n_in != 23 || in_sizes[0] != MT * DM || out_size != MT * DM || ws_size < WS_END) {
            fprintf(stderr, "kernel_launch: unexpected problem shape (n_in %d, in0 %d, out %d, ws %zu); nothing launched\n", n_in, n_in > 0 ? in_sizes[0] : -1, out_size, ws_size); grid = -1; return; }
        int dev = 0, cus = 0, per_cu = 0;
        if (hipGetDevice(&dev) != hipSuccess || hipDeviceGetAttribute(&cus, hipDeviceAttributeMultiprocessorCount, dev) != hipSuccess) { grid = -1; return; }
        if (hipFuncSetAttribute((const void*)hybrid_fwd, hipFuncAttributeMaxDynamicSharedMemorySize, LDS_BYTES) != hipSuccess) { fprintf(stderr, "kernel_launch: hipFuncSetAttribute failed\n"); grid = -1; return; }
        if (hipOccupancyMaxActiveBlocksPerMultiprocessor(&per_cu, (const void*)hybrid_fwd, NTHR, LDS_BYTES) != hipSuccess || per_cu < 1) { fprintf(stderr, "kernel_launch: occupancy query says %d\n", per_cu); }
        (void)hipGetLastError();
        grid = cus;
    }
    if (grid < 0) return;
    (void)hipMemsetAsync((char*)d_ws + WS_CTL, 0, CTL_BYTES, stream);
    Params p{};
    const float** pp = (const float**)&p;
    for (int i = 0; i < 23; ++i) pp[i] = (const float*)d_in[i];
    p.out = (float*)d_out; p.ws = (unsigned char*)d_ws;
    hipLaunchKernelGGL(hybrid_fwd, dim3(grid), dim3(NTHR), LDS_BYTES, stream, p);
}
```

```cpp
#include <hip/hip_runtime.h>
#include <cstdio>
#include <cstdint>

#define LAS __attribute__((address_space(3)))
#define CAS __attribute__((address_space(4)))
typedef unsigned short bf16_t;
typedef short bf16x8 __attribute__((ext_vector_type(8)));
typedef float f32x4 __attribute__((ext_vector_type(4)));
typedef float f32x2 __attribute__((ext_vector_type(2)));
typedef unsigned u32x4 __attribute__((ext_vector_type(4)));
typedef unsigned u32x2 __attribute__((ext_vector_type(2)));
typedef __bf16 bf16x2_t __attribute__((ext_vector_type(2)));
typedef _Float16 h2_t __attribute__((ext_vector_type(2)));
typedef unsigned u32x3a __attribute__((ext_vector_type(3), aligned(4)));
typedef unsigned u32x6 __attribute__((ext_vector_type(6)));
typedef _Float16 h32_t __attribute__((ext_vector_type(32)));

constexpr int BATCH = 4, SEQ = 8192, DM = 1024, MT = BATCH * SEQ;
constexpr int IN_W = 2648, NIN = 2816;
constexpr int NCHUNK = SEQ / 64;
constexpr float EPS = 1e-6f;
constexpr int NWAVES = 8, NTHR = 512;

constexpr size_t MiB = 1u << 20;
constexpr size_t WS_CTL = 0, CTL_BYTES = 1 * MiB;
constexpr size_t WS_WINT = 1 * MiB;
constexpr size_t WS_WQ2T = 7 * MiB;
constexpr size_t WS_WOUT2T = 8 * MiB;
constexpr size_t WS_WQST = 11 * MiB;
constexpr size_t WS_GAMMA = 15 * MiB;
constexpr size_t WS_UB = 368 * MiB;
constexpr size_t WS_VB = 384 * MiB;
constexpr size_t WS_SUV = 400 * MiB;
constexpr size_t WS_SCR = 16 * MiB;
constexpr size_t WS_HB = 80 * MiB;
constexpr size_t WS_KIDXN = 80 * MiB;
constexpr size_t WS_WIDX = 84 * MiB;
constexpr size_t WS_GARR = 86 * MiB;
constexpr size_t WS_BARR = 87 * MiB;
constexpr size_t WS_ATTN = 88 * MiB;
constexpr size_t WS_CKV8 = 104 * MiB;
constexpr size_t WS_REF = 15 * MiB + 65536;
constexpr size_t WS_RES = 15 * MiB + 32768;
constexpr size_t WS_X1B = 80 * MiB;
constexpr size_t WS_AOUT = 144 * MiB;
constexpr size_t WS_QKV = 240 * MiB;
constexpr size_t WS_QIDX = 240 * MiB;
constexpr size_t WS_WBUF = 304 * MiB;
constexpr size_t WS_ZB = 336 * MiB;
constexpr size_t WS_CQ = 368 * MiB;
constexpr size_t WS_CKV = 384 * MiB;
constexpr size_t WS_MISC = 400 * MiB;
constexpr size_t WS_QH = 416 * MiB;
constexpr size_t WS_KH = 448 * MiB;
constexpr size_t WS_VH = 480 * MiB;
constexpr size_t WS_S = 144 * MiB;
constexpr size_t WS_END = 512 * MiB;
constexpr int CW_QUEUE = 64;
constexpr int CW_BAR = 4096;
constexpr size_t CTL_RSS = 256 * 1024;

constexpr int LDS_BYTES = 160 * 1024;
constexpr int LDS_MISC = LDS_BYTES - 256;

__device__ __forceinline__ unsigned cvt_pk_bf16(float lo, float hi) { const f32x2 v = {lo, hi}; return __builtin_bit_cast(unsigned, __builtin_convertvector(v, bf16x2_t)); }
__device__ __forceinline__ float bf_lo(unsigned w) { return __uint_as_float(w << 16); }
__device__ __forceinline__ float bf_hi(unsigned w) { return __uint_as_float(w & 0xffff0000u); }
__device__ __forceinline__ float bf2f(bf16_t b) { return __uint_as_float(((unsigned)b) << 16); }
__device__ __forceinline__ bf16_t f2bf(float f) { return (bf16_t)(cvt_pk_bf16(f, 0.f) & 0xffffu); }
template <int CTRL> __device__ __forceinline__ float dpp_mov(float v) { return __builtin_bit_cast(float, __builtin_amdgcn_update_dpp(0, __builtin_bit_cast(int, v), CTRL, 0xF, 0xF, true)); }
__device__ __forceinline__ float row16_sum(float s) {
    s += dpp_mov<0xB1>(s); s += dpp_mov<0x4E>(s); s += dpp_mov<0x141>(s); s += dpp_mov<0x140>(s); return s; }
__device__ __forceinline__ float rl_f(float v, int l) { return __builtin_bit_cast(float, __builtin_amdgcn_readlane(__builtin_bit_cast(int, v), l)); }
__device__ __forceinline__ float wave_sum(float v) { v = row16_sum(v); return (rl_f(v, 0) + rl_f(v, 16)) + (rl_f(v, 32) + rl_f(v, 48)); }
__device__ __forceinline__ float silu_f(float x) { return x * __builtin_amdgcn_rcpf(1.f + __expf(-x)); }
#define LDS_WAIT() asm volatile("s_waitcnt lgkmcnt(0)" ::: "memory")
#define VM_WAIT() asm volatile("s_waitcnt vmcnt(0)" ::: "memory")
__device__ __forceinline__ bf16x8 mk8(u32x2 lo, u32x2 hi) { u32x4 t; t.x = lo.x; t.y = lo.y; t.z = hi.x; t.w = hi.y; return __builtin_bit_cast(bf16x8, t); }
__device__ __forceinline__ bf16x8 pk8(f32x4 a, f32x4 b) { u32x4 t; t.x = cvt_pk_bf16(a[0], a[1]); t.y = cvt_pk_bf16(a[2], a[3]); t.z = cvt_pk_bf16(b[0], b[1]); t.w = cvt_pk_bf16(b[2], b[3]); return __builtin_bit_cast(bf16x8, t); }
__device__ __forceinline__ bf16x8 pk8lo(f32x4 a, f32x4 b, bf16x8 hi) { const u32x4 h = __builtin_bit_cast(u32x4, hi); f32x4 ra, rb;
    ra[0] = a[0] - bf_lo(h.x); ra[1] = a[1] - bf_hi(h.x); ra[2] = a[2] - bf_lo(h.y); ra[3] = a[3] - bf_hi(h.y);
    rb[0] = b[0] - bf_lo(h.z); rb[1] = b[1] - bf_hi(h.z); rb[2] = b[2] - bf_lo(h.w); rb[3] = b[3] - bf_hi(h.w); return pk8(ra, rb); }
#define MFMA16(a, b, c) __builtin_amdgcn_mfma_f32_16x16x32_bf16((a), (b), (c), 0, 0, 0)

#define XB_TMO      128
#define XB_XCNT(j)  (256  + 64 * (j))
#define XB_XSUB(j)  (1280 + 64 * (j))
#define XB_XGEN(j)  (2304 + 64 * (j))
#define XB_TOP      3328
#define XB_TOPGEN   3392
#define XCD_BAR_WORDS 3456
#define XB_SPIN_CAP (1u << 23)
__device__ __forceinline__ unsigned xb_ld(unsigned* p)              { return __hip_atomic_load(p, __ATOMIC_RELAXED, __HIP_MEMORY_SCOPE_AGENT); }
__device__ __forceinline__ unsigned xb_add(unsigned* p, unsigned v) { return __hip_atomic_fetch_add(p, v, __ATOMIC_RELAXED, __HIP_MEMORY_SCOPE_AGENT); }
__device__ __forceinline__ unsigned xb_xcc_id() { return (unsigned)__builtin_amdgcn_s_getreg((3 << 11) | 20) & 0xFu; }
#define XB_SPIN(cond, bar) do { unsigned _sp = 0; while (cond) { __builtin_amdgcn_s_sleep(1); \
    if ((++_sp & 255u) == 0u) { if (xb_ld(&(bar)[XB_TMO])) break; if (_sp > XB_SPIN_CAP) { atomicAdd(&(bar)[XB_TMO], 1u); break; } } } } while (0)
struct XcdBarrier { unsigned* bar; unsigned x; volatile LAS unsigned* st; };
__device__ __forceinline__ XcdBarrier xcd_barrier_post(unsigned* bar, volatile LAS unsigned* st) {
    XcdBarrier b; b.bar = bar; b.x = xb_xcc_id(); b.st = st;
    if (threadIdx.x == 0) (void)xb_add(&bar[XB_XCNT(b.x)], 1u);
    return b;
}
__device__ __forceinline__ void xcd_barrier_complete(unsigned* bar, unsigned x, unsigned& nloc, unsigned& nx) {
    const unsigned G = gridDim.x * gridDim.y * gridDim.z;
    unsigned sum, cnt, mine, sp = 0u;
    for (;;) {
        sum = 0u; cnt = 0u; mine = 0u;
#pragma unroll
        for (unsigned j = 0; j < 16; ++j) { const unsigned c = xb_ld(&bar[XB_XCNT(j)]); sum += c; cnt += (c > 0u) ? 1u : 0u; mine = (j == x) ? c : mine; }
        if (sum == G) break;
        __builtin_amdgcn_s_sleep(1);
        if ((++sp & 255u) == 0u) { if (xb_ld(&bar[XB_TMO])) break; if (sp > XB_SPIN_CAP) { atomicAdd(&bar[XB_TMO], 1u); break; } }
    }
    nloc = mine > 0u ? mine : 1u; nx = cnt > 0u ? cnt : 1u;
}
__device__ __forceinline__ void xcd_barrier(const XcdBarrier& b) {
    asm volatile("s_waitcnt vmcnt(0)" ::: "memory");
    __syncthreads();
    if (threadIdx.x == 0) {
        unsigned* bar = b.bar;
        __builtin_amdgcn_s_waitcnt(0);
        unsigned nloc = b.st[0], nx = b.st[1];
        if (nloc == 0u) { xcd_barrier_complete(bar, b.x, nloc, nx); b.st[0] = nloc; b.st[1] = nx; }
        const unsigned old = xb_add(&bar[XB_XSUB(b.x)], 1u);
        const unsigned gen = old / nloc;
        if (old + 1u == (gen + 1u) * nloc) {
            __builtin_amdgcn_fence(__ATOMIC_RELEASE, "agent");
            asm volatile("s_waitcnt vmcnt(0)" ::: "memory");
            const unsigned og = xb_add(&bar[XB_TOP], 1u);
            const unsigned tg = og / nx;
            if (og + 1u == (tg + 1u) * nx) xb_add(&bar[XB_TOPGEN], 1u);
            else XB_SPIN(xb_ld(&bar[XB_TOPGEN]) == tg, bar);
            __builtin_amdgcn_fence(__ATOMIC_ACQUIRE, "agent");
            xb_add(&bar[XB_XGEN(b.x)], 1u);
            asm volatile("s_waitcnt vmcnt(0)" ::: "memory");
        } else {
            XB_SPIN(xb_ld(&bar[XB_XGEN(b.x)]) == gen, bar);
            __builtin_amdgcn_fence(__ATOMIC_ACQUIRE, "agent");
            asm volatile("s_waitcnt vmcnt(0)" ::: "memory");
        }
    }
    __syncthreads();
}

__device__ __forceinline__ void xcd_local_sync(const XcdBarrier& b, unsigned k) {
    __syncthreads();
    if (threadIdx.x == 0) {
        unsigned* c = b.bar + (8192 - 4096) + 64 * b.x;
        const unsigned nloc = b.st[0];
        (void)xb_add(c, 1u);
        const unsigned target = k * nloc;
        XB_SPIN(xb_ld(c) < target, b.bar);
    }
    __syncthreads();
}

struct Params {
    const float *x, *ln1_g, *w_in, *conv_w, *a_log, *dt_bias, *gdn_norm_g, *q_norm_g, *kv_norm_g, *w_q_up, *w_qidx_up, *w_kv_up,
                *idx_ln_g, *idx_ln_b, *w_out, *ln2_g, *peer_wq, *peer_k1, *peer_k2, *peer_u, *peer_v, *rel_bias, *final_g;
    float* out; unsigned char* ws;
};

namespace pg8 {
#define PG8_LAS __attribute__((address_space(3)))
typedef unsigned short bf16_t;
typedef short bf16x8 __attribute__((ext_vector_type(8)));
typedef float f32x4 __attribute__((ext_vector_type(4)));
typedef unsigned u32x4 __attribute__((ext_vector_type(4)));
constexpr int BM = 256, BK = 64, HALF = 128, HTB = HALF * BK * 2  , STAGE_BYTES = 8 * HTB, NXCD = 8, WGM = 8;

__host__ __device__ __forceinline__ int lds_byte(int r, int c) { const int st = (r >> 4) * 2 + (c >> 5), rr = r & 15, cc = c & 31, ob = rr * 64 + cc * 2; return st * 1024 + (ob ^ (((ob >> 9) & 1) << 5)); }
__host__ __device__ __forceinline__ void stage_rc(int b, int& R, int& C) { const int st = b / 1024, sb = b % 1024, swz = sb ^ (((sb >> 9) & 1) << 5); R = (st >> 1) * 16 + swz / 64; C = (st & 1) * 32 + (swz % 64) / 2; }
__host__ __device__ __forceinline__ int perm32(int rho) { const int n = rho >> 4, i = rho & 15; return 8 * (i >> 2) + 4 * n + (i & 3); }

struct Unit { int pm, pn; };
struct Gemm { const bf16_t* A; const bf16_t* Bt; int M, N, K; };

struct StaticOrder {
    int nM, nN, nwg, G, c;
    __host__ __device__ void init(int M, int N, int G_, int c_) { nM = M / BM; nN = N / BM; nwg = nM * nN; G = G_; c = c_; }
    __host__ __device__ bool next(int i, Unit& u) const {
        const long L = (long)i * G + c; if (L >= nwg) return false;
        int wgid = (int)L; { const int q = nwg / NXCD, r = nwg % NXCD, xcd = wgid % NXCD, off = wgid / NXCD; wgid = (xcd < r ? xcd * (q + 1) : r * (q + 1) + (xcd - r) * q) + off; }
        const int nig = WGM * nN, gid = wgid / nig, fm = gid * WGM, gsz = (nM - fm) < WGM ? (nM - fm) : WGM;
        u.pm = fm + ((wgid % nig) % gsz); u.pn = (wgid % nig) / gsz; return true;
    }
    __device__ __forceinline__ void a_ready(const Unit&) const {}
    __device__ __forceinline__ void done(const Unit&) const {}
};
template <class Epi, class Sched, bool STAMP = false>
__device__ __forceinline__ void gemm_phase(PG8_LAS unsigned char* lds, const Gemm g, const Sched& S, const Epi& E, unsigned long long* stamps) {
    int tid_o = threadIdx.x; asm volatile("" : "+v"(tid_o));
    const int tid = tid_o, wid = __builtin_amdgcn_readfirstlane(tid >> 6), lane = tid & 63, wr = wid >> 2, wc = wid & 3, fr = lane & 15, fq = lane >> 4;
    const int K = g.K, nt = K / BK;
    int ts_lo = 0, ts_hi = 0, nts = 0; const unsigned long long rt_entry = STAMP ? (unsigned long long)wall_clock64() : 0ull;
#define PG8_STAMP() do { if (STAMP && wid == 0 && nts < 64) { const unsigned long long _c = (unsigned long long)clock64(); \
        ts_lo = (lane == nts) ? (int)(unsigned)_c : ts_lo; ts_hi = (lane == nts) ? (int)(unsigned)(_c >> 32) : ts_hi; ++nts; } } while (0)
    PG8_STAMP();
    unsigned voffA[2], voffB[2];
#pragma unroll
    for (int i = 0; i < 2; ++i) { int R, C; stage_rc(tid * 16 + i * 8192, R, C); const int Rb = Epi::PERM ? ((R & ~31) + perm32(R & 31)) : R;
        voffA[i] = (unsigned)(R * K + C) * 2u; voffB[i] = (unsigned)(Rb * K + C) * 2u; }
    const size_t kstep = (size_t)(BK * 2);
    const size_t hstep = (size_t)HALF * K * 2;
    const size_t tstep = 2 * hstep;
    const unsigned ldsw = (unsigned)wid * 1024u;
    const int aoff = lds_byte(wr * 64 + fr, fq * 8), boff = lds_byte(wc * 32 + fr, fq * 8);
#define PG8_SA(b, h) (((b) * 2 + (h)) * HTB)
#define PG8_SB(b, h) ((4 + (b) * 2 + (h)) * HTB)
#define PG8_STAGE(bufoff, gbase, voff) do { _Pragma("unroll") for (int _i = 0; _i < 2; ++_i) \
        __builtin_amdgcn_global_load_lds((const unsigned*)((const char*)(gbase) + (voff)[_i]), (PG8_LAS unsigned*)(lds + (bufoff) + ldsw + _i * 8192), 16, 0, 0); } while (0)
#define PG8_LDA(dst, b, h) do { _Pragma("unroll") for (int m = 0; m < 4; ++m) _Pragma("unroll") for (int k = 0; k < 2; ++k) dst[m][k] = *(const PG8_LAS bf16x8*)(lds + PG8_SA(b, h) + aoff + m * 2048 + k * 1024); } while (0)
#define PG8_LDB(dst, b, h) do { _Pragma("unroll") for (int n = 0; n < 2; ++n) _Pragma("unroll") for (int k = 0; k < 2; ++k) dst[n][k] = *(const PG8_LAS bf16x8*)(lds + PG8_SB(b, h) + boff + n * 2048 + k * 1024); } while (0)
#define PG8_MMA(ai, bj, At, Bt) do { __builtin_amdgcn_s_setprio(1); _Pragma("unroll") for (int m = 0; m < 4; ++m) _Pragma("unroll") for (int n = 0; n < 2; ++n) _Pragma("unroll") for (int k = 0; k < 2; ++k) \
        acc[ai][bj][m][n] = __builtin_amdgcn_mfma_f32_16x16x32_bf16(Bt[n][k], At[m][k], acc[ai][bj][m][n], 0, 0, 0); __builtin_amdgcn_s_setprio(0); } while (0)
#define PG8_WAIT_V(n) asm volatile("s_waitcnt vmcnt(" #n ")" ::: "memory")
#define PG8_WAIT_L(n) asm volatile("s_waitcnt lgkmcnt(" #n ")" ::: "memory")
#define PG8_BAR __builtin_amdgcn_s_barrier()
#define PG8_SCHED __builtin_amdgcn_sched_barrier(0)
    Unit cur, nxt; int ui = 0;
    if (!S.next(0, cur)) return;
    f32x4 acc[2][2][4][2];
#pragma unroll
    for (int a = 0; a < 2; ++a)
#pragma unroll
        for (int b = 0; b < 2; ++b)
#pragma unroll
            for (int m = 0; m < 4; ++m)
#pragma unroll
                for (int n = 0; n < 2; ++n) acc[a][b][m][n] = (f32x4){0.f, 0.f, 0.f, 0.f};
    bf16x8 At[4][2], B0[2][2], B1[2][2];
    const char* cA = (const char*)g.A + (size_t)cur.pm * tstep; const char* cB = (const char*)g.Bt + (size_t)cur.pn * tstep;
    S.a_ready(cur);
    PG8_STAGE(PG8_SB(0, 0), cB, voffB); PG8_STAGE(PG8_SA(0, 0), cA, voffA); PG8_STAGE(PG8_SB(0, 1), cB + hstep, voffB); PG8_STAGE(PG8_SA(0, 1), cA + hstep, voffA);
    if (wr == 1) PG8_BAR;
    PG8_WAIT_V(4); PG8_BAR;
    PG8_STAGE(PG8_SB(1, 0), cB + kstep, voffB); PG8_STAGE(PG8_SA(1, 0), cA + kstep, voffA); PG8_STAGE(PG8_SB(1, 1), cB + hstep + kstep, voffB);
    PG8_WAIT_V(6); PG8_BAR;
    PG8_STAMP();
    for (;;) {
        const bool has_next = S.next(ui + 1, nxt);
        const char* nA = has_next ? (const char*)g.A + (size_t)nxt.pm * tstep : cA; const char* nB = has_next ? (const char*)g.Bt + (size_t)nxt.pn * tstep : cB;
        for (int t = 0; t < nt; t += 2) {
            const bool last = (t == nt - 2);
            const char* a1 = cA + (size_t)(t + 1) * kstep;
            const char* a2 = last ? nA : cA + (size_t)(t + 2) * kstep; const char* b2 = last ? nB : cB + (size_t)(t + 2) * kstep;
            const char* a3 = a2 + kstep; const char* b3 = b2 + kstep;
            if (last && has_next) S.a_ready(nxt);
            PG8_LDB(B0, 0, 0); PG8_SCHED; PG8_LDA(At, 0, 0); PG8_STAGE(PG8_SA(1, 1), a1 + hstep, voffA);
            PG8_WAIT_L(8); PG8_BAR; PG8_WAIT_L(0); PG8_MMA(0, 0, At, B0); PG8_BAR; PG8_SCHED;
            PG8_LDB(B1, 0, 1); PG8_STAGE(PG8_SB(0, 0), b2, voffB);
            PG8_BAR; PG8_WAIT_L(0); PG8_MMA(0, 1, At, B1); PG8_BAR;
            PG8_LDA(At, 0, 1); PG8_STAGE(PG8_SA(0, 0), a2, voffA);
            PG8_BAR; PG8_WAIT_L(0); PG8_MMA(1, 0, At, B0); PG8_BAR; PG8_SCHED;
            PG8_STAGE(PG8_SB(0, 1), b2 + hstep, voffB);
            PG8_WAIT_V(6); PG8_BAR; PG8_MMA(1, 1, At, B1); PG8_BAR;
            PG8_LDB(B0, 1, 0); PG8_SCHED; PG8_LDA(At, 1, 0); PG8_STAGE(PG8_SA(0, 1), a2 + hstep, voffA);
            PG8_WAIT_L(8); PG8_BAR; PG8_WAIT_L(0); PG8_MMA(0, 0, At, B0); PG8_BAR; PG8_SCHED;
            PG8_LDB(B1, 1, 1); PG8_STAGE(PG8_SB(1, 0), b3, voffB);
            PG8_BAR; PG8_WAIT_L(0); PG8_MMA(0, 1, At, B1); PG8_BAR;
            PG8_LDA(At, 1, 1); PG8_STAGE(PG8_SA(1, 0), a3, voffA);
            PG8_BAR; PG8_WAIT_L(0); PG8_MMA(1, 0, At, B0); PG8_BAR; PG8_SCHED;
            PG8_STAGE(PG8_SB(1, 1), b3 + hstep, voffB);
            PG8_WAIT_V(6); PG8_BAR; PG8_MMA(1, 1, At, B1); PG8_BAR;
        }
        PG8_STAMP();
        if constexpr (!Epi::AFTER_DRAIN) { E(acc, cur, wr, wc, fr, fq); S.done(cur); }
        PG8_STAMP();
        if (!has_next) break;
#pragma unroll
        for (int a = 0; a < 2; ++a)
#pragma unroll
            for (int b = 0; b < 2; ++b)
#pragma unroll
                for (int m = 0; m < 4; ++m)
#pragma unroll
                    for (int n = 0; n < 2; ++n) acc[a][b][m][n] = (f32x4){0.f, 0.f, 0.f, 0.f};
        cur = nxt; cA = nA; cB = nB; ++ui;
    }
    PG8_WAIT_V(0);
    if (wr == 0) PG8_BAR;
    PG8_BAR;
    if constexpr (Epi::AFTER_DRAIN) { E.fused(acc, cur, wr, wc, fr, fq, lds, wid, lane); S.done(cur); }
    PG8_STAMP();
    if (STAMP && wid == 0) { stamps[lane] = lane < nts ? (((unsigned long long)(unsigned)ts_hi << 32) | (unsigned)ts_lo) : 0ull;
        if (lane == 62) stamps[62] = rt_entry; if (lane == 63) stamps[63] = (unsigned long long)wall_clock64(); }
#undef PG8_STAMP
#undef PG8_SA
#undef PG8_SB
#undef PG8_STAGE
#undef PG8_LDA
#undef PG8_LDB
#undef PG8_MMA
#undef PG8_WAIT_V
#undef PG8_WAIT_L
#undef PG8_BAR
#undef PG8_SCHED
}
}
__device__ __forceinline__ int in_src_col(int n) {
    if (n < 2048) return n;
    if (n < 2304) return 2056 + (n - 2048);
    if (n < 2560) return 2312 + (n - 2304);
    if (n < 2624) return 2568 + (n - 2560);
    if (n < 2640) return 2632 + (n - 2624);
    if (n < 2644) return 2048 + (n - 2640);
    if (n < 2648) return 2052 + (n - 2644);
    return -1;
}
__device__ __forceinline__ void tr_item(const float* W, int ldw, int srccol, bf16_t* WT, int ldt, int n0, int k0, LAS float* scr, int lane) {
    float tv[32];
#pragma unroll
    for (int i = 0; i < 32; ++i) { const int kk = 2 * i + (lane >> 5); tv[i] = (srccol >= 0) ? W[(size_t)(k0 + kk) * ldw + srccol] : 0.f; }
#pragma unroll
    for (int i = 0; i < 32; ++i) { const int kk = 2 * i + (lane >> 5); scr[kk * 33 + (lane & 31)] = tv[i]; }
    LDS_WAIT(); asm volatile("" ::: "memory");
    const int c = lane & 7;
#pragma unroll
    for (int j = 0; j < 4; ++j) { const int n = (lane >> 3) + 8 * j; const LAS float* s = scr + (8 * c) * 33 + n;
        u32x4 o; o.x = cvt_pk_bf16(s[0 * 33], s[1 * 33]); o.y = cvt_pk_bf16(s[2 * 33], s[3 * 33]); o.z = cvt_pk_bf16(s[4 * 33], s[5 * 33]); o.w = cvt_pk_bf16(s[6 * 33], s[7 * 33]);
        *(u32x4*)(WT + (size_t)(n0 + n) * ldt + k0 + 8 * c) = o; }
    LDS_WAIT(); asm volatile("" ::: "memory");
}
__device__ __forceinline__ void fold_nt(const float* A, int lda, const float* B, int ldb, bf16_t* O, int ldo, float sc, LAS float* scr, int lane) {
#pragma unroll 1
    for (int hf = 0; hf < 2; ++hf) {
        f32x2 a[32];
        const f32x4* ap = (const f32x4*)(A + (size_t)lane * lda + 64 * hf);
#pragma unroll
        for (int i = 0; i < 16; ++i) { const f32x4 t = ap[i]; a[2 * i] = f32x2{t[0], t[1]}; a[2 * i + 1] = f32x2{t[2], t[3]}; }
#pragma unroll 1
        for (int nn = 0; nn < 16; ++nn) {
            const CAS f32x2* bp = (const CAS f32x2*)(B + (size_t)nn * ldb + 64 * hf);
            f32x2 t0 = {0.f, 0.f}, t1 = {0.f, 0.f};
#pragma unroll
            for (int d = 0; d < 32; d += 2) { t0 = __builtin_elementwise_fma(a[d], bp[d], t0); t1 = __builtin_elementwise_fma(a[d + 1], bp[d + 1], t1); }
            const float r = (t0[0] + t0[1]) + (t1[0] + t1[1]);
            if (hf == 0) scr[lane * 17 + nn] = r;
            else O[(size_t)nn * ldo + lane] = f2bf((r + scr[lane * 17 + nn]) * sc);
        }
        LDS_WAIT(); asm volatile("" ::: "memory");
    }
}
__device__ __forceinline__ void fold_vo(const float* wo, const float* wv, bf16_t* O, int ldo, LAS float* scr, int lane) {
#pragma unroll 1
    for (int hf = 0; hf < 2; ++hf) {
        f32x2 a[32];
#pragma unroll
        for (int d = 0; d < 32; ++d) a[d] = f32x2{wo[(size_t)(64 * hf + 2 * d) * 1024 + lane], wo[(size_t)(64 * hf + 2 * d + 1) * 1024 + lane]};
#pragma unroll 1
        for (int nn = 0; nn < 16; ++nn) {
            const CAS f32x2* bp = (const CAS f32x2*)(wv + (size_t)nn * 1024 + 64 * hf);
            f32x2 t0 = {0.f, 0.f}, t1 = {0.f, 0.f};
#pragma unroll
            for (int d = 0; d < 32; d += 2) { t0 = __builtin_elementwise_fma(a[d], bp[d], t0); t1 = __builtin_elementwise_fma(a[d + 1], bp[d + 1], t1); }
            const float r = (t0[0] + t0[1]) + (t1[0] + t1[1]);
            scr[lane * 17 + nn] = (hf == 0) ? r : r + scr[lane * 17 + nn];
        }
        LDS_WAIT(); asm volatile("" ::: "memory");
    }
    const LAS float* sp = scr + lane * 17;
    u32x4 o0, o1; o0.x = cvt_pk_bf16(sp[0], sp[1]); o0.y = cvt_pk_bf16(sp[2], sp[3]); o0.z = cvt_pk_bf16(sp[4], sp[5]); o0.w = cvt_pk_bf16(sp[6], sp[7]);
    o1.x = cvt_pk_bf16(sp[8], sp[9]); o1.y = cvt_pk_bf16(sp[10], sp[11]); o1.z = cvt_pk_bf16(sp[12], sp[13]); o1.w = cvt_pk_bf16(sp[14], sp[15]);
    u32x4* op = (u32x4*)(O + (size_t)lane * ldo); op[0] = o0; op[1] = o1;
    LDS_WAIT(); asm volatile("" ::: "memory");
}
__device__ __forceinline__ void p0_prologue(const Params& p, LAS unsigned char* lds, int gw, int ngw, int wave, int lane) {
    unsigned char* ws = p.ws;
    LAS float* scr = (LAS float*)(lds + wave * 8448);
    bf16_t* WINT = (bf16_t*)(ws + WS_WINT); bf16_t* WQ2T = (bf16_t*)(ws + WS_WQ2T); bf16_t* WO2T = (bf16_t*)(ws + WS_WOUT2T); bf16_t* WQST = (bf16_t*)(ws + WS_WQST);
    constexpr int I_IN = 16 * 88, I_QI = 4 * 32, I_WO = 8 * 32, F_QK = 256, F_QS = 2048, F_VO = 1024;
    constexpr int NITEMS = I_IN + I_QI + I_WO + F_QK + F_QS + F_VO;
    for (int it = gw; it < NITEMS; it += ngw) {
        int r = it;
        if (r < I_IN) { const int kb = r / 88, nb = r % 88; tr_item(p.w_in, IN_W, in_src_col(32 * nb + (lane & 31)), WINT, 1024, 32 * nb, 64 * kb, scr, lane); continue; } r -= I_IN;
        if (r < I_QI) { const int kb = r / 32, nb = r % 32; tr_item(p.w_qidx_up, 1024, 32 * nb + (lane & 31), WQ2T + (size_t)1024 * 256, 256, 32 * nb, 64 * kb, scr, lane); continue; } r -= I_QI;
        if (r < I_WO) { const int kb = r / 32, nb = r % 32; tr_item(p.w_out, 1024, 32 * nb + (lane & 31), WO2T, 1536, 32 * nb, 64 * kb, scr, lane); continue; } r -= I_WO;
        if (r < F_QK) {
            const int h = r >> 6, jt = (r >> 2) & 15, kt = r & 3;
            fold_nt(p.w_q_up + (size_t)(64 * kt) * 512 + h * 128, 512, p.w_kv_up + (size_t)(16 * jt) * 1024 + h * 256, 1024,
                    WQ2T + (size_t)(h * 256 + 16 * jt) * 256 + 64 * kt, 256, 0.08838834764831845f, scr, lane);
            continue; } r -= F_QK;
        if (r < F_QS) {
            const int hs = r >> 7, nt = (r >> 4) & 7, kt = r & 15; const int h = hs >> 1, side = hs & 1;
            const float* sk = (side ? p.peer_k2 : p.peer_k1) + (size_t)(h * 128 + 16 * nt) * 128;
            fold_nt(p.peer_wq + (size_t)(64 * kt) * 2048 + hs * 128, 2048, sk, 128, WQST + (size_t)(hs * 128 + 16 * nt) * 1024 + 64 * kt, 1024, p.ln2_g[64 * kt + lane], scr, lane);
            continue; } r -= F_QS;
        {
            const int h = r >> 8, jt = (r >> 4) & 15, nt = r & 15;
            fold_vo(p.w_out + (size_t)(512 + h * 128) * 1024 + 64 * nt, p.w_kv_up + (size_t)(16 * jt) * 1024 + h * 256 + 128, WO2T + (size_t)(64 * nt) * 1536 + 512 + h * 256 + 16 * jt, 1536, scr, lane);
        }
    }
    bf16_t* HB = (bf16_t*)(ws + WS_HB);
    {
        const f32x4* gr = (const f32x4*)p.ln1_g + lane; f32x4 gv[4];
#pragma unroll
        for (int j = 0; j < 4; ++j) gv[j] = gr[64 * j];
        for (int m4 = 4 * gw; m4 < MT; m4 += 4 * ngw) {
            f32x4 v[4][4];
#pragma unroll
            for (int r = 0; r < 4; ++r) { const f32x4* xr = (const f32x4*)(p.x + (size_t)(m4 + r) * DM) + lane;
#pragma unroll
                for (int j = 0; j < 4; ++j) v[r][j] = xr[64 * j]; }
#pragma unroll
            for (int r = 0; r < 4; ++r) { float s2 = 0.f;
#pragma unroll
                for (int j = 0; j < 4; ++j) s2 += (v[r][j][0] * v[r][j][0] + v[r][j][1] * v[r][j][1]) + (v[r][j][2] * v[r][j][2] + v[r][j][3] * v[r][j][3]);
                const float rstd = rsqrtf(wave_sum(s2) * (1.f / DM) + EPS);
                u32x2* o8 = (u32x2*)(HB + (size_t)(m4 + r) * DM) + lane;
#pragma unroll
                for (int j = 0; j < 4; ++j) { const f32x4 g4 = gv[j]; u32x2 w; w.x = cvt_pk_bf16(v[r][j][0] * rstd * g4[0], v[r][j][1] * rstd * g4[1]); w.y = cvt_pk_bf16(v[r][j][2] * rstd * g4[2], v[r][j][3] * rstd * g4[3]); o8[64 * j] = w; } }
        }
    }
}

struct EpiIn {
    static constexpr bool PERM = true, AFTER_DRAIN = false;
    unsigned char* ws;
    __device__ __forceinline__ void operator()(const f32x4 (&acc)[2][2][4][2], const pg8::Unit& u, int wr, int wc, int fr, int fq) const {
        const int row0 = u.pm * 256 + wr * 64 + fr, cl0 = wc * 32 + 8 * fq, pn = u.pn;
        if (pn < 10) {
            bf16_t* base; int ld;
            if (pn < 6) { base = (bf16_t*)(ws + WS_QKV) + pn * 256; ld = 1536; }
            else if (pn < 8) { base = (bf16_t*)(ws + WS_ZB) + (pn - 6) * 256; ld = 512; }
            else if (pn == 8) { base = (bf16_t*)(ws + WS_CQ); ld = 256; }
            else { base = (bf16_t*)(ws + WS_CKV); ld = 256; }
#pragma unroll
            for (int ai = 0; ai < 2; ++ai)
#pragma unroll
                for (int m = 0; m < 4; ++m) { bf16_t* rowp = base + (size_t)(row0 + ai * 128 + m * 16) * ld + cl0;
#pragma unroll
                    for (int bj = 0; bj < 2; ++bj)
                        { const f32x4 v0 = acc[ai][bj][m][0], v1 = acc[ai][bj][m][1]; u32x4 w; w.x = cvt_pk_bf16(v0[0], v0[1]); w.y = cvt_pk_bf16(v0[2], v0[3]); w.z = cvt_pk_bf16(v1[0], v1[1]); w.w = cvt_pk_bf16(v1[2], v1[3]); *(u32x4*)(rowp + bj * 128) = w; }
                    asm volatile("" ::: "memory"); }
        } else {
            float* base = (float*)(ws + WS_MISC);
#pragma unroll
            for (int ai = 0; ai < 2; ++ai)
#pragma unroll
                for (int m = 0; m < 4; ++m) { float* rowp = base + (size_t)(row0 + ai * 128 + m * 16) * 128 + cl0;
#pragma unroll
                    for (int n = 0; n < 2; ++n) *(f32x4*)(rowp + n * 4) = acc[ai][0][m][n]; }
        }
    }
};
struct EpiQ {
    static constexpr bool PERM = true, AFTER_DRAIN = false;
    unsigned char* ws;
    __device__ __forceinline__ void operator()(const f32x4 (&acc)[2][2][4][2], const pg8::Unit& u, int wr, int wc, int fr, int fq) const {
        const int row0 = u.pm * 256 + wr * 64 + fr, cl0 = wc * 32 + 8 * fq, pn = u.pn;
        bf16_t* base; int ld;
        if (pn < 4) { base = (bf16_t*)(ws + WS_AOUT) + 512 + pn * 256; ld = 1536; } else { base = (bf16_t*)(ws + WS_QIDX) + (pn - 4) * 256; ld = 1024; }
#pragma unroll
        for (int ai = 0; ai < 2; ++ai)
#pragma unroll
            for (int m = 0; m < 4; ++m) { bf16_t* rowp = base + (size_t)(row0 + ai * 128 + m * 16) * ld + cl0;
#pragma unroll
                for (int bj = 0; bj < 2; ++bj)
                    { const f32x4 v0 = acc[ai][bj][m][0], v1 = acc[ai][bj][m][1]; u32x4 w; w.x = cvt_pk_bf16(v0[0], v0[1]); w.y = cvt_pk_bf16(v0[2], v0[3]); w.z = cvt_pk_bf16(v1[0], v1[1]); w.w = cvt_pk_bf16(v1[2], v1[3]); *(u32x4*)(rowp + bj * 128) = w; }
                asm volatile("" ::: "memory"); }
    }
};
struct EpiOut {
    static constexpr bool PERM = true, AFTER_DRAIN = false;
    const float* x; bf16_t* x1b; float* rss;
    __device__ __forceinline__ void operator()(const f32x4 (&acc)[2][2][4][2], const pg8::Unit& u, int wr, int wc, int fr, int fq) const {
        const int row0 = u.pm * 256 + wr * 64 + fr, col0 = u.pn * 256 + wc * 32 + 8 * fq;
#pragma unroll
        for (int ai = 0; ai < 2; ++ai)
#pragma unroll
            for (int m = 0; m < 4; ++m) { const int row = row0 + ai * 128 + m * 16; const size_t off = (size_t)row * DM + col0; float ss = 0.f;
#pragma unroll
                for (int bj = 0; bj < 2; ++bj) { const f32x4 v0 = acc[ai][bj][m][0] + *(const f32x4*)(x + off + bj * 128), v1 = acc[ai][bj][m][1] + *(const f32x4*)(x + off + bj * 128 + 4);
                        u32x4 w; w.x = cvt_pk_bf16(v0[0], v0[1]); w.y = cvt_pk_bf16(v0[2], v0[3]); w.z = cvt_pk_bf16(v1[0], v1[1]); w.w = cvt_pk_bf16(v1[2], v1[3]); *(u32x4*)(x1b + off + bj * 128) = w;
                        ss += ((v0[0] * v0[0] + v0[1] * v0[1]) + (v0[2] * v0[2] + v0[3] * v0[3])) + ((v1[0] * v1[0] + v1[1] * v1[1]) + (v1[2] * v1[2] + v1[3] * v1[3])); }
                ss += __shfl_xor(ss, 16); ss += __shfl_xor(ss, 32);
                if (fq == 0) __hip_atomic_fetch_add(rss + row, ss, __ATOMIC_RELAXED, __HIP_MEMORY_SCOPE_AGENT);
                asm volatile("" ::: "memory"); }
    }
};
struct EpiS {
    static constexpr bool PERM = true, AFTER_DRAIN = false;
    _Float16* S; const float* rss;
    __device__ __forceinline__ void operator()(const f32x4 (&acc)[2][2][4][2], const pg8::Unit& u, int wr, int wc, int fr, int fq) const {
        const int row0 = u.pm * 256 + wr * 64 + fr, col0 = u.pn * 256 + wc * 32 + 8 * fq;
#pragma unroll
        for (int ai = 0; ai < 2; ++ai)
#pragma unroll
            for (int m = 0; m < 4; ++m) { const int row = row0 + ai * 128 + m * 16; const float rs = rsqrtf(rss[row] * (1.f / DM) + EPS); _Float16* rowp = S + (size_t)row * 2048 + col0;
#pragma unroll
                for (int bj = 0; bj < 2; ++bj) { const f32x4 v0 = acc[ai][bj][m][0] * rs, v1 = acc[ai][bj][m][1] * rs; u32x4 w; w.x = __builtin_bit_cast(unsigned, (h2_t){(_Float16)v0[0], (_Float16)v0[1]}); w.y = __builtin_bit_cast(unsigned, (h2_t){(_Float16)v0[2], (_Float16)v0[3]});
                    w.z = __builtin_bit_cast(unsigned, (h2_t){(_Float16)v1[0], (_Float16)v1[1]}); w.w = __builtin_bit_cast(unsigned, (h2_t){(_Float16)v1[2], (_Float16)v1[3]}); *(u32x4*)(rowp + bj * 128) = w; } }
    }
};

__device__ __forceinline__ void p3_token(const Params& p, const LAS float* cw, int m, int lane, const u32x4 (&x0)[3], const u32x4 (&x1)[3], const u32x4 (&x2)[3], const u32x4 (&x3)[3]) {
    unsigned char* ws = p.ws;
    const int b = m >> 13, t = m & (SEQ - 1);
#pragma unroll
    for (int i = 0; i < 3; ++i) {
        const int piece = lane + 64 * i, hv = piece >> 4;
        float y[8];
#pragma unroll
        for (int e = 0; e < 8; ++e) y[e] = 0.f;
#pragma unroll
        for (int jj = 0; jj < 4; ++jj) { const f32x4 w0 = *(const LAS f32x4*)(cw + jj * 1536 + 8 * piece), w1 = *(const LAS f32x4*)(cw + jj * 1536 + 8 * piece + 4); const u32x4 v = (jj == 0) ? x0[i] : (jj == 1) ? x1[i] : (jj == 2) ? x2[i] : x3[i];
            y[0] = fmaf(w0[0], bf_lo(v.x), y[0]); y[1] = fmaf(w0[1], bf_hi(v.x), y[1]); y[2] = fmaf(w0[2], bf_lo(v.y), y[2]); y[3] = fmaf(w0[3], bf_hi(v.y), y[3]);
            y[4] = fmaf(w1[0], bf_lo(v.z), y[4]); y[5] = fmaf(w1[1], bf_hi(v.z), y[5]); y[6] = fmaf(w1[2], bf_lo(v.w), y[6]); y[7] = fmaf(w1[3], bf_hi(v.w), y[7]); }
        float ss = 0.f;
#pragma unroll
        for (int e = 0; e < 8; ++e) { y[e] = silu_f(y[e]); ss = fmaf(y[e], y[e], ss); }
        ss = row16_sum(ss);
        float r = 1.f;
        if (i < 2) { r = rsqrtf(ss + EPS); if (i == 0) r *= 0.08838834764831845f; }
        bf16_t* dst = (bf16_t*)(ws + (i == 0 ? WS_QH : (i == 1 ? WS_KH : WS_VH)));
        const int h = hv & 3;
        const size_t idx = ((((size_t)(b * 4 + h)) * NCHUNK + (t >> 6)) * 64 + (t & 63)) * 128 + 8 * (piece & 15);
        u32x4 o; o.x = cvt_pk_bf16(y[0] * r, y[1] * r); o.y = cvt_pk_bf16(y[2] * r, y[3] * r); o.z = cvt_pk_bf16(y[4] * r, y[5] * r); o.w = cvt_pk_bf16(y[6] * r, y[7] * r);
        *(u32x4*)(dst + idx) = o;
#ifdef PROBE_GDN
        if (b == 0 && t < 512 && (hv & 3) == 0) { float* rf = (float*)(ws + WS_REF) + ((size_t)i * 512 + t) * 128 + 8 * (piece & 15);
#pragma unroll
            for (int e = 0; e < 8; ++e) rf[e] = y[e] * r; }
#endif
    }
    const float* misc = (const float*)(ws + WS_MISC) + (size_t)m * 128;
    if (lane < 4) {
        const float a = misc[80 + lane] + p.dt_bias[lane], bb = misc[84 + lane];
        const float ea = __expf(a), ua = 1.f + ea, da = ua - 1.f;
        const float sp = (a > 20.f) ? a : (da == 0.f ? ea : __logf(ua) * ea * __builtin_amdgcn_rcpf(da));
        ((float*)(ws + WS_GARR))[(size_t)(b * 4 + lane) * SEQ + t] = -__expf(p.a_log[lane]) * sp;
        ((float*)(ws + WS_BARR))[(size_t)(b * 4 + lane) * SEQ + t] = __builtin_amdgcn_rcpf(1.f + __expf(-bb));
#ifdef PROBE_GDN
        if (b == 0 && lane == 0 && t < 512) { ((float*)(ws + WS_RES))[256 + t] = -__expf(p.a_log[0]) * sp; ((float*)(ws + WS_RES))[1024 + t] = 1.f / (1.f + __expf(-bb)); }
#endif
    }
    {
        u32x2* cq = (u32x2*)((bf16_t*)(ws + WS_CQ) + (size_t)m * 256) + lane; const u32x2 v = *cq;
        float f0 = bf_lo(v.x), f1 = bf_hi(v.x), f2 = bf_lo(v.y), f3 = bf_hi(v.y);
        float rs = rsqrtf(wave_sum((f0 * f0 + f1 * f1) + (f2 * f2 + f3 * f3)) * (1.f / 256.f) + EPS);
        f32x4 g = ((const f32x4*)p.q_norm_g)[lane]; u32x2 w; w.x = cvt_pk_bf16(f0 * rs * g[0], f1 * rs * g[1]); w.y = cvt_pk_bf16(f2 * rs * g[2], f3 * rs * g[3]); *cq = w;
        u32x2* ck = (u32x2*)((bf16_t*)(ws + WS_CKV) + (size_t)m * 256) + lane; const u32x2 v2 = *ck;
        f0 = bf_lo(v2.x); f1 = bf_hi(v2.x); f2 = bf_lo(v2.y); f3 = bf_hi(v2.y);
        rs = rsqrtf(wave_sum((f0 * f0 + f1 * f1) + (f2 * f2 + f3 * f3)) * (1.f / 256.f) + EPS);
        g = ((const f32x4*)p.kv_norm_g)[lane];
        { int w8 = __builtin_amdgcn_cvt_pk_fp8_f32(f0 * rs * g[0], f1 * rs * g[1], 0, false); w8 = __builtin_amdgcn_cvt_pk_fp8_f32(f2 * rs * g[2], f3 * rs * g[3], w8, true); ((unsigned*)(ws + WS_CKV8))[(size_t)m * 64 + lane] = (unsigned)w8; }
    }
    {
        const float xk = misc[lane]; const float mu = wave_sum(xk) * (1.f / 64.f); const float d = xk - mu; const float var = wave_sum(d * d) * (1.f / 64.f);
        ((bf16_t*)(ws + WS_KIDXN))[(size_t)m * 64 + lane] = f2bf(d * rsqrtf(var + EPS) * p.idx_ln_g[lane] + p.idx_ln_b[lane]);
        if (lane < 16) ((float*)(ws + WS_WIDX))[(size_t)m * 16 + lane] = misc[64 + lane] * (0.5f / 32.f);
    }
}

constexpr int G2_KL = 0, G2_QL = 17408, G2_VT = 34816, G2_KBT = 53248, G2_TL = 71680, G2_AM = 80896, G2_GC = 97280, G2_VT2 = 98304, G2_KBT2 = 116736, G2_TL2 = 135168, G2_TF = 144384;
__device__ __forceinline__ float bf_elem(const u32x4& v, int e) { const unsigned w = v[e >> 1]; return (e & 1) ? bf_hi(w) : bf_lo(w); }
struct G2In { u32x4 k[2], q[2], v[2]; float g, b; };
__device__ __forceinline__ void g2_load(const Params& p, G2In& in, int cb, int tid, int lane) {
    unsigned char* ws = p.ws;
    const u32x4* qB = (const u32x4*)((const bf16_t*)(ws + WS_QH) + (size_t)cb * 8192); const u32x4* kB = (const u32x4*)((const bf16_t*)(ws + WS_KH) + (size_t)cb * 8192); const u32x4* vB = (const u32x4*)((const bf16_t*)(ws + WS_VH) + (size_t)cb * 8192);
    const int bh = cb >> 7, c = cb & 127;
#pragma unroll
    for (int i = 0; i < 2; ++i) { const int piece = tid + 512 * i; in.k[i] = kB[piece]; in.q[i] = qB[piece]; in.v[i] = vB[piece]; }
    in.g = ((const float*)(ws + WS_GARR))[(size_t)bh * SEQ + c * 64 + lane]; in.b = ((const float*)(ws + WS_BARR))[(size_t)bh * SEQ + c * 64 + lane];
}
__device__ __forceinline__ void g2_chunk(const Params& p, LAS unsigned char* lds, int cb, int cb_next, G2In& in, int tid_in, int wave, int lane_in) {
    unsigned char* ws = p.ws;
    int tid = tid_in; asm volatile("" : "+v"(tid));
    const int lane = tid & 63; (void)lane_in;
    bf16_t* qB = (bf16_t*)(ws + WS_QH) + (size_t)cb * 8192; bf16_t* kB = (bf16_t*)(ws + WS_KH) + (size_t)cb * 8192; bf16_t* vB = (bf16_t*)(ws + WS_VH) + (size_t)cb * 8192;
    bf16_t* wB = (bf16_t*)(ws + WS_WBUF) + (size_t)cb * 8192; bf16_t* aB = (bf16_t*)(ws + WS_ATTN) + (size_t)cb * 4096;
    const int bh = cb >> 7, c = cb & 127;
    const float* gsrc = (const float*)(ws + WS_GARR) + (size_t)bh * SEQ + c * 64; const float* bsrc = (const float*)(ws + WS_BARR) + (size_t)bh * SEQ + c * 64;
    LAS bf16_t* KL = (LAS bf16_t*)(lds + G2_KL); LAS bf16_t* QL = (LAS bf16_t*)(lds + G2_QL); LAS bf16_t* VT = (LAS bf16_t*)(lds + G2_VT);
    LAS bf16_t* KBT = (LAS bf16_t*)(lds + G2_KBT); LAS bf16_t* TL = (LAS bf16_t*)(lds + G2_TL); LAS float* AM = (LAS float*)(lds + G2_AM);
    LAS float* GC = (LAS float*)(lds + G2_GC); LAS float* BT = GC + 64;
    const int g = lane >> 4, fr = lane & 15;
#ifdef PROBE_NAN
    unsigned pbad = 0u;
#define PCHK(idx, v) do { if (!(fabsf(v) < 1e30f)) pbad |= 1u << ((idx) - 30); } while (0)
#else
#define PCHK(idx, v) do {} while (0)
#endif
    u32x4 kp[2], qp[2], vp[2];
#pragma unroll
    for (int i = 0; i < 2; ++i) { kp[i] = in.k[i]; qp[i] = in.q[i]; vp[i] = in.v[i]; }
    if (wave == 0) {
        float gv = in.g;
#pragma unroll
        for (int o = 1; o < 64; o <<= 1) { const float t = __shfl_up(gv, o); if (lane >= o) gv += t; }
        GC[lane] = gv; BT[lane] = in.b;
    }
    __syncthreads();
#pragma unroll
    for (int i = 0; i < 2; ++i) { const int piece = tid + 512 * i, row = piece >> 4, ch = piece & 15;
        *(LAS u32x4*)(KL + row * 136 + ch * 8) = kp[i]; *(LAS u32x4*)(QL + row * 136 + ch * 8) = qp[i];
        const float bj = BT[row], be = bj * __expf(GC[row]);
#pragma unroll
        for (int e = 0; e < 8; ++e) { const float vv = bf_elem(vp[i], e) * bj, kk = bf_elem(kp[i], e) * be; const bf16_t vh = f2bf(vv), kh = f2bf(kk);
            VT[(ch * 8 + e) * 72 + row] = vh; KBT[(ch * 8 + e) * 72 + row] = kh; } }
    __syncthreads();
#pragma unroll
    for (int tt = 0; tt < 2; ++tt) { const int idx = wave + 8 * tt, ti = idx >> 2, tj = idx & 3;
        f32x4 accA = {0.f, 0.f, 0.f, 0.f}, accT = {0.f, 0.f, 0.f, 0.f};
        if (tj <= ti) {
#pragma unroll
            for (int s = 0; s < 4; ++s) { const bf16x8 ki = *(const LAS bf16x8*)(KL + (16 * ti + fr) * 136 + 32 * s + 8 * g), kj = *(const LAS bf16x8*)(KL + (16 * tj + fr) * 136 + 32 * s + 8 * g),
                                                       qi = *(const LAS bf16x8*)(QL + (16 * ti + fr) * 136 + 32 * s + 8 * g);
                accA = MFMA16(ki, kj, accA);
                accT = MFMA16(kj, qi, accT); }
        }
#pragma unroll
        for (int reg = 0; reg < 4; ++reg) { const int i = 16 * ti + 4 * g + reg, j = 16 * tj + fr;
            const float amv = (j < i) ? BT[i] * accA[reg] * __expf(GC[i] - GC[j]) : 0.f; AM[i * 64 + j] = amv; }
        { const int i = 16 * ti + fr; float v[4];
#pragma unroll
            for (int reg = 0; reg < 4; ++reg) { const int j = 16 * tj + 4 * g + reg; v[reg] = (j <= i) ? accT[reg] * __expf(GC[i] - GC[j]) : 0.f; }
            u32x2 w; w.x = cvt_pk_bf16(v[0], v[1]); w.y = cvt_pk_bf16(v[2], v[3]); *(u32x2*)(aB + i * 64 + 32 * (tj >> 1) + 8 * g + 4 * (tj & 1)) = w; }
    }
#pragma unroll
    for (int q = 0; q < 8; ++q) ((LAS float*)(lds + G2_TF))[tid + 512 * q] = 0.f;
    __syncthreads();
    LAS float* TF = (LAS float*)(lds + G2_TF); LAS float* XB = (LAS float*)(lds + G2_QL);
    if (wave == 0) {
        const int o = 16 * (lane >> 4), c = lane & 15;
        for (int i = 0; i < 16; ++i) { float acc = (i == c) ? 1.f : 0.f;
            for (int j = 0; j < i; ++j) acc = fmaf(-AM[(o + i) * 64 + o + j], TF[(o + j) * 64 + o + c], acc);
            TF[(o + i) * 64 + o + c] = acc; }
    } else {
        const int t2 = tid - 64; const float gl = GC[63];
        for (int piece = t2; piece < 1024; piece += 448) { const int row = piece >> 4, ch = piece & 15; const u32x4 v = *(const LAS u32x4*)(QL + row * 136 + ch * 8); const float e = __expf(GC[row]);
            u32x4 o; o.x = cvt_pk_bf16(bf_lo(v.x) * e, bf_hi(v.x) * e); o.y = cvt_pk_bf16(bf_lo(v.y) * e, bf_hi(v.y) * e); o.z = cvt_pk_bf16(bf_lo(v.z) * e, bf_hi(v.z) * e); o.w = cvt_pk_bf16(bf_lo(v.w) * e, bf_hi(v.w) * e);
            { const int kb = ch >> 2, u0 = 2 * (ch & 3), u1 = u0 + 1; bf16_t* rp = qB + row * 128 + 32 * kb;
              u32x2 lo2; lo2.x = o.x; lo2.y = o.y; u32x2 hi2; hi2.x = o.z; hi2.y = o.w;
              *(u32x2*)(rp + 4 * (2 * (u0 & 3) + (u0 >> 2))) = lo2; *(u32x2*)(rp + 4 * (2 * (u1 & 3) + (u1 >> 2))) = hi2; } }
        for (int piece = t2; piece < 1024; piece += 448) { const int d = piece >> 3, jc = piece & 7; float v[8];
#pragma unroll
            for (int e = 0; e < 8; ++e) { const int j = 8 * jc + e; v[e] = bf2f(KL[j * 136 + d]) * __expf(gl - GC[j]); }
            u32x4 o; o.x = cvt_pk_bf16(v[0], v[1]); o.y = cvt_pk_bf16(v[2], v[3]); o.z = cvt_pk_bf16(v[4], v[5]); o.w = cvt_pk_bf16(v[6], v[7]);
            { const int kb = jc >> 2, u0 = 2 * (jc & 3), u1 = u0 + 1; bf16_t* rp = kB + d * 64 + 32 * kb;
              u32x2 lo2; lo2.x = o.x; lo2.y = o.y; u32x2 hi2; hi2.x = o.z; hi2.y = o.w;
              *(u32x2*)(rp + 4 * (2 * (u0 & 3) + (u0 >> 2))) = lo2; *(u32x2*)(rp + 4 * (2 * (u1 & 3) + (u1 >> 2))) = hi2; } }
        if (t2 == 0) ((float*)(ws + WS_GAMMA))[cb] = __expf(gl);
    }
    __syncthreads();
    {
        const int pr = tid >> 8, r = (tid >> 4) & 15, c = tid & 15, o = 32 * pr; float x = 0.f;
#pragma unroll 4
        for (int k = 0; k < 16; ++k) x = fmaf(AM[(o + 16 + r) * 64 + o + k], TF[(o + k) * 64 + o + c], x);
        XB[tid] = x;
    }
    __syncthreads();
    {
        const int pr = tid >> 8, r = (tid >> 4) & 15, c = tid & 15, o = 32 * pr; float y = 0.f;
#pragma unroll 4
        for (int k = 0; k < 16; ++k) y = fmaf(TF[(o + 16 + r) * 64 + o + 16 + k], XB[pr * 256 + k * 16 + c], y);
        TF[(o + 16 + r) * 64 + o + c] = -y;
    }
    __syncthreads();
    {
        const int r = tid >> 4, c0 = (tid & 15) * 2; float x0 = 0.f, x1 = 0.f;
#pragma unroll 8
        for (int k = 0; k < 32; ++k) { const float a = AM[(32 + r) * 64 + k]; const f32x2 t = *(const LAS f32x2*)(TF + k * 64 + c0); x0 = fmaf(a, t[0], x0); x1 = fmaf(a, t[1], x1); }
        *(LAS f32x2*)(XB + r * 32 + c0) = (f32x2){x0, x1};
    }
    __syncthreads();
    {
        const int r = tid >> 4, c0 = (tid & 15) * 2; float x0 = 0.f, x1 = 0.f;
#pragma unroll 8
        for (int k = 0; k < 32; ++k) { const float a = TF[(32 + r) * 64 + 32 + k]; const f32x2 t = *(const LAS f32x2*)(XB + k * 32 + c0); x0 = fmaf(a, t[0], x0); x1 = fmaf(a, t[1], x1); }
        *(LAS f32x2*)(TF + (32 + r) * 64 + c0) = (f32x2){-x0, -x1};
    }
    __syncthreads();
#ifdef PROBE_GDN
    if (cb == 0) { float* dmp = (float*)(ws + 15 * MiB + 880000);
#pragma unroll 1
        for (int idx = tid; idx < 4096; idx += NTHR) { dmp[idx] = AM[idx]; dmp[4096 + idx] = TF[idx]; } }
#endif
#pragma unroll
    for (int q = 0; q < 8; ++q) { const int idx = tid + 512 * q, i = idx >> 6, j = idx & 63; TL[i * 72 + j] = f2bf(TF[idx]); }
    __syncthreads();
    if (cb_next < 16 * NCHUNK) g2_load(p, in, cb_next, tid, lane);
#pragma unroll
    for (int tt = 0; tt < 4; ++tt) { const int t = wave * 4 + tt, ti = t >> 3, te = t & 7; f32x4 acc = {0.f, 0.f, 0.f, 0.f};
#pragma unroll
        for (int s = 0; s < 2; ++s) { const int oa = (16 * ti + fr) * 72 + 32 * s + 8 * g, ob = (16 * te + fr) * 72 + 32 * s + 8 * g;
            const bf16x8 fa = *(const LAS bf16x8*)(TL + oa), fb = *(const LAS bf16x8*)(VT + ob);
            acc = MFMA16(fa, fb, acc); }
        u32x2 w; w.x = cvt_pk_bf16(acc[0], acc[1]); w.y = cvt_pk_bf16(acc[2], acc[3]); *(u32x2*)(vB + (16 * te + fr) * 64 + 16 * ti + 4 * g) = w; }
#pragma unroll
    for (int tt = 0; tt < 4; ++tt) { const int t = wave * 4 + tt, td = t >> 2, ti = t & 3; f32x4 acc = {0.f, 0.f, 0.f, 0.f};
#pragma unroll
        for (int s = 0; s < 2; ++s) { const int oa = (16 * td + fr) * 72 + 32 * s + 8 * g, ob = (16 * ti + fr) * 72 + 32 * s + 8 * g;
            const bf16x8 fa = *(const LAS bf16x8*)(KBT + oa), fb = *(const LAS bf16x8*)(TL + ob);
            acc = MFMA16(fa, fb, acc); }
        u32x2 w; w.x = cvt_pk_bf16(acc[0], acc[1]); w.y = cvt_pk_bf16(acc[2], acc[3]); *(u32x2*)(wB + (16 * ti + fr) * 128 + 32 * (td >> 1) + 8 * g + 4 * (td & 1)) = w; }
#ifdef PROBE_NAN
    if (pbad) { unsigned* pfl = (unsigned*)(ws + WS_CTL) + 1024; for (int k = 0; k < 7; ++k) if (pbad & (1u << k)) atomicOr(pfl + 30 + k, 1u); }
#endif
    __syncthreads();
}

constexpr int G3_W = 0, G3_Q = 16384, G3_KT = 32768, G3_AT = 49152, G3_BUF = 57344, G3_OB = 2 * G3_BUF, G3_OBS = 132;
static_assert(G3_OB + 64 * G3_OBS * 4 <= LDS_MISC, "scan LDS map");
__device__ __forceinline__ unsigned g3_off256(unsigned r, unsigned c) { return r * 256u + ((c ^ (r & 15u)) << 4); }
__device__ __forceinline__ unsigned g3_off128(unsigned r, unsigned c) { return r * 128u + ((c ^ ((r >> 1) & 7u)) << 4); }
__device__ __forceinline__ void g3_scan(const Params& p, LAS unsigned char* lds, int bh, int wave, int lane) {
    unsigned char* ws = p.ws;
    const int b = bh >> 2, h = bh & 3, e0 = 16 * wave;
    LAS float* OB = (LAS float*)(lds + G3_OB);
    f32x4 S[8];
#pragma unroll
    for (int i = 0; i < 8; ++i) S[i] = (f32x4){0.f, 0.f, 0.f, 0.f};
    const bf16_t* ZB = (const bf16_t*)(ws + WS_ZB); bf16_t* AO = (bf16_t*)(ws + WS_AOUT);
    const int tid = wave * 64 + lane;
    {
        const size_t cb = (size_t)bh * NCHUNK;
        const u32x4* s0 = (const u32x4*)((const bf16_t*)(ws + WS_WBUF) + cb * 8192); const u32x4* s1 = (const u32x4*)((const bf16_t*)(ws + WS_QH) + cb * 8192);
        const u32x4* s2 = (const u32x4*)((const bf16_t*)(ws + WS_KH) + cb * 8192); const u32x4* s4 = (const u32x4*)((const bf16_t*)(ws + WS_ATTN) + cb * 4096);
#pragma unroll
        for (int i = 0; i < 2; ++i) { const unsigned pp = tid + 512 * i;
            *(LAS u32x4*)(lds + G3_W + g3_off256(pp >> 4, pp & 15u)) = s0[pp]; *(LAS u32x4*)(lds + G3_Q + g3_off256(pp >> 4, pp & 15u)) = s1[pp]; *(LAS u32x4*)(lds + G3_KT + g3_off128(pp >> 3, pp & 7u)) = s2[pp]; }
        *(LAS u32x4*)(lds + G3_AT + g3_off128((unsigned)tid >> 3, (unsigned)tid & 7u)) = s4[tid];
    }
    __syncthreads();
#pragma unroll 1
    for (int c = 0; c < NCHUNK; ++c) {
        int lane_o = threadIdx.x & 63; asm volatile("" : "+v"(lane_o));
        const unsigned g = (unsigned)lane_o >> 4, fr = (unsigned)lane_o & 15u;
        const unsigned tid2 = wave * 64 + lane_o;
        const size_t cb = (size_t)bh * NCHUNK + c;
        LAS unsigned char* buf = lds + (c & 1) * G3_BUF; LAS unsigned char* nbuf = lds + ((c + 1) & 1) * G3_BUF;
        const float gam = ((const float*)(ws + WS_GAMMA))[cb];
        u32x4 zp[2]; u32x2 uu[4];
        {
            const size_t nb = (c + 1 < NCHUNK) ? cb + 1 : cb;
            const u32x4* s0 = (const u32x4*)((const bf16_t*)(ws + WS_WBUF) + nb * 8192); const u32x4* s1 = (const u32x4*)((const bf16_t*)(ws + WS_QH) + nb * 8192);
            const u32x4* s2 = (const u32x4*)((const bf16_t*)(ws + WS_KH) + nb * 8192); const u32x4* s4 = (const u32x4*)((const bf16_t*)(ws + WS_ATTN) + nb * 4096);
#pragma unroll
            for (int i = 0; i < 2; ++i) { const unsigned sl = tid2 + 512u * i, r = sl >> 4, cs = (sl & 15u) ^ (r & 15u); const unsigned wb = (unsigned)(wave * 64 + 512 * i) * 16u;
                __builtin_amdgcn_global_load_lds((const unsigned*)(s0 + r * 16u + cs), (LAS unsigned*)(nbuf + G3_W + wb), 16, 0, 0);
                __builtin_amdgcn_global_load_lds((const unsigned*)(s1 + r * 16u + cs), (LAS unsigned*)(nbuf + G3_Q + wb), 16, 0, 0);
                const unsigned r8 = sl >> 3, c8s = (sl & 7u) ^ ((r8 >> 1) & 7u);
                __builtin_amdgcn_global_load_lds((const unsigned*)(s2 + r8 * 8u + c8s), (LAS unsigned*)(nbuf + G3_KT + wb), 16, 0, 0); }
            { const unsigned r8 = tid2 >> 3, c8s = (tid2 & 7u) ^ ((r8 >> 1) & 7u);
                __builtin_amdgcn_global_load_lds((const unsigned*)(s4 + r8 * 8u + c8s), (LAS unsigned*)(nbuf + G3_AT + (unsigned)(wave * 64) * 16u), 16, 0, 0); }
            const bf16_t* uT = (const bf16_t*)(ws + WS_VH) + cb * 8192;
#pragma unroll
            for (int mt = 0; mt < 4; ++mt) uu[mt] = *(const u32x2*)(uT + (e0 + fr) * 64 + 16 * mt + 4 * g);
#pragma unroll
            for (int q = 0; q < 2; ++q) { const unsigned pp = tid2 + 512u * q; const size_t m = (size_t)b * SEQ + c * 64 + (pp >> 4); zp[q] = *(const u32x4*)(ZB + m * 512 + h * 128 + 8 * (pp & 15u)); }
        }
        bf16x8 Sb[4];
#pragma unroll
        for (int kb = 0; kb < 4; ++kb) Sb[kb] = pk8(S[2 * kb], S[2 * kb + 1]);
        f32x4 vn[4], ot[4];
#define G3_FRAG256(base, R, kb) (*(const LAS bf16x8*)(buf + (base) + g3_off256((R), 4 * (kb) + g)))
#define G3_FRAG128(base, R, k2) (*(const LAS bf16x8*)(buf + (base) + g3_off128((R), 4 * (k2) + g)))
        {
#pragma unroll
            for (int hf = 0; hf < 2; ++hf) {
                bf16x8 af[8];
#pragma unroll
                for (int m2 = 0; m2 < 2; ++m2)
#pragma unroll
                    for (int kb = 0; kb < 4; ++kb) af[4 * m2 + kb] = G3_FRAG256(G3_W, 16 * (2 * hf + m2) + fr, kb);
                asm volatile("" ::: "memory");
#pragma unroll
                for (int m2 = 0; m2 < 2; ++m2) { const int mt = 2 * hf + m2; f32x4 acc = {0.f, 0.f, 0.f, 0.f};
#pragma unroll
                    for (int kb = 0; kb < 4; ++kb) acc = MFMA16(af[4 * m2 + kb], Sb[kb], acc);
                    vn[mt] = (f32x4){bf_lo(uu[mt].x) - acc[0], bf_hi(uu[mt].x) - acc[1], bf_lo(uu[mt].y) - acc[2], bf_hi(uu[mt].y) - acc[3]}; }
            }
        }
        bf16x8 vb[2]; vb[0] = pk8(vn[0], vn[1]); vb[1] = pk8(vn[2], vn[3]);
        {
#pragma unroll
            for (int mt = 0; mt < 4; ++mt) {
                bf16x8 af[6];
#pragma unroll
                for (int kb = 0; kb < 4; ++kb) af[kb] = G3_FRAG256(G3_Q, 16 * mt + fr, kb);
#pragma unroll
                for (int k2 = 0; k2 < 2; ++k2) af[4 + k2] = G3_FRAG128(G3_AT, 16 * mt + fr, k2);
                asm volatile("" ::: "memory");
                f32x4 acc = {0.f, 0.f, 0.f, 0.f};
#pragma unroll
                for (int kb = 0; kb < 4; ++kb) acc = MFMA16(af[kb], Sb[kb], acc);
#pragma unroll
                for (int k2 = 0; k2 < 2; ++k2) acc = MFMA16(af[4 + k2], vb[k2], acc);
                ot[mt] = acc; }
        }
        {
#pragma unroll
            for (int hf = 0; hf < 4; ++hf) {
                bf16x8 af[4];
#pragma unroll
                for (int r2 = 0; r2 < 2; ++r2)
#pragma unroll
                    for (int k2 = 0; k2 < 2; ++k2) af[2 * r2 + k2] = G3_FRAG128(G3_KT, 16 * (2 * hf + r2) + fr, k2);
                asm volatile("" ::: "memory");
#pragma unroll
                for (int r2 = 0; r2 < 2; ++r2) { const int rt = 2 * hf + r2; f32x4 acc = S[rt] * gam;
#pragma unroll
                    for (int k2 = 0; k2 < 2; ++k2) acc = MFMA16(af[2 * r2 + k2], vb[k2], acc);
                    S[rt] = acc; }
            }
        }
#undef G3_FRAG256
#undef G3_FRAG128
        __syncthreads();
#pragma unroll
        for (int mt = 0; mt < 4; ++mt)
#pragma unroll
            for (int reg = 0; reg < 4; ++reg) OB[(16 * mt + 4 * g + reg) * G3_OBS + e0 + fr] = ot[mt][reg];
        asm volatile("s_waitcnt vmcnt(0)" ::: "memory");
        __syncthreads();
#pragma unroll
        for (int q = 0; q < 2; ++q) { const unsigned pp = tid2 + 512u * q, i = pp >> 4, c8 = pp & 15u;
            const f32x4 o0 = *(const LAS f32x4*)(OB + i * G3_OBS + 8 * c8), o1 = *(const LAS f32x4*)(OB + i * G3_OBS + 8 * c8 + 4);
            const float tot = row16_sum((o0[0] * o0[0] + o0[1] * o0[1]) + (o0[2] * o0[2] + o0[3] * o0[3]) + (o1[0] * o1[0] + o1[1] * o1[1]) + (o1[2] * o1[2] + o1[3] * o1[3]));
            const float rstd = rsqrtf(tot * (1.f / 128.f) + EPS);
            const u32x4 z = zp[q]; f32x4 gnv[2]; { const f32x4* gp4 = (const f32x4*)(p.gdn_norm_g + 8 * c8); gnv[0] = gp4[0]; gnv[1] = gp4[1]; }
            float r[8];
            r[0] = o0[0] * rstd * gnv[0][0] * silu_f(bf_lo(z.x)); r[1] = o0[1] * rstd * gnv[0][1] * silu_f(bf_hi(z.x)); r[2] = o0[2] * rstd * gnv[0][2] * silu_f(bf_lo(z.y)); r[3] = o0[3] * rstd * gnv[0][3] * silu_f(bf_hi(z.y));
            r[4] = o1[0] * rstd * gnv[1][0] * silu_f(bf_lo(z.z)); r[5] = o1[1] * rstd * gnv[1][1] * silu_f(bf_hi(z.z)); r[6] = o1[2] * rstd * gnv[1][2] * silu_f(bf_lo(z.w)); r[7] = o1[3] * rstd * gnv[1][3] * silu_f(bf_hi(z.w));
#ifdef ZERO_GDN
#pragma unroll
            for (int e = 0; e < 8; ++e) r[e] = 0.f;
#elif defined(DOUBLE_GDN)
#pragma unroll
            for (int e = 0; e < 8; ++e) r[e] *= 2.f;
#endif
            u32x4 w; w.x = cvt_pk_bf16(r[0], r[1]); w.y = cvt_pk_bf16(r[2], r[3]); w.z = cvt_pk_bf16(r[4], r[5]); w.w = cvt_pk_bf16(r[6], r[7]);
            const size_t m = (size_t)b * SEQ + c * 64 + i;
            *(u32x4*)(AO + m * 1536 + h * 128 + 8 * c8) = w; }
    }
}

constexpr int DL_QS = 0;
constexpr int DL_IMG = 0;
constexpr int DL_SEL = 131072;
constexpr int DL_HIST = 139264;
constexpr int DL_WQ = 147456;
constexpr int DL_BKT = 148480;
constexpr int DL_RB = 156672;
static_assert(DL_RB + 512 <= LDS_MISC, "DSA LDS map");

__device__ __forceinline__ unsigned img_off(unsigned row, unsigned ch) { return 256u * row + 16u * (ch ^ (((row & 3u) << 2) | ((row >> 2) & 3u))); }
__device__ __forceinline__ unsigned key16(unsigned u) { return (u & 0x8000u) ? (~u & 0xffffu) : (u | 0x8000u); }
__device__ __forceinline__ void radix_find(const LAS unsigned* hist, unsigned need, int lane, unsigned& bsel, unsigned& above) {
    const u32x4 hv = *(const LAS u32x4*)(hist + 4 * lane);
    const unsigned s4 = hv.x + hv.y + hv.z + hv.w;
    unsigned incl = s4;
#pragma unroll
    for (int o = 1; o < 64; o <<= 1) { const unsigned t = __shfl_down(incl, o); if (lane + o < 64) incl += t; }
    const unsigned excl = incl - s4;
    const bool hit = (excl < need) && (incl >= need);
    const unsigned c3 = excl + hv.w, c2 = c3 + hv.z, c1 = c2 + hv.y;
    unsigned bb, ab;
    if (c3 >= need) { bb = 3; ab = excl; } else if (c2 >= need) { bb = 2; ab = c3; } else if (c1 >= need) { bb = 1; ab = c2; } else { bb = 0; ab = c1; }
    const unsigned long long mask = __ballot(hit);
    const int src = mask ? (__ffsll((long long)mask) - 1) : 0;
    bsel = __shfl(4u * lane + bb, src); above = __shfl(ab, src);
}
__device__ __forceinline__ void dsa_tables(const Params& p, LAS unsigned char* lds, int tid) {
    LAS unsigned char* BK = lds + DL_BKT; LAS float* RB = (LAS float*)(lds + DL_RB);
    for (int d = tid; d < SEQ; d += NTHR) { int bk = d;
        if (d >= 16) { bk = 16 + (d >= 21) + (d >= 27) + (d >= 35) + (d >= 46) + (d >= 59) + (d >= 77) + (d >= 99) + (d >= 128) + (d >= 166) + (d >= 216) + (d >= 280) + (d >= 363) + (d >= 470) + (d >= 609) + (d >= 790); }
        BK[d] = (unsigned char)bk; }
    if (tid < 128) RB[tid] = p.rel_bias[tid];
    __syncthreads();
}
struct TabJob { f32x4 a[4], b[4], g[4]; int pair; };
__device__ __forceinline__ void tab_load(const Params& p, TabJob& tj, int pair, int lane) {
    tj.pair = pair; const int tb = pair >> 13, r0 = (pair & 8191) * 2;
    const float* src = (tb ? p.peer_v : p.peer_u) + (size_t)r0 * 1024 + 16 * lane;
#pragma unroll
    for (int q = 0; q < 4; ++q) { tj.a[q] = ((const f32x4*)src)[q]; tj.b[q] = ((const f32x4*)(src + 1024))[q]; tj.g[q] = ((const f32x4*)p.ln2_g)[4 * lane + q]; }
}
__device__ __forceinline__ void tab_finish(unsigned char* ws, const TabJob& tj, int lane) {
    const int tb = tj.pair >> 13, r0 = (tj.pair & 8191) * 2;
    float va[16], vb[16];
#pragma unroll
    for (int q = 0; q < 4; ++q)
#pragma unroll
        for (int e = 0; e < 4; ++e) { const float gq = tb ? 1.f : tj.g[q][e]; va[4 * q + e] = tj.a[q][e] * gq; vb[4 * q + e] = tj.b[q][e] * gq; }
    float ma = 0.f, mb = 0.f;
#pragma unroll
    for (int e = 0; e < 16; ++e) { ma = fmaxf(ma, __builtin_fabsf(va[e])); mb = fmaxf(mb, __builtin_fabsf(vb[e])); }
#pragma unroll
    for (int o = 32; o >= 1; o >>= 1) { ma = fmaxf(ma, __shfl_xor(ma, o)); mb = fmaxf(mb, __shfl_xor(mb, o)); }
    ma = fmaxf(ma, 1e-30f); mb = fmaxf(mb, 1e-30f);
    const float ia = 7.5f / ma, ib = 7.5f / mb;
    h32_t hv;
#pragma unroll
    for (int e = 0; e < 16; ++e) { hv[e] = (_Float16)(va[e] * ia); hv[16 + e] = (_Float16)(vb[e] * ib); }
    const u32x6 enc = __builtin_amdgcn_cvt_scalef32_pk32_fp6_f16(hv, 1.0f);
    unsigned char* dst = ws + (tb ? WS_VB : WS_UB) + (size_t)r0 * 768 + lane * 12;
    *(u32x3a*)dst = (u32x3a){enc[0], enc[1], enc[2]}; *(u32x3a*)(dst + 768) = (u32x3a){enc[3], enc[4], enc[5]};
    if (lane == 0) { float* SUVp = (float*)(ws + WS_SUV); SUVp[tb * 16384 + r0] = ma * (1.f / 7.5f); SUVp[tb * 16384 + r0 + 1] = mb * (1.f / 7.5f); }
}
__device__ __forceinline__ void dsa_unit(const Params& p, LAS unsigned char* lds, int b, int qb16, const TabJob& tj) {
    unsigned char* ws = p.ws;
    int tid = threadIdx.x; asm volatile("" : "+v"(tid));
    const int lane = tid & 63, wave = __builtin_amdgcn_readfirstlane(tid >> 6);
    const int g = lane >> 4, fr = lane & 15, t0 = 16 * qb16, nkt = qb16 + 1;
    const size_t m0 = (size_t)b * SEQ + t0;
    LAS bf16_t* QS = (LAS bf16_t*)(lds + DL_QS); LAS float* WQ = (LAS float*)(lds + DL_WQ);
    LAS unsigned short* SEL = (LAS unsigned short*)(lds + DL_SEL); LAS unsigned* HIST = (LAS unsigned*)(lds + DL_HIST) + wave * 256;
    const LAS unsigned char* BK = lds + DL_BKT; const LAS float* RB = (const LAS float*)(lds + DL_RB);
    _Float16* scr = (_Float16*)(ws + WS_SCR) + (size_t)blockIdx.x * (16 * SEQ);
#ifdef PROBE_TIME
    const unsigned long long td0 = __builtin_amdgcn_s_memrealtime();
#endif
    {
        const bf16_t* qsrc = (const bf16_t*)(ws + WS_QIDX) + m0 * 1024;
#pragma unroll
        for (int i = 0; i < 4; ++i) { const int piece = tid + 512 * i, qi = piece >> 7, rem = piece & 127, h = rem >> 3, ch = rem & 7;
            *(LAS u32x4*)(QS + (h * 16 + qi) * 72 + ch * 8) = *(const u32x4*)(qsrc + (size_t)qi * 1024 + h * 64 + ch * 8); }
        if (tid < 256) WQ[tid] = ((const float*)(ws + WS_WIDX))[m0 * 16 + tid];
        __syncthreads();
        tab_finish(ws, tj, lane);
        { const int qi = tid >> 5, d = (tid & 31) * 2; float s0 = 0.f, s1 = 0.f;
#pragma unroll
            for (int h = 0; h < 16; ++h) { const unsigned w2 = *(const LAS unsigned*)(QS + (h * 16 + qi) * 72 + d); const float wh = WQ[qi * 16 + h]; s0 = fmaf(wh, bf_lo(w2), s0); s1 = fmaf(wh, bf_hi(w2), s1); }
            *(LAS unsigned*)(QS + (16 * 16 + qi) * 72 + d) = cvt_pk_bf16(s0, s1); }
        __syncthreads();
    }
    {
        float wreg[16];
#pragma unroll
        for (int h = 0; h < 16; ++h) wreg[h] = WQ[fr * 16 + h];
        const bf16_t* kbase = (const bf16_t*)(ws + WS_KIDXN) + (size_t)b * SEQ * 64;
        constexpr int NQR = 11;
        bf16x8 qfr[NQR][2];
#pragma unroll
        for (int h = 0; h < NQR; ++h) { qfr[h][0] = *(const LAS bf16x8*)(QS + (h * 16 + fr) * 72 + 8 * g); qfr[h][1] = *(const LAS bf16x8*)(QS + (h * 16 + fr) * 72 + 32 + 8 * g); }
        bf16x8 kn[2];
        { int kt = wave; if (kt >= nkt) kt = 0; const bf16_t* kr = kbase + (size_t)(16 * kt + fr) * 64 + 8 * g; kn[0] = *(const bf16x8*)kr; kn[1] = *(const bf16x8*)(kr + 32); }
#pragma unroll 1
        for (int kt = wave; kt < nkt; kt += 8) {
            const bf16x8 ka0 = kn[0], ka1 = kn[1];
            { int k2 = kt + 8; if (k2 >= nkt) k2 = 0; const bf16_t* kr = kbase + (size_t)(16 * k2 + fr) * 64 + 8 * g; kn[0] = *(const bf16x8*)kr; kn[1] = *(const bf16x8*)(kr + 32); }
            f32x4 sc = {0.f, 0.f, 0.f, 0.f};
            unsigned oz1; asm volatile("v_mov_b32 %0, 0" : "=v"(oz1));
            const LAS bf16_t* QSz = QS + oz1;
            bf16x8 ql[17 - NQR][2];
#pragma unroll
            for (int h = NQR; h < 17; ++h) { ql[h - NQR][0] = *(const LAS bf16x8*)(QSz + (h * 16 + fr) * 72 + 8 * g); ql[h - NQR][1] = *(const LAS bf16x8*)(QSz + (h * 16 + fr) * 72 + 32 + 8 * g); }
#pragma unroll
            for (int h = 0; h < 17; ++h) { f32x4 c = {0.f, 0.f, 0.f, 0.f}; const bf16x8 q0 = (h < NQR) ? qfr[h < NQR ? h : 0][0] : ql[h >= NQR ? h - NQR : 0][0], q1 = (h < NQR) ? qfr[h < NQR ? h : 0][1] : ql[h >= NQR ? h - NQR : 0][1];
                c = MFMA16(ka0, q0, c); c = MFMA16(ka1, q1, c);
                if (h < 16) {
#pragma unroll
                    for (int r = 0; r < 4; ++r) { float t = fmaf(__builtin_fabsf(c[r]), wreg[h < 16 ? h : 0], sc[r]); asm volatile("" : "+v"(t)); sc[r] = t; }
                } else sc += c; }
            { _Float16 hv[4];
#pragma unroll
                for (int r = 0; r < 4; ++r) { const int key = 16 * kt + 4 * g + r; float v = sc[r]; if (kt == nkt - 1 && key > t0 + fr) v = -INFINITY; hv[r] = (_Float16)v; }
                typedef _Float16 h4 __attribute__((ext_vector_type(4))); h4 o; o[0] = hv[0]; o[1] = hv[1]; o[2] = hv[2]; o[3] = hv[3];
                *(h4*)(scr + (size_t)fr * SEQ + 16 * kt + 4 * g) = o; }
        }
    }
    VM_WAIT(); __syncthreads();
#ifdef PROBE_TIME
    const unsigned long long td1 = __builtin_amdgcn_s_memrealtime(); unsigned long long t2acc = 0, t3acc = 0;
#endif
    const unsigned char* ckv8 = ws + WS_CKV8 + (size_t)b * SEQ * 256;
    bf16_t* AO = (bf16_t*)(ws + WS_AOUT);
    LAS unsigned char* img = lds + DL_IMG + wave * 16384;
#pragma unroll 1
    for (int qq = 0; qq < 2; ++qq) {
#ifdef PROBE_TIME
        const unsigned long long tdq = __builtin_amdgcn_s_memrealtime();
#endif
        int lane3 = threadIdx.x & 63; asm volatile("" : "+v"(lane3));
        const int lane = lane3, g = lane >> 4, fr = lane & 15;
        const unsigned long long lt_mask = (1ull << lane) - 1ull;
        const int qi = wave + 8 * qq, t = t0 + qi, n = t + 1; const size_t m = m0 + qi;
        LAS unsigned short* sel = SEL + qi * 256;
        int cnt;
        if (n <= 256) { cnt = n; for (int k = lane; k < 256; k += 64) sel[k] = (unsigned short)((k < n) ? k : 0); }
        else {
            cnt = 256;
            const unsigned* srow = (const unsigned*)(scr + (size_t)qi * SEQ); const int nw = (n + 1) >> 1;
            unsigned sv[64];
            const int nfull = n >> 1;
#pragma unroll
            for (int blk = 0; blk < 4; ++blk) {
                if (1024 * blk < nw) {
#pragma unroll
                    for (int jj = 0; jj < 16; ++jj) { const int j = 16 * blk + jj; sv[j] = srow[lane + 64 * j]; }
                } else {
#pragma unroll
                    for (int jj = 0; jj < 16; ++jj) sv[16 * blk + jj] = 0u;
                }
            }
            LAS unsigned* H = (LAS unsigned*)img;
#pragma unroll
            for (int k = 0; k < 8; ++k) *(LAS u32x4*)(H + 4 * (lane + 64 * k)) = (u32x4){0u, 0u, 0u, 0u};
            LDS_WAIT();
#pragma unroll
            for (int blk = 0; blk < 4; ++blk) if (1024 * blk < nw) {
#pragma unroll
                for (int jj = 0; jj < 16; ++jj) { const int j = 16 * blk + jj; const unsigned v = sv[j];
                    const unsigned neg = (v >> 15) & 0x00010001u, msk = (neg << 16) - neg;
                    unsigned kk = v ^ (msk | 0x80008000u);
                    if (64 * j + 64 <= nfull) {
                        sv[j] = kk;
                        __hip_atomic_fetch_add(H + ((kk & 0xffffu) >> 5), 1u, __ATOMIC_RELAXED, __HIP_MEMORY_SCOPE_WORKGROUP);
                        __hip_atomic_fetch_add(H + (kk >> 21), 1u, __ATOMIC_RELAXED, __HIP_MEMORY_SCOPE_WORKGROUP);
                    } else {
                        const int w = lane + 64 * j;
                        kk = (w < nw) ? kk : 0u; if (2 * w + 1 >= n) kk &= 0xFFFFu;
                        sv[j] = kk;
                        const unsigned k0 = kk & 0xffffu, k1 = kk >> 16;
                        if (k0) __hip_atomic_fetch_add(H + (k0 >> 5), 1u, __ATOMIC_RELAXED, __HIP_MEMORY_SCOPE_WORKGROUP);
                        if (k1) __hip_atomic_fetch_add(H + (k1 >> 5), 1u, __ATOMIC_RELAXED, __HIP_MEMORY_SCOPE_WORKGROUP);
                    } }
            }
            LDS_WAIT();
            unsigned b1, need1;
            {
                unsigned hb[32];
#pragma unroll
                for (int k = 0; k < 8; ++k) { const u32x4 t = *(const LAS u32x4*)(H + 32 * lane + 4 * k); hb[4 * k] = t.x; hb[4 * k + 1] = t.y; hb[4 * k + 2] = t.z; hb[4 * k + 3] = t.w; }
                unsigned s32 = 0u;
#pragma unroll
                for (int k = 0; k < 32; ++k) s32 += hb[k];
                unsigned incl = s32;
#pragma unroll
                for (int o = 1; o < 64; o <<= 1) { const unsigned t = __shfl_down(incl, o); if (lane + o < 64) incl += t; }
                const unsigned excl = incl - s32; const bool hit = (excl < 256u) && (incl >= 256u);
                unsigned run = excl, bb = 0u, ab = excl; bool found = false;
#pragma unroll
                for (int k = 31; k >= 0; --k) { const unsigned nr = run + hb[k]; if (!found && nr >= 256u) { found = true; bb = (unsigned)k; ab = run; } run = nr; }
                const unsigned long long mask = __ballot(hit); const int src = mask ? (__ffsll((long long)mask) - 1) : 0;
                b1 = __shfl(32u * lane + bb, src); need1 = 256u - __shfl(ab, src);
            }
            LDS_WAIT();
            if (lane < 32) H[lane] = 0u;
            LDS_WAIT();
#pragma unroll
            for (int blk = 0; blk < 4; ++blk) if (1024 * blk < nw) {
#pragma unroll
                for (int jj = 0; jj < 16; ++jj) { const unsigned v = sv[16 * blk + jj]; const unsigned k0 = v & 0xffffu, k1 = v >> 16;
                    if ((k0 >> 5) == b1) __hip_atomic_fetch_add(H + (k0 & 31u), 1u, __ATOMIC_RELAXED, __HIP_MEMORY_SCOPE_WORKGROUP);
                    if ((k1 >> 5) == b1) __hip_atomic_fetch_add(H + (k1 & 31u), 1u, __ATOMIC_RELAXED, __HIP_MEMORY_SCOPE_WORKGROUP); }
            }
            LDS_WAIT();
            unsigned thr, need2;
            {
                const unsigned hv = (lane < 32) ? H[lane] : 0u; unsigned incl = hv;
#pragma unroll
                for (int o = 1; o < 32; o <<= 1) { const unsigned t = __shfl_down(incl, o); if (lane + o < 32) incl += t; }
                const unsigned excl = incl - hv; const bool hit = (lane < 32) && (excl < need1) && (incl >= need1);
                const unsigned long long mask = __ballot(hit); const int src = mask ? (__ffsll((long long)mask) - 1) : 0;
                thr = (b1 << 5) | (unsigned)src; need2 = need1 - __shfl(excl, src);
            }
            unsigned mg[4], me[4];
#pragma unroll
            for (int blk = 0; blk < 4; ++blk) { unsigned g1 = 0u, e1 = 0u;
                if (1024 * blk < nw) {
#pragma unroll
                    for (int jj = 0; jj < 16; ++jj) { const unsigned v = sv[16 * blk + jj]; const unsigned k0 = v & 0xffffu, k1 = v >> 16;
                        asm("v_cmp_gt_u32 vcc, %2, %4\n\tv_addc_co_u32 %0, vcc, %0, %0, vcc\n\tv_cmp_gt_u32 vcc, %3, %4\n\tv_addc_co_u32 %0, vcc, %0, %0, vcc\n\t"
                            "v_cmp_eq_u32 vcc, %2, %4\n\tv_addc_co_u32 %1, vcc, %1, %1, vcc\n\tv_cmp_eq_u32 vcc, %3, %4\n\tv_addc_co_u32 %1, vcc, %1, %1, vcc"
                            : "+v"(g1), "+v"(e1) : "v"(k0), "v"(k1), "v"(thr) : "vcc"); }
                }
                mg[blk] = g1; me[blk] = e1; }
            const unsigned cgt = (unsigned)(__builtin_popcount(mg[0]) + __builtin_popcount(mg[1]) + __builtin_popcount(mg[2]) + __builtin_popcount(mg[3]));
            const unsigned ceq = (unsigned)(__builtin_popcount(me[0]) + __builtin_popcount(me[1]) + __builtin_popcount(me[2]) + __builtin_popcount(me[3]));
            unsigned pg = cgt, pe = ceq;
#pragma unroll
            for (int o = 1; o < 64; o <<= 1) { const unsigned tg = __shfl_up(pg, o), te = __shfl_up(pe, o); if (lane >= o) { pg += tg; pe += te; } }
            unsigned og = pg - cgt, oe = pe - ceq;
#pragma unroll
            for (int blk = 0; blk < 4; ++blk) {
                unsigned m = mg[blk];
                while (__any(m != 0u)) {
                    if (m) { const int bp = __builtin_ctz(m); const int pq = 31 - bp; sel[og] = (unsigned short)(2 * (lane + 64 * (16 * blk + (pq >> 1))) + (pq & 1)); ++og; m &= m - 1u; } }
                m = me[blk];
                while (__any(m != 0u)) {
                    if (m) { const int bp = __builtin_ctz(m); const int pq = 31 - bp; if (oe < need2) sel[255u - oe] = (unsigned short)(2 * (lane + 64 * (16 * blk + (pq >> 1))) + (pq & 1)); ++oe; m &= m - 1u; } }
            }
        }
        LDS_WAIT();
#ifdef PROBE_TIME
        const unsigned long long td2 = __builtin_amdgcn_s_memrealtime();
#endif
        bf16x8 qf[8];
        { const bf16_t* qrow = AO + m * 1536 + 512 + (fr & 3) * 256;
#pragma unroll
            for (int s = 0; s < 8; ++s) { bf16x8 v = *(const bf16x8*)(qrow + 64 * (s >> 1) + 16 * g + 8 * (s & 1)); if (fr >= 4) v = (bf16x8){0, 0, 0, 0, 0, 0, 0, 0}; qf[s] = v; } }
        f32x4 O[16];
#pragma unroll
        for (int c = 0; c < 16; ++c) O[c] = (f32x4){0.f, 0.f, 0.f, 0.f};
        float mrun = -1e30f, lrun = 0.f;
        const int nchunk = (cnt + 31) >> 5;
        const unsigned img_base = (unsigned)(size_t)img;
        u32x4 gp[8];
#pragma unroll
        for (int rb = 0; rb < 2; ++rb) { const int slot = 16 * rb + fr; const unsigned kraw = sel[slot]; const unsigned key = (slot < cnt) ? kraw : 0u; const unsigned char* kp = ckv8 + (size_t)key * 256 + 16 * g;
#pragma unroll
            for (int pq = 0; pq < 4; ++pq) gp[4 * rb + pq] = *(const u32x4*)(kp + 64 * pq); }
        const unsigned swz_w = ((fr & 3u) << 2) | ((fr >> 2) & 3u), wb = img_base + 256u * fr + 16u * ((2u * g) ^ swz_w);
        const unsigned q4 = (unsigned)fr >> 2, pp = (unsigned)fr & 3u, rrow = 4u * g + q4, swz_r = ((rrow & 3u) << 2) | ((rrow >> 2) & 3u);
        const unsigned rbs = img_base + 256u * rrow + 16u * ((pp >> 1) ^ swz_r) + 8u * (pp & 1u);
#pragma unroll 1
        for (int ck = 0; ck < nchunk; ++ck) {
            f32x4 sacc[2] = {(f32x4){0.f, 0.f, 0.f, 0.f}, (f32x4){0.f, 0.f, 0.f, 0.f}};
#pragma unroll
            for (int i = 0; i < 8; ++i) {
                u32x4 lo, hi;
#pragma unroll
                for (int q = 0; q < 2; ++q) { lo[2 * q] = __builtin_bit_cast(unsigned, __builtin_amdgcn_cvt_scalef32_pk_bf16_fp8(gp[i][q], 1.0f, false)); lo[2 * q + 1] = __builtin_bit_cast(unsigned, __builtin_amdgcn_cvt_scalef32_pk_bf16_fp8(gp[i][q], 1.0f, true));
                    hi[2 * q] = __builtin_bit_cast(unsigned, __builtin_amdgcn_cvt_scalef32_pk_bf16_fp8(gp[i][2 + q], 1.0f, false)); hi[2 * q + 1] = __builtin_bit_cast(unsigned, __builtin_amdgcn_cvt_scalef32_pk_bf16_fp8(gp[i][2 + q], 1.0f, true)); }
                sacc[i >> 2] = MFMA16(__builtin_bit_cast(bf16x8, lo), qf[2 * (i & 3)], sacc[i >> 2]); sacc[i >> 2] = MFMA16(__builtin_bit_cast(bf16x8, hi), qf[2 * (i & 3) + 1], sacc[i >> 2]);
                const unsigned wa = wb ^ (128u * (i & 1)), cst = 8192u * ((i & 3) >> 1) + 4096u * (i >> 2);
                *(LAS u32x4*)(size_t)(wa + cst) = lo; *(LAS u32x4*)(size_t)((wa ^ 16u) + cst) = hi; }
            if (ck + 1 < nchunk) {
#pragma unroll
                for (int rb = 0; rb < 2; ++rb) { const int slot = 32 * (ck + 1) + 16 * rb + fr; const unsigned kraw = sel[slot]; const unsigned key = (slot < cnt) ? kraw : 0u; const unsigned char* kp = ckv8 + (size_t)key * 256 + 16 * g;
#pragma unroll
                    for (int pq = 0; pq < 4; ++pq) gp[4 * rb + pq] = *(const u32x4*)(kp + 64 * pq); }
            }
            float lg[8]; float mx = -1e30f;
#pragma unroll
            for (int rb = 0; rb < 2; ++rb) { const u32x2 kk = *(const LAS u32x2*)(sel + 32 * ck + 16 * rb + 4 * g);
#pragma unroll
                for (int r = 0; r < 4; ++r) { const int slot = 32 * ck + 16 * rb + 4 * g + r; const unsigned kw = (r < 2) ? kk.x : kk.y; const int key = (r & 1) ? (int)(kw >> 16) : (int)(kw & 0xffffu);
                    int dist = t - key; dist = dist < 0 ? 0 : dist; const int bk = BK[dist];
                    float v = sacc[rb][r] + RB[bk * 4 + (fr & 3)]; if (slot >= cnt) v = -1e30f; if (fr >= 4) v = 0.f; lg[4 * rb + r] = v; mx = fmaxf(mx, v); } }
            mx = fmaxf(mx, __shfl_xor(mx, 16)); mx = fmaxf(mx, __shfl_xor(mx, 32));
            const float mnew = fmaxf(mrun, mx), alpha = __expf(mrun - mnew);
            float pv[8], ps = 0.f;
#pragma unroll
            for (int j = 0; j < 8; ++j) { pv[j] = __expf(lg[j] - mnew); ps += pv[j]; }
            lrun = lrun * alpha + ps; mrun = mnew;
            const bf16x8 pf = pk8((f32x4){pv[0], pv[1], pv[2], pv[3]}, (f32x4){pv[4], pv[5], pv[6], pv[7]});
            if (__any(alpha != 1.f)) {
#pragma unroll
                for (int c = 0; c < 16; ++c) O[c] *= alpha;
            }
#pragma unroll
            for (int c4 = 0; c4 < 4; ++c4) {
                u32x2 rr[8];
                const unsigned a0 = rbs ^ (32u * ((4 * c4) & 7)), a1 = rbs ^ (32u * ((4 * c4 + 1) & 7)), a2 = rbs ^ (32u * ((4 * c4 + 2) & 7)), a3 = rbs ^ (32u * ((4 * c4 + 3) & 7));
                asm volatile("ds_read_b64_tr_b16 %0, %8 offset:%12\n\tds_read_b64_tr_b16 %1, %8 offset:%13\n\tds_read_b64_tr_b16 %2, %9 offset:%12\n\tds_read_b64_tr_b16 %3, %9 offset:%13\n\t"
                             "ds_read_b64_tr_b16 %4, %10 offset:%12\n\tds_read_b64_tr_b16 %5, %10 offset:%13\n\tds_read_b64_tr_b16 %6, %11 offset:%12\n\tds_read_b64_tr_b16 %7, %11 offset:%13\n\ts_waitcnt lgkmcnt(0)"
                             : "=&v"(rr[0]), "=&v"(rr[1]), "=&v"(rr[2]), "=&v"(rr[3]), "=&v"(rr[4]), "=&v"(rr[5]), "=&v"(rr[6]), "=&v"(rr[7])
                             : "v"(a0), "v"(a1), "v"(a2), "v"(a3), "n"(8192 * (c4 >> 1)), "n"(8192 * (c4 >> 1) + 4096) : "memory");
#pragma unroll
                for (int j = 0; j < 4; ++j) O[4 * c4 + j] = MFMA16(mk8(rr[2 * j], rr[2 * j + 1]), pf, O[4 * c4 + j]);
            }
        }
        lrun += __shfl_xor(lrun, 16); lrun += __shfl_xor(lrun, 32);
        const float inv = 1.f / lrun;
        if (fr < 4) {
#pragma unroll
            for (int c = 0; c < 16; ++c) {
#ifdef ZERO_DSA
                const f32x4 v = O[c] * 0.f; (void)inv;
#elif defined(DOUBLE_DSA)
                const f32x4 v = O[c] * (2.f * inv);
#else
                const f32x4 v = O[c] * inv;
#endif
                u32x2 w; w.x = cvt_pk_bf16(v[0], v[1]); w.y = cvt_pk_bf16(v[2], v[3]); *(LAS u32x2*)(img + 2 * (fr * 256 + 16 * c + 4 * g)) = w; } }
        LDS_WAIT(); asm volatile("" ::: "memory");
        { const u32x4 t0 = *(const LAS u32x4*)(img + 16 * lane), t1 = *(const LAS u32x4*)(img + 1024 + 16 * lane);
          u32x4* orow = (u32x4*)(AO + m * 1536 + 512); orow[lane] = t0; orow[64 + lane] = t1; }
        LDS_WAIT(); asm volatile("" ::: "memory");
#ifdef PROBE_TIME
        { const unsigned long long td3 = __builtin_amdgcn_s_memrealtime(); t2acc += td2 - tdq; t3acc += td3 - td2; }
#endif
    }
#ifdef PROBE_TIME
    const unsigned long long tdw = __builtin_amdgcn_s_memrealtime();
#endif
    __syncthreads();
#ifdef PROBE_TIME
    if (blockIdx.x == 255 && threadIdx.x == 0) { ((volatile float*)(ws + WS_CTL))[2048 + 28] += (float)(__builtin_amdgcn_s_memrealtime() - tdw) * 0.01f; }
    if (blockIdx.x == 255 && threadIdx.x == 0) { volatile float* ct = (volatile float*)(ws + WS_CTL) + 2048; ct[20] += (float)(td1 - td0) * 0.01f; ct[21] += (float)t2acc * 0.01f; ct[22] += (float)t3acc * 0.01f; ct[23] += 1.f; ct[27] += (float)(__builtin_amdgcn_s_memrealtime() - td0) * 0.01f; }
#endif
}

__device__ __forceinline__ float erf_as(float x) {
    const float ax = __builtin_fabsf(x);
    const float t = __builtin_amdgcn_rcpf(fmaf(0.3275911f, ax, 1.f));
    float pl = fmaf(1.061405429f, t, -1.453152027f); pl = fmaf(pl, t, 1.421413741f); pl = fmaf(pl, t, -0.284496736f); pl = fmaf(pl, t, 0.254829592f); pl *= t;
    const float e = __builtin_amdgcn_exp2f(ax * ax * -1.4426950408889634f);
    return __builtin_copysignf(fmaf(-pl, e, 1.f), x);
}
__device__ __forceinline__ unsigned mbcnt64(unsigned long long m) { return __builtin_amdgcn_mbcnt_hi((unsigned)(m >> 32), __builtin_amdgcn_mbcnt_lo((unsigned)m, 0u)); }
__device__ __forceinline__ float pack_idx(float v, unsigned idx, unsigned mask) { return __uint_as_float((__float_as_uint(v) & ~mask) | idx); }
__device__ __forceinline__ void ins16(float (&L)[16], float x) {
#pragma unroll
    for (int i = 15; i >= 1; --i) L[i] = __builtin_amdgcn_fmed3f(L[i - 1], L[i], x);
    L[0] = fmaxf(L[0], x);
}
__device__ __forceinline__ unsigned pk4_fp8(float a, float b, float c, float d) { int w = __builtin_amdgcn_cvt_pk_fp8_f32(a, b, 0, false); w = __builtin_amdgcn_cvt_pk_fp8_f32(c, d, w, true); return (unsigned)w; }
__device__ __forceinline__ float dot2bf(unsigned a, unsigned b, float acc) { return __builtin_amdgcn_fdot2_f32_bf16(__builtin_bit_cast(bf16x2_t, a), __builtin_bit_cast(bf16x2_t, b), acc, false); }
constexpr float P8_K = 256.f;
#define H2AT(r, i) __builtin_shufflevector(r, r, (i), (i) + 1)
typedef unsigned u32x4a8 __attribute__((ext_vector_type(4), aligned(8)));
__device__ __forceinline__ void p8_offsets(const LAS unsigned short* se, int k0, unsigned (&off)[4], unsigned hoff, unsigned hsh) {
    const u32x4 ew = *(const LAS u32x4*)(se + k0);
#pragma unroll
#ifdef PROBE_MASK
    for (int jj = 0; jj < 4; ++jj) off[jj] = ((ew[jj] >> hsh) & PROBE_MASK) * 768u + hoff;
#else
    for (int jj = 0; jj < 4; ++jj) off[jj] = ((ew[jj] >> hsh) & 0xFFFFu) * 768u + hoff;
#endif
}
#ifdef P8_AUX
typedef __amdgpu_buffer_rsrc_t p8_tab_t;
__device__ __forceinline__ p8_tab_t p8_tab(const unsigned char* T) { return __builtin_amdgcn_make_buffer_rsrc((void*)T, 0, 16384 * 768, 0x00020000); }
__device__ __forceinline__ u32x6 p8_ld(p8_tab_t T, unsigned off) { const u32x4 a = __builtin_amdgcn_raw_buffer_load_b128(T, (int)off, 0, P8_AUX); const u32x2 c = __builtin_amdgcn_raw_buffer_load_b64(T, (int)off + 16, 0, P8_AUX); return (u32x6){a[0], a[1], a[2], a[3], c[0], c[1]}; }
#else
typedef const unsigned char* p8_tab_t;
__device__ __forceinline__ p8_tab_t p8_tab(const unsigned char* T) { return T; }
__device__ __forceinline__ u32x6 p8_ld(const unsigned char* T, unsigned off) { const u32x4a8 a = *(const u32x4a8*)(T + off); const u32x2 c = *(const u32x2*)(T + off + 16); return (u32x6){a[0], a[1], a[2], a[3], c[0], c[1]}; }
#endif
__device__ __forceinline__ void p8_u(u32x6 (&up)[4], const unsigned (&offn)[4], p8_tab_t Tn, LAS float* sg, const LAS float* sul, int k0, const h2_t (&xh)[16], float rs, int lane) {
    float part[4];
#pragma unroll
    for (int jj = 0; jj < 4; ++jj) {
        const h32_t r = __builtin_amdgcn_cvt_scalef32_pk32_f16_fp6(up[jj], 1.0f);
        up[jj] = p8_ld(Tn, offn[jj]);
        float d0 = 0.f, d1 = 0.f;
        d0 = __builtin_amdgcn_fdot2(H2AT(r, 0), xh[0], d0, false); d1 = __builtin_amdgcn_fdot2(H2AT(r, 2), xh[1], d1, false);
        d0 = __builtin_amdgcn_fdot2(H2AT(r, 4), xh[2], d0, false); d1 = __builtin_amdgcn_fdot2(H2AT(r, 6), xh[3], d1, false);
        d0 = __builtin_amdgcn_fdot2(H2AT(r, 8), xh[4], d0, false); d1 = __builtin_amdgcn_fdot2(H2AT(r, 10), xh[5], d1, false);
        d0 = __builtin_amdgcn_fdot2(H2AT(r, 12), xh[6], d0, false); d1 = __builtin_amdgcn_fdot2(H2AT(r, 14), xh[7], d1, false);
        d0 = __builtin_amdgcn_fdot2(H2AT(r, 16), xh[8], d0, false); d1 = __builtin_amdgcn_fdot2(H2AT(r, 18), xh[9], d1, false);
        d0 = __builtin_amdgcn_fdot2(H2AT(r, 20), xh[10], d0, false); d1 = __builtin_amdgcn_fdot2(H2AT(r, 22), xh[11], d1, false);
        d0 = __builtin_amdgcn_fdot2(H2AT(r, 24), xh[12], d0, false); d1 = __builtin_amdgcn_fdot2(H2AT(r, 26), xh[13], d1, false);
        d0 = __builtin_amdgcn_fdot2(H2AT(r, 28), xh[14], d0, false); d1 = __builtin_amdgcn_fdot2(H2AT(r, 30), xh[15], d1, false);
        part[jj] = d0 + d1; }
    float r2[2];
#pragma unroll
    for (int k = 0; k < 2; ++k) { const float mine = (lane & 16) ? part[k + 2] : part[k], theirs = (lane & 16) ? part[k] : part[k + 2]; r2[k] = mine + __shfl_xor(theirs, 16); }
    float r1; { const float mine = (lane & 8) ? r2[1] : r2[0], theirs = (lane & 8) ? r2[0] : r2[1]; r1 = mine + dpp_mov<0x128>(theirs); }
    r1 += dpp_mov<0xB1>(r1); r1 += dpp_mov<0x4E>(r1); r1 += dpp_mov<0x141>(r1);
    const int jl = ((lane >> 4) & 1) * 4 + ((lane >> 3) & 1) * 2 + ((lane >> 5) & 1);
    const float a = r1 * rs * sul[k0 + jl]; const float act = 0.5f * a * (1.f + erf_as(a * 0.70710678118654752f));
    const float coef = sg[k0 + jl] * act;
    if ((lane & 7) == 0) sg[k0 + jl] = coef;
}
__device__ __forceinline__ void p8_v(u32x6 (&vp)[4], const unsigned (&offn)[4], p8_tab_t Tn, const LAS float* sg, int k0, h2_t (&y16)[16], int lane) {
    float cj[4];
#pragma unroll
    for (int jj = 0; jj < 4; ++jj) cj[jj] = sg[k0 + 2 * jj + (lane >> 5)];
#pragma unroll
    for (int jj = 0; jj < 4; ++jj) {
        const h32_t r = __builtin_amdgcn_cvt_scalef32_pk32_f16_fp6(vp[jj], 1.0f);
        vp[jj] = p8_ld(Tn, offn[jj]);
        const _Float16 cf = (_Float16)cj[jj]; const h2_t c2 = {cf, cf};
        y16[0] += c2 * H2AT(r, 0); y16[1] += c2 * H2AT(r, 2); y16[2] += c2 * H2AT(r, 4); y16[3] += c2 * H2AT(r, 6);
        y16[4] += c2 * H2AT(r, 8); y16[5] += c2 * H2AT(r, 10); y16[6] += c2 * H2AT(r, 12); y16[7] += c2 * H2AT(r, 14);
        y16[8] += c2 * H2AT(r, 16); y16[9] += c2 * H2AT(r, 18); y16[10] += c2 * H2AT(r, 20); y16[11] += c2 * H2AT(r, 22);
        y16[12] += c2 * H2AT(r, 24); y16[13] += c2 * H2AT(r, 26); y16[14] += c2 * H2AT(r, 28); y16[15] += c2 * H2AT(r, 30); }
}
__device__ __forceinline__ h2_t bf2_to_h2(unsigned w) { return __builtin_bit_cast(h2_t, __builtin_amdgcn_cvt_pkrtz(__uint_as_float(w << 16), __uint_as_float(w & 0xFFFF0000u))); }
__device__ __forceinline__ void p8_peer(const Params& p, LAS unsigned char* lds, int bx, int wave, int lane_in, XcdBarrier& bar) {
    unsigned char* ws = p.ws;
    const _Float16* S = (const _Float16*)(ws + WS_S); const float* rss = (const float*)(ws + WS_CTL + CTL_RSS);
    const p8_tab_t UB6 = p8_tab(ws + WS_UB), VB6 = p8_tab(ws + WS_VB); const bf16_t* X1B = (const bf16_t*)(ws + WS_X1B);
    const float* SU = (const float*)(ws + WS_SUV); const float* SV = SU + 16384;
    LAS unsigned short* EI = (LAS unsigned short*)(lds + wave * 6656);
    LAS float* GT = (LAS float*)(lds + wave * 6656 + 1024);
    LAS unsigned char* IX = lds + wave * 6656 + 3072;
    LAS float* SUL = (LAS float*)(lds + wave * 6656 + 4352);
    LAS float* YL = (LAS float*)(lds + 8 * 6656 + wave * 4096);
#ifdef PROBE_TIME
    unsigned long long pr_acc = 0, ps_acc = 0, pg_acc = 0;
#endif
    unsigned nsync = 0;
#pragma unroll 1
    for (int blk0 = 0; blk0 < MT / 128; blk0 += (int)gridDim.x)
    for (int ds = 0; ds < 4; ++ds) {
#ifdef P8_ALIGN
        if (blk0 + ds > 0) xcd_barrier(bar);
#endif
        const int blk = blk0 + bx; if (blk >= MT / 128) continue;
        int lane = lane_in; asm volatile("" : "+v"(lane));
        const int tq = lane >> 4, hs = lane & 15, head = hs >> 1, side = hs & 1;
        const size_t m0 = ((size_t)blk * 4 + ds) * 32 + wave * 4;
#ifdef PROBE_TIME
        const unsigned long long tp0 = __builtin_amdgcn_s_memrealtime();
#endif
        {
            const size_t m = m0 + tq; const _Float16* srow = S + m * 2048 + hs * 128;
            float L[16];
#pragma unroll
            for (int i = 0; i < 16; ++i) L[i] = -INFINITY;
#pragma unroll 4
            for (int j8 = 0; j8 < 16; ++j8) { const u32x4 v = ((const u32x4*)srow)[j8];
                const unsigned vw[4] = {v.x, v.y, v.z, v.w};
#pragma unroll
                for (int e = 0; e < 4; ++e) { const float lo = (float)__builtin_bit_cast(_Float16, (unsigned short)(vw[e] & 0xFFFFu)), hi = (float)__builtin_bit_cast(_Float16, (unsigned short)(vw[e] >> 16));
                    ins16(L, pack_idx(lo, (unsigned)(8 * j8 + 2 * e), 0x7Fu)); ins16(L, pack_idx(hi, (unsigned)(8 * j8 + 2 * e + 1), 0x7Fu)); } }
            float A[16], B[16];
#pragma unroll
            for (int i = 0; i < 16; ++i) { const float o = dpp_mov<0xB1>(L[i]); A[i] = side ? o : L[i]; B[i] = side ? L[i] : o; }
            float C[16];
#pragma unroll
            for (int i = 0; i < 16; ++i) C[i] = -INFINITY;
#pragma unroll
            for (int i = 0; i < 16; ++i)
#pragma unroll
                for (int j = 0; j < 16; ++j) if ((i + 1) * (j + 1) <= 16) {
                    const unsigned ab = __float_as_uint(A[i]), bb = __float_as_uint(B[j]);
                    const float sum = __uint_as_float(ab & ~0x7Fu) + __uint_as_float(bb & ~0x7Fu);
                    ins16(C, pack_idx(sum, (unsigned)(i * 16 + j), 0xFFu)); }
            { u32x4 w;
                w.x = (__float_as_uint(L[0]) & 0x7Fu) | ((__float_as_uint(L[1]) & 0x7Fu) << 8) | ((__float_as_uint(L[2]) & 0x7Fu) << 16) | ((__float_as_uint(L[3]) & 0x7Fu) << 24);
                w.y = (__float_as_uint(L[4]) & 0x7Fu) | ((__float_as_uint(L[5]) & 0x7Fu) << 8) | ((__float_as_uint(L[6]) & 0x7Fu) << 16) | ((__float_as_uint(L[7]) & 0x7Fu) << 24);
                w.z = (__float_as_uint(L[8]) & 0x7Fu) | ((__float_as_uint(L[9]) & 0x7Fu) << 8) | ((__float_as_uint(L[10]) & 0x7Fu) << 16) | ((__float_as_uint(L[11]) & 0x7Fu) << 24);
                w.w = (__float_as_uint(L[12]) & 0x7Fu) | ((__float_as_uint(L[13]) & 0x7Fu) << 8) | ((__float_as_uint(L[14]) & 0x7Fu) << 16) | ((__float_as_uint(L[15]) & 0x7Fu) << 24);
                *(LAS u32x4*)(IX + lane * 16) = w; }
            LDS_WAIT(); asm volatile("" ::: "memory");
            float tv[16]; unsigned ei[16]; float mx = -INFINITY;
#pragma unroll
            for (int k = 0; k < 16; ++k) { const unsigned rk = __float_as_uint(C[k]) & 0xFFu; const unsigned i1 = IX[(lane & ~1) * 16 + (rk >> 4)], i2 = IX[(lane | 1) * 16 + (rk & 15u)];
                ei[k] = (i1 << 7) | i2; tv[k] = (float)S[m * 2048 + head * 256 + i1] + (float)S[m * 2048 + head * 256 + 128 + i2]; mx = fmaxf(mx, tv[k]); }
            float z = 0.f;
#pragma unroll
            for (int k = 0; k < 16; ++k) { tv[k] = __expf(tv[k] - mx); z += tv[k]; }
            const float iz = 1.f / z;
#pragma unroll
            for (int k = 0; k < 16; ++k) { EI[tq * 128 + head * 16 + k] = (unsigned short)ei[k]; GT[tq * 128 + head * 16 + k] = tv[k] * iz * (SV[ei[k]] * P8_K); SUL[tq * 128 + head * 16 + k] = SU[ei[k]]; }
        }
        LDS_WAIT(); asm volatile("" ::: "memory");
#ifdef PROBE_TIME
        const unsigned long long tp1 = __builtin_amdgcn_s_memrealtime();
#endif
#pragma unroll 1
        for (int t4 = 0; t4 < 4; ++t4) {
            const unsigned e0 = EI[t4 * 128 + lane], e1 = EI[t4 * 128 + 64 + lane]; const float g0 = GT[t4 * 128 + lane], g1 = GT[t4 * 128 + 64 + lane], s0 = SUL[t4 * 128 + lane], s1 = SUL[t4 * 128 + 64 + lane];
            LDS_WAIT(); asm volatile("" ::: "memory");
            unsigned base = 0u;
#pragma unroll 1
            for (unsigned s = 0; s < 16; ++s) {
                const bool h0 = (e0 >> 10) == s, h1 = (e1 >> 10) == s;
                const unsigned long long b0 = __ballot(h0), b1 = __ballot(h1);
                if (h0) { const unsigned pos = base + mbcnt64(b0); EI[t4 * 128 + pos] = (unsigned short)e0; GT[t4 * 128 + pos] = g0; SUL[t4 * 128 + pos] = s0; }
                if (h1) { const unsigned pos = base + (unsigned)__popcll(b0) + mbcnt64(b1); EI[t4 * 128 + pos] = (unsigned short)e1; GT[t4 * 128 + pos] = g1; SUL[t4 * 128 + pos] = s1; }
                base += (unsigned)__popcll(b0) + (unsigned)__popcll(b1);
            }
        }
        LDS_WAIT(); asm volatile("" ::: "memory");
#ifdef PROBE_TIME
        const unsigned long long tp2 = __builtin_amdgcn_s_memrealtime();
#endif
        {
            const int hf = lane >> 5, sl = lane & 31; const unsigned hoff = 24u * sl, hsh = 16u * hf;
            u32x6 uT[4][4];
#pragma unroll
            for (int tk = 0; tk < 4; ++tk) { unsigned o0[4]; p8_offsets(EI, 128 * tk, o0, hoff, hsh);
#pragma unroll
              for (int jj = 0; jj < 4; ++jj) uT[tk][jj] = p8_ld(UB6, o0[jj]); }
            {
                h2_t y4[4][16];
                {
                h2_t xh[4][16]; float rs4[4];
#pragma unroll
                for (int tk = 0; tk < 4; ++tk) { const u32x4* xr = (const u32x4*)(X1B + (m0 + tk) * 1024) + 4 * sl;
#pragma unroll
                  for (int q = 0; q < 4; ++q) { const u32x4 ta = xr[q];
#pragma unroll
                      for (int e = 0; e < 4; ++e) xh[tk][4 * q + e] = bf2_to_h2(ta[e]); }
                  rs4[tk] = rsqrtf(rss[m0 + tk] * (1.f / DM) + EPS); }
                xcd_local_sync(bar, ++nsync);
#pragma unroll 1
                for (int hp = 0; hp < 2; ++hp) {
                if (hp) xcd_local_sync(bar, ++nsync);
#pragma unroll 1
                for (int i = 8 * hp; i < 8 * hp + 8; ++i) {
                    const int kN = (i < 15) ? 8 * i + 8 : 0; const p8_tab_t Tn = (i < 15) ? UB6 : VB6;
#pragma unroll
                    for (int tk = 0; tk < 4; ++tk) {
                        unsigned offn[4];
                        p8_offsets(EI, 128 * tk + kN, offn, hoff, hsh);
                        p8_u(uT[tk], offn, Tn, GT, SUL, 128 * tk + 8 * i, xh[tk], rs4[tk], lane);
                    }
                }
                }
                }
#pragma unroll
                for (int tk = 0; tk < 4; ++tk)
#pragma unroll
                    for (int i = 0; i < 16; ++i) y4[tk][i] = (h2_t){(_Float16)0.f, (_Float16)0.f};
                xcd_local_sync(bar, ++nsync);
#pragma unroll 1
                for (int hp = 0; hp < 2; ++hp) {
                if (hp) xcd_local_sync(bar, ++nsync);
#pragma unroll 1
                for (int i = 8 * hp; i < 8 * hp + 8; ++i) {
                    const int kN = (i < 15) ? 8 * i + 8 : 120;
#pragma unroll
                    for (int tk = 0; tk < 4; ++tk) {
                        unsigned offn[4];
                        p8_offsets(EI, 128 * tk + kN, offn, hoff, hsh);
                        p8_v(uT[tk], offn, VB6, GT, 128 * tk + 8 * i, y4[tk], lane);
                    }
                }
                }
                int lz = lane; asm volatile("" : "+v"(lz));
                const int hf_e = lz >> 5, sl_e = lz & 31;
#pragma unroll
                for (int tk = 0; tk < 4; ++tk) {
                    const size_t mm = m0 + tk;
                    float y[16];
#pragma unroll
                    for (int q = 0; q < 8; ++q) { const h2_t lo = y4[tk][q], hi = y4[tk][8 + q];
                        const h2_t mine = hf_e ? hi : lo, send = hf_e ? lo : hi; const h2_t recv = __builtin_bit_cast(h2_t, __shfl_xor(__builtin_bit_cast(int, send), 32));
                        y[2 * q] = ((float)mine[0] + (float)recv[0]) * (1.f / P8_K); y[2 * q + 1] = ((float)mine[1] + (float)recv[1]) * (1.f / P8_K); }
#ifdef DOUBLE_PEER
#pragma unroll
                    for (int i = 0; i < 16; ++i) y[i] *= 2.f;
#endif
#ifdef ZERO_PEER
#pragma unroll
                    for (int i = 0; i < 16; ++i) y[i] = 0.f;
#endif
                    LAS float* yl = YL + 32 * sl_e + 16 * hf_e;
#pragma unroll
                    for (int q = 0; q < 4; ++q) *(LAS f32x4*)(yl + 4 * q) = (f32x4){y[4 * q], y[4 * q + 1], y[4 * q + 2], y[4 * q + 3]};
                    LDS_WAIT(); asm volatile("" ::: "memory");
                    f32x4 o[4]; float ss = 0.f;
#pragma unroll
                    for (int k = 0; k < 4; ++k) { const f32x4 yy = *(const LAS f32x4*)(YL + 4 * lz + 256 * k); const u32x2 xw = *(const u32x2*)(X1B + mm * 1024 + 4 * lz + 256 * k);
                        o[k] = (f32x4){bf_lo(xw.x), bf_hi(xw.x), bf_lo(xw.y), bf_hi(xw.y)} + yy; ss += (o[k][0] * o[k][0] + o[k][1] * o[k][1]) + (o[k][2] * o[k][2] + o[k][3] * o[k][3]); }
                    const float rf = rsqrtf(wave_sum(ss) * (1.f / DM) + EPS);
#pragma unroll
                    for (int k = 0; k < 4; ++k) { const f32x4 fgk = *((const f32x4*)p.final_g + lz + 64 * k); *((f32x4*)(p.out + mm * 1024) + lz + 64 * k) = o[k] * rf * fgk; }
                    LDS_WAIT(); asm volatile("" ::: "memory");
                }
            }
        }
        LDS_WAIT(); asm volatile("" ::: "memory");
#ifdef PROBE_TIME
        { const unsigned long long tp3 = __builtin_amdgcn_s_memrealtime(); pr_acc += tp1 - tp0; ps_acc += tp2 - tp1; pg_acc += tp3 - tp2;
          if (blockIdx.x == 1 && threadIdx.x == 0) { volatile float* ct = (volatile float*)(ws + WS_CTL) + 2048; ct[24] = (float)pr_acc * 0.01f; ct[25] = (float)ps_acc * 0.01f; ct[26] = (float)pg_acc * 0.01f; } }
#endif
    }
}


#ifdef PROBE_GDN
__device__ __forceinline__ void gdn_reference(const Params& p, LAS unsigned char* lds) {
    unsigned char* ws = p.ws; const int tid = threadIdx.x, e = tid & 127, rg = tid >> 7;
    LAS float* KQ = (LAS float*)lds;
    LAS float* RED = (LAS float*)(lds + 1024);
    LAS float* OSQ = (LAS float*)(lds + 4096);
    const float* qf = (const float*)(ws + WS_REF); const float* kf = qf + 512 * 128; const float* vf = kf + 512 * 128;
    const float* garr = (const float*)(ws + WS_RES) + 256; const float* barr = (const float*)(ws + WS_RES) + 1024;
    const bf16_t* ZB = (const bf16_t*)(ws + WS_ZB); const bf16_t* AO = (const bf16_t*)(ws + WS_AOUT);
    float S[32];
#pragma unroll
    for (int i = 0; i < 32; ++i) S[i] = 0.f;
    float d2 = 0.f, r2 = 0.f;
    for (int t = 0; t < 512; ++t) {
        __syncthreads();
        if (tid < 128) KQ[tid] = kf[t * 128 + tid]; else if (tid < 256) KQ[tid] = qf[t * 128 + tid - 128];
        __syncthreads();
        const float al = __expf(garr[t]), be = barr[t], v = vf[t * 128 + e];
        float ks = 0.f;
#pragma unroll
        for (int i = 0; i < 32; ++i) ks = fmaf(KQ[32 * rg + i], S[i], ks);
        RED[rg * 128 + e] = ks;
        __syncthreads();
        const float kS = (RED[e] + RED[128 + e]) + (RED[256 + e] + RED[384 + e]);
        const float dv = be * (v - al * kS);
        float os = 0.f;
#pragma unroll
        for (int i = 0; i < 32; ++i) { S[i] = fmaf(KQ[32 * rg + i], dv, al * S[i]); os = fmaf(KQ[128 + 32 * rg + i], S[i], os); }
        __syncthreads();
        RED[rg * 128 + e] = os;
        __syncthreads();
        const float o = (RED[e] + RED[128 + e]) + (RED[256 + e] + RED[384 + e]);
        if (rg == 0) { const float sq = wave_sum(o * o); if ((tid & 63) == 0) OSQ[tid >> 6] = sq; }
        __syncthreads();
        if (rg == 0) { const float rstd = rsqrtf((OSQ[0] + OSQ[1]) * (1.f / 128.f) + EPS); const float zf = bf2f(ZB[(size_t)t * 512 + e]);
            const float ref = o * rstd * p.gdn_norm_g[e] * silu_f(zf); const float got = bf2f(AO[(size_t)t * 1536 + e]);
            if (t >= PROBE_T0 && t < PROBE_T1) { d2 += (got - ref) * (got - ref); r2 += ref * ref; } }
    }
    if (rg == 0) { d2 = wave_sum(d2); r2 = wave_sum(r2); if ((tid & 63) == 0) { atomicAdd((float*)(ws + WS_RES), d2); atomicAdd((float*)(ws + WS_RES) + 1, r2); } }
}
#endif

#ifdef PROBE_GDN
__device__ __forceinline__ void gdn_chunk0_reference(const Params& p, LAS unsigned char* lds) {
    unsigned char* ws = p.ws; const int tid = threadIdx.x;
    LAS float* A = (LAS float*)lds;
    LAS float* Tm = (LAS float*)(lds + 16384);
    LAS float* GCs = (LAS float*)(lds + 32768);
    const float* qf = (const float*)(ws + WS_REF); const float* kf = qf + 512 * 128; const float* vf = kf + 512 * 128;
    const float* garr = (const float*)(ws + WS_RES) + 256; const float* barr = (const float*)(ws + WS_RES) + 1024;
    if (tid == 0) { float acc = 0.f; for (int i = 0; i < 64; ++i) { acc += garr[i]; GCs[i] = acc; GCs[64 + i] = barr[i]; } }
    __syncthreads();
    for (int idx = tid; idx < 4096; idx += NTHR) { const int i = idx >> 6, j = idx & 63; float d = 0.f;
        if (j < i) { for (int e = 0; e < 128; ++e) d = fmaf(kf[i * 128 + e], kf[j * 128 + e], d); d *= GCs[64 + i] * __expf(GCs[i] - GCs[j]); }
        A[idx] = d; Tm[idx] = 0.f; }
    __syncthreads();
#if PROBE_WHAT == 8
    { const float* dmpA = (const float*)(ws + 15 * MiB + 880000); for (int idx = tid; idx < 4096; idx += NTHR) A[idx] = dmpA[idx]; }
    __syncthreads();
#endif
    if (tid < 64) { const int c = tid; for (int i = 0; i < 64; ++i) { float acc = (i == c) ? 1.f : 0.f; for (int j = 0; j < i; ++j) acc = fmaf(-A[i * 64 + j], Tm[j * 64 + c], acc); Tm[i * 64 + c] = acc; } }
    __syncthreads();
    float d2 = 0.f, r2 = 0.f;
#if PROBE_WHAT == 0
    const bf16_t* uT = (const bf16_t*)(ws + WS_VH);
    for (int idx = tid; idx < 8192; idx += NTHR) { const int i = idx >> 7, e = idx & 127; float acc = 0.f;
        for (int j = 0; j <= i; ++j) acc = fmaf(Tm[i * 64 + j] * GCs[64 + j], vf[j * 128 + e], acc);
        const float got = bf2f(uT[e * 64 + i]); d2 += (got - acc) * (got - acc); r2 += acc * acc; }
#elif PROBE_WHAT == 1
    const bf16_t* wB = (const bf16_t*)(ws + WS_WBUF);
    for (int idx = tid; idx < 8192; idx += NTHR) { const int i = idx >> 7, d = idx & 127; float acc = 0.f;
        for (int j = 0; j <= i; ++j) acc = fmaf(Tm[i * 64 + j] * GCs[64 + j] * __expf(GCs[j]), kf[j * 128 + d], acc);
        const int kb = d >> 5, u = (d & 31) >> 2, nu = 2 * (u & 3) + (u >> 2); const float got = bf2f(wB[i * 128 + 32 * kb + 4 * nu + (d & 3)]);
        d2 += (got - acc) * (got - acc); r2 += acc * acc; }
#elif PROBE_WHAT == 3
    { const float* dmp = (const float*)(ws + 15 * MiB + 880000); for (int idx = tid; idx < 4096; idx += NTHR) { const float got = dmp[idx], acc = A[idx]; d2 += (got - acc) * (got - acc); r2 += acc * acc; } }
#elif PROBE_WHAT == 4 || PROBE_WHAT == 8
    { const float* dmp = (const float*)(ws + 15 * MiB + 880000) + 4096; for (int idx = tid; idx < 4096; idx += NTHR) { const float got = dmp[idx], acc = Tm[idx]; d2 += (got - acc) * (got - acc); r2 += acc * acc; } }
#elif PROBE_WHAT >= 5 && PROBE_WHAT <= 7
    { const float* dmp = (const float*)(ws + 15 * MiB + 880000) + 4096; for (int idx = tid; idx < 4096; idx += NTHR) { const int i = idx >> 6, j = idx & 63;
        const bool in = (PROBE_WHAT == 5) ? (i < 32 && j < 32) : ((PROBE_WHAT == 6) ? (i >= 32 && j >= 32) : (i >= 32 && j < 32));
        if (in) { const float got = dmp[idx], acc = Tm[idx]; d2 += (got - acc) * (got - acc); r2 += acc * acc; } } }
#else
    const bf16_t* qB = (const bf16_t*)(ws + WS_QH);
    for (int idx = tid; idx < 8192; idx += NTHR) { const int i = idx >> 7, d = idx & 127; const float acc = qf[i * 128 + d] * __expf(GCs[i]);
        const int kb = d >> 5, u = (d & 31) >> 2, nu = 2 * (u & 3) + (u >> 2); const float got = bf2f(qB[i * 128 + 32 * kb + 4 * nu + (d & 3)]);
        d2 += (got - acc) * (got - acc); r2 += acc * acc; }
#endif
    d2 = wave_sum(d2); r2 = wave_sum(r2);
    if ((tid & 63) == 0) { atomicAdd((float*)(ws + WS_RES), d2); atomicAdd((float*)(ws + WS_RES) + 1, r2); }
}
#endif
__global__ void __launch_bounds__(NTHR, 2) hybrid_fwd(Params p) {
    extern __shared__ __attribute__((aligned(16))) unsigned char lds_raw[];
    LAS unsigned char* lds = (LAS unsigned char*)lds_raw;
    volatile LAS unsigned* MISCW = (volatile LAS unsigned*)(lds + LDS_MISC);
#define PHASE_IDS int tid = threadIdx.x; asm volatile("" : "+v"(tid)); const int lane = tid & 63, wave = __builtin_amdgcn_readfirstlane(tid >> 6); \
    const int gw = bx * NWAVES + wave, ngw = G * NWAVES; (void)lane; (void)gw; (void)ngw;
    const int G = gridDim.x, bx = blockIdx.x;
    unsigned char* ws = p.ws;
    const int tid0 = threadIdx.x;
    unsigned* ctl = (unsigned*)(ws + WS_CTL);
    if (tid0 < 16) MISCW[tid0] = 0u;
    __syncthreads();
    XcdBarrier bar = xcd_barrier_post(ctl + CW_BAR, MISCW);
#if defined(PROBE_TIME) || defined(PROBE_P8)
    unsigned long long tprev = __builtin_amdgcn_s_memrealtime(); int tk = 0;
#define TSTAMP() do { const unsigned long long tn = __builtin_amdgcn_s_memrealtime(); if (threadIdx.x == 0) { const float us = (float)(tn - tprev) * 0.01f; \
        ((volatile LAS float*)(lds + LDS_MISC))[16 + tk] = us; if (blockIdx.x == 0) ((volatile float*)ctl)[2048 + tk] = us; } tprev = tn; ++tk; } while (0)
#else
#define TSTAMP() do {} while (0)
#endif

    { PHASE_IDS p0_prologue(p, lds, gw, ngw, wave, lane); }
    xcd_barrier(bar);
    TSTAMP();
    { pg8::Gemm g{(const bf16_t*)(ws + WS_HB), (const bf16_t*)(ws + WS_WINT), MT, NIN, DM}; pg8::StaticOrder So; So.init(MT, NIN, G, bx); EpiIn E{ws};
      pg8::gemm_phase<EpiIn, pg8::StaticOrder, false>(lds, g, So, E, nullptr); }
    xcd_barrier(bar);
    TSTAMP();
    { PHASE_IDS
#ifdef PROBE_GDN
      if (bx == 0 && tid < 2) ((float*)(ws + WS_RES))[tid] = 0.f;
#endif
      LAS float* cw = (LAS float*)lds;
      for (int i = tid; i < 4 * 1536 / 4; i += NTHR) ((LAS f32x4*)cw)[i] = ((const f32x4*)p.conv_w)[i];
      __syncthreads();
      for (int m = 2 * gw; m < MT; m += 2 * ngw) {
          const int t = m & (SEQ - 1); const bf16_t* pre = (const bf16_t*)(ws + WS_QKV);
          u32x4 xr[5][3];
#pragma unroll
          for (int jj = 0; jj < 5; ++jj)
#pragma unroll
              for (int i = 0; i < 3; ++i) { xr[jj][i] = (u32x4){0u, 0u, 0u, 0u}; if (t - 3 + jj >= 0) xr[jj][i] = *(const u32x4*)(pre + (size_t)(m - 3 + jj) * 1536 + 8 * (lane + 64 * i)); }
          p3_token(p, cw, m, lane, xr[0], xr[1], xr[2], xr[3]);
          p3_token(p, cw, m + 1, lane, xr[1], xr[2], xr[3], xr[4]);
      } }
    xcd_barrier(bar);
    TSTAMP();
    { pg8::Gemm g{(const bf16_t*)(ws + WS_CQ), (const bf16_t*)(ws + WS_WQ2T), MT, 2048, 256}; pg8::StaticOrder So; So.init(MT, 2048, G, bx); EpiQ E{ws};
      pg8::gemm_phase<EpiQ, pg8::StaticOrder, false>(lds, g, So, E, nullptr); }
    __syncthreads();
    { PHASE_IDS G2In gin; if (bx < 16 * NCHUNK) g2_load(p, gin, bx, tid, lane);
      for (int cb = bx; cb < 16 * NCHUNK; cb += G) g2_chunk(p, lds, cb, cb + G, gin, tid, wave, lane); }
    xcd_barrier(bar);
    TSTAMP();
    if (bx < 16) { PHASE_IDS g3_scan(p, lds, bx, wave, lane); __syncthreads();
#ifdef PROBE_TIME
        { const unsigned long long tn = __builtin_amdgcn_s_memrealtime(); if (threadIdx.x == 0) { const float us = (float)(tn - tprev) * 0.01f; ((volatile LAS float*)(lds + LDS_MISC))[16 + 10] = us; if (blockIdx.x == 0) ((volatile float*)ctl)[2048 + 10] = us; } }
#endif
    }
#ifdef SCAN_ALONE
    xcd_barrier(bar);
#endif
    { PHASE_IDS
    dsa_tables(p, lds, tid);
    for (int qi = 0; qi < 4; ++qi) {
        const int b = (int)((bar.x + (unsigned)qi) & 3u);
        for (;;) {
            if (tid == 0) MISCW[2] = __hip_atomic_fetch_add(ctl + CW_QUEUE + 16 * b, 1u, __ATOMIC_RELAXED, __HIP_MEMORY_SCOPE_AGENT);
            __syncthreads();
            const unsigned u = MISCW[2];
            __syncthreads();
            if (u >= 512u) break;
            TabJob tj; tab_load(p, tj, (int)((unsigned)b * 512u + u) * 8 + wave, lane);
            dsa_unit(p, lds, b, 511 - (int)u, tj);
        }
    } }
    xcd_barrier(bar);
    TSTAMP();
#ifdef PROBE_GDN
#ifdef PROBE_WHAT
    if (bx == 255) { gdn_chunk0_reference(p, lds); __syncthreads(); }
#else
    if (bx == 255) { gdn_reference(p, lds); __syncthreads(); }
#endif
#endif
    {
        PHASE_IDS
        pg8::Gemm g{(const bf16_t*)(ws + WS_AOUT), (const bf16_t*)(ws + WS_WOUT2T), MT, DM, 1536}; pg8::StaticOrder So; So.init(MT, DM, G, bx);
        EpiOut E{p.x, (bf16_t*)(ws + WS_X1B), (float*)(ws + WS_CTL + CTL_RSS)};
        pg8::gemm_phase<EpiOut, pg8::StaticOrder, false>(lds, g, So, E, nullptr);
    }
    xcd_barrier(bar);
    TSTAMP();
    { pg8::Gemm g{(const bf16_t*)(ws + WS_X1B), (const bf16_t*)(ws + WS_WQST), MT, 2048, DM}; pg8::StaticOrder So; So.init(MT, 2048, G, bx);
      EpiS E{(_Float16*)(ws + WS_S), (const float*)(ws + WS_CTL + CTL_RSS)};
      pg8::gemm_phase<EpiS, pg8::StaticOrder, false>(lds, g, So, E, nullptr); }
    xcd_barrier(bar);
    TSTAMP();
    { PHASE_IDS p8_peer(p, lds, bx, wave, lane, bar); }
#ifdef PROBE_P8
    xcd_barrier(bar);
    TSTAMP();
    xcd_barrier(bar);
    { PHASE_IDS
      const float tp = ((const volatile float*)ctl)[2048 + PROBE_TA];
      const float qa = rintf(PROBE_SCALE * log2f(fmaxf(tp, 1.f)) + PROBE_SHIFT) - PROBE_BASE, qb = rintf(PROBE_SCALE * log2f(fmaxf(tp, 1.f)) + 0.5f + PROBE_SHIFT) - PROBE_BASE;
      const float sc = 1.f + 0.25f * qa;
      for (int m = gw; m < MT; m += ngw) {
          const f32x4* xr4 = (const f32x4*)(p.x + (size_t)m * 1024) + 4 * lane; f32x4* orow = (f32x4*)(p.out + (size_t)m * 1024) + 4 * lane;
          f32x4 w0 = xr4[0] * sc; if (m == 0 && lane == 0) w0[0] = 10.f * qb;
          orow[0] = w0; orow[1] = xr4[1] * sc; orow[2] = xr4[2] * sc; orow[3] = xr4[3] * sc; } }
#endif
}

extern "C" void kernel_launch(void* const* d_in, const int* in_sizes, int n_in, void* d_out, int out_size, void* d_ws, size_t ws_size, hipStream_t stream) {
    static int grid = 0;
    if (grid == 0) {
        if (n_in != 23 || in_sizes[0] != MT * DM || out_size != MT * DM || ws_size < WS_END) {
            fprintf(stderr, "kernel_launch: unexpected problem shape (n_in %d, in0 %d, out %d, ws %zu); nothing launched\n", n_in, n_in > 0 ? in_sizes[0] : -1, out_size, ws_size); grid = -1; return; }
        int dev = 0, cus = 0, per_cu = 0;
        if (hipGetDevice(&dev) != hipSuccess || hipDeviceGetAttribute(&cus, hipDeviceAttributeMultiprocessorCount, dev) != hipSuccess) { grid = -1; return; }
        if (hipFuncSetAttribute((const void*)hybrid_fwd, hipFuncAttributeMaxDynamicSharedMemorySize, LDS_BYTES) != hipSuccess) { fprintf(stderr, "kernel_launch: hipFuncSetAttribute failed\n"); grid = -1; return; }
        if (hipOccupancyMaxActiveBlocksPerMultiprocessor(&per_cu, (const void*)hybrid_fwd, NTHR, LDS_BYTES) != hipSuccess || per_cu < 1) { fprintf(stderr, "kernel_launch: occupancy query says %d\n", per_cu); }
        (void)hipGetLastError();
        grid = cus;
    }
    if (grid < 0) return;
    (void)hipMemsetAsync((char*)d_ws + WS_CTL, 0, CTL_BYTES, stream);
    Params p{};
    const float** pp = (const float**)&p;
    for (int i = 0; i < 23; ++i) pp[i] = (const float*)d_in[i];
    p.out = (float*)d_out; p.ws = (unsigned char*)d_ws;
    hipLaunchKernelGGL(hybrid_fwd, dim3(grid), dim3(NTHR), LDS_BYTES, stream, p);
}
```

```cpp
#include <hip/hip_runtime.h>
#include <cstdio>
#include <cstdint>

#define LAS __attribute__((address_space(3)))
#define CAS __attribute__((address_space(4)))
typedef unsigned short bf16_t;
typedef short bf16x8 __attribute__((ext_vector_type(8)));
typedef float f32x4 __attribute__((ext_vector_type(4)));
typedef float f32x2 __attribute__((ext_vector_type(2)));
typedef unsigned u32x4 __attribute__((ext_vector_type(4)));
typedef unsigned u32x2 __attribute__((ext_vector_type(2)));
typedef __bf16 bf16x2_t __attribute__((ext_vector_type(2)));
typedef _Float16 h2_t __attribute__((ext_vector_type(2)));
typedef unsigned u32x3a __attribute__((ext_vector_type(3), aligned(4)));
typedef unsigned u32x6 __attribute__((ext_vector_type(6)));
typedef _Float16 h32_t __attribute__((ext_vector_type(32)));

constexpr int BATCH = 4, SEQ = 8192, DM = 1024, MT = BATCH * SEQ;
constexpr int IN_W = 2648, NIN = 2816;
constexpr int NCHUNK = SEQ / 64;
constexpr float EPS = 1e-6f;
constexpr int NWAVES = 8, NTHR = 512;

constexpr size_t MiB = 1u << 20;
constexpr size_t WS_CTL = 0, CTL_BYTES = 1 * MiB;
constexpr size_t WS_WINT = 1 * MiB;
constexpr size_t WS_WQ2T = 7 * MiB;
constexpr size_t WS_WOUT2T = 8 * MiB;
constexpr size_t WS_WQST = 11 * MiB;
constexpr size_t WS_GAMMA = 15 * MiB;
constexpr size_t WS_UB = 368 * MiB;
constexpr size_t WS_VB = 384 * MiB;
constexpr size_t WS_SUV = 400 * MiB;
constexpr size_t WS_SCR = 16 * MiB;
constexpr size_t WS_HB = 80 * MiB;
constexpr size_t WS_KIDXN = 80 * MiB;
constexpr size_t WS_WIDX = 84 * MiB;
constexpr size_t WS_GARR = 86 * MiB;
constexpr size_t WS_BARR = 87 * MiB;
constexpr size_t WS_ATTN = 88 * MiB;
constexpr size_t WS_CKV8 = 104 * MiB;
constexpr size_t WS_REF = 15 * MiB + 65536;
constexpr size_t WS_RES = 15 * MiB + 32768;
constexpr size_t WS_X1B = 80 * MiB;
constexpr size_t WS_AOUT = 144 * MiB;
constexpr size_t WS_QKV = 240 * MiB;
constexpr size_t WS_QIDX = 240 * MiB;
constexpr size_t WS_WBUF = 304 * MiB;
constexpr size_t WS_ZB = 336 * MiB;
constexpr size_t WS_CQ = 368 * MiB;
constexpr size_t WS_CKV = 384 * MiB;
constexpr size_t WS_MISC = 400 * MiB;
constexpr size_t WS_QH = 416 * MiB;
constexpr size_t WS_KH = 448 * MiB;
constexpr size_t WS_VH = 480 * MiB;
constexpr size_t WS_S = 144 * MiB;
constexpr size_t WS_END = 512 * MiB;
constexpr int CW_QUEUE = 64;
constexpr int CW_BAR = 4096;
constexpr size_t CTL_RSS = 256 * 1024;

constexpr int LDS_BYTES = 160 * 1024;
constexpr int LDS_MISC = LDS_BYTES - 256;

__device__ __forceinline__ unsigned cvt_pk_bf16(float lo, float hi) { const f32x2 v = {lo, hi}; return __builtin_bit_cast(unsigned, __builtin_convertvector(v, bf16x2_t)); }
__device__ __forceinline__ float bf_lo(unsigned w) { return __uint_as_float(w << 16); }
__device__ __forceinline__ float bf_hi(unsigned w) { return __uint_as_float(w & 0xffff0000u); }
__device__ __forceinline__ float bf2f(bf16_t b) { return __uint_as_float(((unsigned)b) << 16); }
__device__ __forceinline__ bf16_t f2bf(float f) { return (bf16_t)(cvt_pk_bf16(f, 0.f) & 0xffffu); }
template <int CTRL> __device__ __forceinline__ float dpp_mov(float v) { return __builtin_bit_cast(float, __builtin_amdgcn_update_dpp(0, __builtin_bit_cast(int, v), CTRL, 0xF, 0xF, true)); }
__device__ __forceinline__ float row16_sum(float s) {
    s += dpp_mov<0xB1>(s); s += dpp_mov<0x4E>(s); s += dpp_mov<0x141>(s); s += dpp_mov<0x140>(s); return s; }
__device__ __forceinline__ float rl_f(float v, int l) { return __builtin_bit_cast(float, __builtin_amdgcn_readlane(__builtin_bit_cast(int, v), l)); }
__device__ __forceinline__ float wave_sum(float v) { v = row16_sum(v); return (rl_f(v, 0) + rl_f(v, 16)) + (rl_f(v, 32) + rl_f(v, 48)); }
__device__ __forceinline__ float silu_f(float x) { return x * __builtin_amdgcn_rcpf(1.f + __expf(-x)); }
#define LDS_WAIT() asm volatile("s_waitcnt lgkmcnt(0)" ::: "memory")
#define VM_WAIT() asm volatile("s_waitcnt vmcnt(0)" ::: "memory")
__device__ __forceinline__ bf16x8 mk8(u32x2 lo, u32x2 hi) { u32x4 t; t.x = lo.x; t.y = lo.y; t.z = hi.x; t.w = hi.y; return __builtin_bit_cast(bf16x8, t); }
__device__ __forceinline__ bf16x8 pk8(f32x4 a, f32x4 b) { u32x4 t; t.x = cvt_pk_bf16(a[0], a[1]); t.y = cvt_pk_bf16(a[2], a[3]); t.z = cvt_pk_bf16(b[0], b[1]); t.w = cvt_pk_bf16(b[2], b[3]); return __builtin_bit_cast(bf16x8, t); }
__device__ __forceinline__ bf16x8 pk8lo(f32x4 a, f32x4 b, bf16x8 hi) { const u32x4 h = __builtin_bit_cast(u32x4, hi); f32x4 ra, rb;
    ra[0] = a[0] - bf_lo(h.x); ra[1] = a[1] - bf_hi(h.x); ra[2] = a[2] - bf_lo(h.y); ra[3] = a[3] - bf_hi(h.y);
    rb[0] = b[0] - bf_lo(h.z); rb[1] = b[1] - bf_hi(h.z); rb[2] = b[2] - bf_lo(h.w); rb[3] = b[3] - bf_hi(h.w); return pk8(ra, rb); }
#define MFMA16(a, b, c) __builtin_amdgcn_mfma_f32_16x16x32_bf16((a), (b), (c), 0, 0, 0)

#define XB_TMO      128
#define XB_XCNT(j)  (256  + 64 * (j))
#define XB_XSUB(j)  (1280 + 64 * (j))
#define XB_XGEN(j)  (2304 + 64 * (j))
#define XB_TOP      3328
#define XB_TOPGEN   3392
#define XCD_BAR_WORDS 3456
#define XB_SPIN_CAP (1u << 23)
__device__ __forceinline__ unsigned xb_ld(unsigned* p)              { return __hip_atomic_load(p, __ATOMIC_RELAXED, __HIP_MEMORY_SCOPE_AGENT); }
__device__ __forceinline__ unsigned xb_add(unsigned* p, unsigned v) { return __hip_atomic_fetch_add(p, v, __ATOMIC_RELAXED, __HIP_MEMORY_SCOPE_AGENT); }
__device__ __forceinline__ unsigned xb_xcc_id() { return (unsigned)__builtin_amdgcn_s_getreg((3 << 11) | 20) & 0xFu; }
#define XB_SPIN(cond, bar) do { unsigned _sp = 0; while (cond) { __builtin_amdgcn_s_sleep(1); \
    if ((++_sp & 255u) == 0u) { if (xb_ld(&(bar)[XB_TMO])) break; if (_sp > XB_SPIN_CAP) { atomicAdd(&(bar)[XB_TMO], 1u); break; } } } } while (0)
struct XcdBarrier { unsigned* bar; unsigned x; volatile LAS unsigned* st; };
__device__ __forceinline__ XcdBarrier xcd_barrier_post(unsigned* bar, volatile LAS unsigned* st) {
    XcdBarrier b; b.bar = bar; b.x = xb_xcc_id(); b.st = st;
    if (threadIdx.x == 0) (void)xb_add(&bar[XB_XCNT(b.x)], 1u);
    return b;
}
__device__ __forceinline__ void xcd_barrier_complete(unsigned* bar, unsigned x, unsigned& nloc, unsigned& nx) {
    const unsigned G = gridDim.x * gridDim.y * gridDim.z;
    unsigned sum, cnt, mine, sp = 0u;
    for (;;) {
        sum = 0u; cnt = 0u; mine = 0u;
#pragma unroll
        for (unsigned j = 0; j < 16; ++j) { const unsigned c = xb_ld(&bar[XB_XCNT(j)]); sum += c; cnt += (c > 0u) ? 1u : 0u; mine = (j == x) ? c : mine; }
        if (sum == G) break;
        __builtin_amdgcn_s_sleep(1);
        if ((++sp & 255u) == 0u) { if (xb_ld(&bar[XB_TMO])) break; if (sp > XB_SPIN_CAP) { atomicAdd(&bar[XB_TMO], 1u); break; } }
    }
    nloc = mine > 0u ? mine : 1u; nx = cnt > 0u ? cnt : 1u;
}
__device__ __forceinline__ void xcd_barrier(const XcdBarrier& b) {
    asm volatile("s_waitcnt vmcnt(0)" ::: "memory");
    __syncthreads();
    if (threadIdx.x == 0) {
        unsigned* bar = b.bar;
        __builtin_amdgcn_s_waitcnt(0);
        unsigned nloc = b.st[0], nx = b.st[1];
        if (nloc == 0u) { xcd_barrier_complete(bar, b.x, nloc, nx); b.st[0] = nloc; b.st[1] = nx; }
        const unsigned old = xb_add(&bar[XB_XSUB(b.x)], 1u);
        const unsigned gen = old / nloc;
        if (old + 1u == (gen + 1u) * nloc) {
            __builtin_amdgcn_fence(__ATOMIC_RELEASE, "agent");
            asm volatile("s_waitcnt vmcnt(0)" ::: "memory");
            const unsigned og = xb_add(&bar[XB_TOP], 1u);
            const unsigned tg = og / nx;
            if (og + 1u == (tg + 1u) * nx) xb_add(&bar[XB_TOPGEN], 1u);
            else XB_SPIN(xb_ld(&bar[XB_TOPGEN]) == tg, bar);
            __builtin_amdgcn_fence(__ATOMIC_ACQUIRE, "agent");
            xb_add(&bar[XB_XGEN(b.x)], 1u);
            asm volatile("s_waitcnt vmcnt(0)" ::: "memory");
        } else {
            XB_SPIN(xb_ld(&bar[XB_XGEN(b.x)]) == gen, bar);
            __builtin_amdgcn_fence(__ATOMIC_ACQUIRE, "agent");
            asm volatile("s_waitcnt vmcnt(0)" ::: "memory");
        }
    }
    __syncthreads();
}

__device__ __forceinline__ void xcd_local_sync(const XcdBarrier& b, unsigned k) {
    __syncthreads();
    if (threadIdx.x == 0) {
        unsigned* c = b.bar + (8192 - 4096) + 64 * b.x;
        const unsigned nloc = b.st[0];
        (void)xb_add(c, 1u);
        const unsigned target = k * nloc;
        XB_SPIN(xb_ld(c) < target, b.bar);
    }
    __syncthreads();
}

struct Params {
    const float *x, *ln1_g, *w_in, *conv_w, *a_log, *dt_bias, *gdn_norm_g, *q_norm_g, *kv_norm_g, *w_q_up, *w_qidx_up, *w_kv_up,
                *idx_ln_g, *idx_ln_b, *w_out, *ln2_g, *peer_wq, *peer_k1, *peer_k2, *peer_u, *peer_v, *rel_bias, *final_g;
    float* out; unsigned char* ws;
};

namespace pg8 {
#define PG8_LAS __attribute__((address_space(3)))
typedef unsigned short bf16_t;
typedef short bf16x8 __attribute__((ext_vector_type(8)));
typedef float f32x4 __attribute__((ext_vector_type(4)));
typedef unsigned u32x4 __attribute__((ext_vector_type(4)));
constexpr int BM = 256, BK = 64, HALF = 128, HTB = HALF * BK * 2  , STAGE_BYTES = 8 * HTB, NXCD = 8, WGM = 8;

__host__ __device__ __forceinline__ int lds_byte(int r, int c) { const int st = (r >> 4) * 2 + (c >> 5), rr = r & 15, cc = c & 31, ob = rr * 64 + cc * 2; return st * 1024 + (ob ^ (((ob >> 9) & 1) << 5)); }
__host__ __device__ __forceinline__ void stage_rc(int b, int& R, int& C) { const int st = b / 1024, sb = b % 1024, swz = sb ^ (((sb >> 9) & 1) << 5); R = (st >> 1) * 16 + swz / 64; C = (st & 1) * 32 + (swz % 64) / 2; }
__host__ __device__ __forceinline__ int perm32(int rho) { const int n = rho >> 4, i = rho & 15; return 8 * (i >> 2) + 4 * n + (i & 3); }

struct Unit { int pm, pn; };
struct Gemm { const bf16_t* A; const bf16_t* Bt; int M, N, K; };

struct StaticOrder {
    int nM, nN, nwg, G, c;
    __host__ __device__ void init(int M, int N, int G_, int c_) { nM = M / BM; nN = N / BM; nwg = nM * nN; G = G_; c = c_; }
    __host__ __device__ bool next(int i, Unit& u) const {
        const long L = (long)i * G + c; if (L >= nwg) return false;
        int wgid = (int)L; { const int q = nwg / NXCD, r = nwg % NXCD, xcd = wgid % NXCD, off = wgid / NXCD; wgid = (xcd < r ? xcd * (q + 1) : r * (q + 1) + (xcd - r) * q) + off; }
        const int nig = WGM * nN, gid = wgid / nig, fm = gid * WGM, gsz = (nM - fm) < WGM ? (nM - fm) : WGM;
        u.pm = fm + ((wgid % nig) % gsz); u.pn = (wgid % nig) / gsz; return true;
    }
    __device__ __forceinline__ void a_ready(const Unit&) const {}
    __device__ __forceinline__ void done(const Unit&) const {}
};
template <class Epi, class Sched, bool STAMP = false>
__device__ __forceinline__ void gemm_phase(PG8_LAS unsigned char* lds, const Gemm g, const Sched& S, const Epi& E, unsigned long long* stamps) {
    int tid_o = threadIdx.x; asm volatile("" : "+v"(tid_o));
    const int tid = tid_o, wid = __builtin_amdgcn_readfirstlane(tid >> 6), lane = tid & 63, wr = wid >> 2, wc = wid & 3, fr = lane & 15, fq = lane >> 4;
    const int K = g.K, nt = K / BK;
    int ts_lo = 0, ts_hi = 0, nts = 0; const unsigned long long rt_entry = STAMP ? (unsigned long long)wall_clock64() : 0ull;
#define PG8_STAMP() do { if (STAMP && wid == 0 && nts < 64) { const unsigned long long _c = (unsigned long long)clock64(); \
        ts_lo = (lane == nts) ? (int)(unsigned)_c : ts_lo; ts_hi = (lane == nts) ? (int)(unsigned)(_c >> 32) : ts_hi; ++nts; } } while (0)
    PG8_STAMP();
    unsigned voffA[2], voffB[2];
#pragma unroll
    for (int i = 0; i < 2; ++i) { int R, C; stage_rc(tid * 16 + i * 8192, R, C); const int Rb = Epi::PERM ? ((R & ~31) + perm32(R & 31)) : R;
        voffA[i] = (unsigned)(R * K + C) * 2u; voffB[i] = (unsigned)(Rb * K + C) * 2u; }
    const size_t kstep = (size_t)(BK * 2);
    const size_t hstep = (size_t)HALF * K * 2;
    const size_t tstep = 2 * hstep;
    const unsigned ldsw = (unsigned)wid * 1024u;
    const int aoff = lds_byte(wr * 64 + fr, fq * 8), boff = lds_byte(wc * 32 + fr, fq * 8);
#define PG8_SA(b, h) (((b) * 2 + (h)) * HTB)
#define PG8_SB(b, h) ((4 + (b) * 2 + (h)) * HTB)
#define PG8_STAGE(bufoff, gbase, voff) do { _Pragma("unroll") for (int _i = 0; _i < 2; ++_i) \
        __builtin_amdgcn_global_load_lds((const unsigned*)((const char*)(gbase) + (voff)[_i]), (PG8_LAS unsigned*)(lds + (bufoff) + ldsw + _i * 8192), 16, 0, 0); } while (0)
#define PG8_LDA(dst, b, h) do { _Pragma("unroll") for (int m = 0; m < 4; ++m) _Pragma("unroll") for (int k = 0; k < 2; ++k) dst[m][k] = *(const PG8_LAS bf16x8*)(lds + PG8_SA(b, h) + aoff + m * 2048 + k * 1024); } while (0)
#define PG8_LDB(dst, b, h) do { _Pragma("unroll") for (int n = 0; n < 2; ++n) _Pragma("unroll") for (int k = 0; k < 2; ++k) dst[n][k] = *(const PG8_LAS bf16x8*)(lds + PG8_SB(b, h) + boff + n * 2048 + k * 1024); } while (0)
#define PG8_MMA(ai, bj, At, Bt) do { __builtin_amdgcn_s_setprio(1); _Pragma("unroll") for (int m = 0; m < 4; ++m) _Pragma("unroll") for (int n = 0; n < 2; ++n) _Pragma("unroll") for (int k = 0; k < 2; ++k) \
        acc[ai][bj][m][n] = __builtin_amdgcn_mfma_f32_16x16x32_bf16(Bt[n][k], At[m][k], acc[ai][bj][m][n], 0, 0, 0); __builtin_amdgcn_s_setprio(0); } while (0)
#define PG8_WAIT_V(n) asm volatile("s_waitcnt vmcnt(" #n ")" ::: "memory")
#define PG8_WAIT_L(n) asm volatile("s_waitcnt lgkmcnt(" #n ")" ::: "memory")
#define PG8_BAR __builtin_amdgcn_s_barrier()
#define PG8_SCHED __builtin_amdgcn_sched_barrier(0)
    Unit cur, nxt; int ui = 0;
    if (!S.next(0, cur)) return;
    f32x4 acc[2][2][4][2];
#pragma unroll
    for (int a = 0; a < 2; ++a)
#pragma unroll
        for (int b = 0; b < 2; ++b)
#pragma unroll
            for (int m = 0; m < 4; ++m)
#pragma unroll
                for (int n = 0; n < 2; ++n) acc[a][b][m][n] = (f32x4){0.f, 0.f, 0.f, 0.f};
    bf16x8 At[4][2], B0[2][2], B1[2][2];
    const char* cA = (const char*)g.A + (size_t)cur.pm * tstep; const char* cB = (const char*)g.Bt + (size_t)cur.pn * tstep;
    S.a_ready(cur);
    PG8_STAGE(PG8_SB(0, 0), cB, voffB); PG8_STAGE(PG8_SA(0, 0), cA, voffA); PG8_STAGE(PG8_SB(0, 1), cB + hstep, voffB); PG8_STAGE(PG8_SA(0, 1), cA + hstep, voffA);
    if (wr == 1) PG8_BAR;
    PG8_WAIT_V(4); PG8_BAR;
    PG8_STAGE(PG8_SB(1, 0), cB + kstep, voffB); PG8_STAGE(PG8_SA(1, 0), cA + kstep, voffA); PG8_STAGE(PG8_SB(1, 1), cB + hstep + kstep, voffB);
    PG8_WAIT_V(6); PG8_BAR;
    PG8_STAMP();
    for (;;) {
        const bool has_next = S.next(ui + 1, nxt);
        const char* nA = has_next ? (const char*)g.A + (size_t)nxt.pm * tstep : cA; const char* nB = has_next ? (const char*)g.Bt + (size_t)nxt.pn * tstep : cB;
        for (int t = 0; t < nt; t += 2) {
            const bool last = (t == nt - 2);
            const char* a1 = cA + (size_t)(t + 1) * kstep;
            const char* a2 = last ? nA : cA + (size_t)(t + 2) * kstep; const char* b2 = last ? nB : cB + (size_t)(t + 2) * kstep;
            const char* a3 = a2 + kstep; const char* b3 = b2 + kstep;
            if (last && has_next) S.a_ready(nxt);
            PG8_LDB(B0, 0, 0); PG8_SCHED; PG8_LDA(At, 0, 0); PG8_STAGE(PG8_SA(1, 1), a1 + hstep, voffA);
            PG8_WAIT_L(8); PG8_BAR; PG8_WAIT_L(0); PG8_MMA(0, 0, At, B0); PG8_BAR; PG8_SCHED;
            PG8_LDB(B1, 0, 1); PG8_STAGE(PG8_SB(0, 0), b2, voffB);
            PG8_BAR; PG8_WAIT_L(0); PG8_MMA(0, 1, At, B1); PG8_BAR;
            PG8_LDA(At, 0, 1); PG8_STAGE(PG8_SA(0, 0), a2, voffA);
            PG8_BAR; PG8_WAIT_L(0); PG8_MMA(1, 0, At, B0); PG8_BAR; PG8_SCHED;
            PG8_STAGE(PG8_SB(0, 1), b2 + hstep, voffB);
            PG8_WAIT_V(6); PG8_BAR; PG8_MMA(1, 1, At, B1); PG8_BAR;
            PG8_LDB(B0, 1, 0); PG8_SCHED; PG8_LDA(At, 1, 0); PG8_STAGE(PG8_SA(0, 1), a2 + hstep, voffA);
            PG8_WAIT_L(8); PG8_BAR; PG8_WAIT_L(0); PG8_MMA(0, 0, At, B0); PG8_BAR; PG8_SCHED;
            PG8_LDB(B1, 1, 1); PG8_STAGE(PG8_SB(1, 0), b3, voffB);
            PG8_BAR; PG8_WAIT_L(0); PG8_MMA(0, 1, At, B1); PG8_BAR;
            PG8_LDA(At, 1, 1); PG8_STAGE(PG8_SA(1, 0), a3, voffA);
            PG8_BAR; PG8_WAIT_L(0); PG8_MMA(1, 0, At, B0); PG8_BAR; PG8_SCHED;
            PG8_STAGE(PG8_SB(1, 1), b3 + hstep, voffB);
            PG8_WAIT_V(6); PG8_BAR; PG8_MMA(1, 1, At, B1); PG8_BAR;
        }
        PG8_STAMP();
        if constexpr (!Epi::AFTER_DRAIN) { E(acc, cur, wr, wc, fr, fq); S.done(cur); }
        PG8_STAMP();
        if (!has_next) break;
#pragma unroll
        for (int a = 0; a < 2; ++a)
#pragma unroll
            for (int b = 0; b < 2; ++b)
#pragma unroll
                for (int m = 0; m < 4; ++m)
#pragma unroll
                    for (int n = 0; n < 2; ++n) acc[a][b][m][n] = (f32x4){0.f, 0.f, 0.f, 0.f};
        cur = nxt; cA = nA; cB = nB; ++ui;
    }
    PG8_WAIT_V(0);
    if (wr == 0) PG8_BAR;
    PG8_BAR;
    if constexpr (Epi::AFTER_DRAIN) { E.fused(acc, cur, wr, wc, fr, fq, lds, wid, lane); S.done(cur); }
    PG8_STAMP();
    if (STAMP && wid == 0) { stamps[lane] = lane < nts ? (((unsigned long long)(unsigned)ts_hi << 32) | (unsigned)ts_lo) : 0ull;
        if (lane == 62) stamps[62] = rt_entry; if (lane == 63) stamps[63] = (unsigned long long)wall_clock64(); }
#undef PG8_STAMP
#undef PG8_SA
#undef PG8_SB
#undef PG8_STAGE
#undef PG8_LDA
#undef PG8_LDB
#undef PG8_MMA
#undef PG8_WAIT_V
#undef PG8_WAIT_L
#undef PG8_BAR
#undef PG8_SCHED
}
}
__device__ __forceinline__ int in_src_col(int n) {
    if (n < 2048) return n;
    if (n < 2304) return 2056 + (n - 2048);
    if (n < 2560) return 2312 + (n - 2304);
    if (n < 2624) return 2568 + (n - 2560);
    if (n < 2640) return 2632 + (n - 2624);
    if (n < 2644) return 2048 + (n - 2640);
    if (n < 2648) return 2052 + (n - 2644);
    return -1;
}
__device__ __forceinline__ void tr_item(const float* W, int ldw, int srccol, bf16_t* WT, int ldt, int n0, int k0, LAS float* scr, int lane) {
    float tv[32];
#pragma unroll
    for (int i = 0; i < 32; ++i) { const int kk = 2 * i + (lane >> 5); tv[i] = (srccol >= 0) ? W[(size_t)(k0 + kk) * ldw + srccol] : 0.f; }
#pragma unroll
    for (int i = 0; i < 32; ++i) { const int kk = 2 * i + (lane >> 5); scr[kk * 33 + (lane & 31)] = tv[i]; }
    LDS_WAIT(); asm volatile("" ::: "memory");
    const int c = lane & 7;
#pragma unroll
    for (int j = 0; j < 4; ++j) { const int n = (lane >> 3) + 8 * j; const LAS float* s = scr + (8 * c) * 33 + n;
        u32x4 o; o.x = cvt_pk_bf16(s[0 * 33], s[1 * 33]); o.y = cvt_pk_bf16(s[2 * 33], s[3 * 33]); o.z = cvt_pk_bf16(s[4 * 33], s[5 * 33]); o.w = cvt_pk_bf16(s[6 * 33], s[7 * 33]);
        *(u32x4*)(WT + (size_t)(n0 + n) * ldt + k0 + 8 * c) = o; }
    LDS_WAIT(); asm volatile("" ::: "memory");
}
__device__ __forceinline__ void fold_nt(const float* A, int lda, const float* B, int ldb, bf16_t* O, int ldo, float sc, LAS float* scr, int lane) {
#pragma unroll 1
    for (int hf = 0; hf < 2; ++hf) {
        f32x2 a[32];
        const f32x4* ap = (const f32x4*)(A + (size_t)lane * lda + 64 * hf);
#pragma unroll
        for (int i = 0; i < 16; ++i) { const f32x4 t = ap[i]; a[2 * i] = f32x2{t[0], t[1]}; a[2 * i + 1] = f32x2{t[2], t[3]}; }
#pragma unroll 1
        for (int nn = 0; nn < 16; ++nn) {
            const CAS f32x2* bp = (const CAS f32x2*)(B + (size_t)nn * ldb + 64 * hf);
            f32x2 t0 = {0.f, 0.f}, t1 = {0.f, 0.f};
#pragma unroll
            for (int d = 0; d < 32; d += 2) { t0 = __builtin_elementwise_fma(a[d], bp[d], t0); t1 = __builtin_elementwise_fma(a[d + 1], bp[d + 1], t1); }
            const float r = (t0[0] + t0[1]) + (t1[0] + t1[1]);
            if (hf == 0) scr[lane * 17 + nn] = r;
            else O[(size_t)nn * ldo + lane] = f2bf((r + scr[lane * 17 + nn]) * sc);
        }
        LDS_WAIT(); asm volatile("" ::: "memory");
    }
}
__device__ __forceinline__ void fold_vo(const float* wo, const float* wv, bf16_t* O, int ldo, LAS float* scr, int lane) {
#pragma unroll 1
    for (int hf = 0; hf < 2; ++hf) {
        f32x2 a[32];
#pragma unroll
        for (int d = 0; d < 32; ++d) a[d] = f32x2{wo[(size_t)(64 * hf + 2 * d) * 1024 + lane], wo[(size_t)(64 * hf + 2 * d + 1) * 1024 + lane]};
#pragma unroll 1
        for (int nn = 0; nn < 16; ++nn) {
            const CAS f32x2* bp = (const CAS f32x2*)(wv + (size_t)nn * 1024 + 64 * hf);
            f32x2 t0 = {0.f, 0.f}, t1 = {0.f, 0.f};
#pragma unroll
            for (int d = 0; d < 32; d += 2) { t0 = __builtin_elementwise_fma(a[d], bp[d], t0); t1 = __builtin_elementwise_fma(a[d + 1], bp[d + 1], t1); }
            const float r = (t0[0] + t0[1]) + (t1[0] + t1[1]);
            scr[lane * 17 + nn] = (hf == 0) ? r : r + scr[lane * 17 + nn];
        }
        LDS_WAIT(); asm volatile("" ::: "memory");
    }
    const LAS float* sp = scr + lane * 17;
    u32x4 o0, o1; o0.x = cvt_pk_bf16(sp[0], sp[1]); o0.y = cvt_pk_bf16(sp[2], sp[3]); o0.z = cvt_pk_bf16(sp[4], sp[5]); o0.w = cvt_pk_bf16(sp[6], sp[7]);
    o1.x = cvt_pk_bf16(sp[8], sp[9]); o1.y = cvt_pk_bf16(sp[10], sp[11]); o1.z = cvt_pk_bf16(sp[12], sp[13]); o1.w = cvt_pk_bf16(sp[14], sp[15]);
    u32x4* op = (u32x4*)(O + (size_t)lane * ldo); op[0] = o0; op[1] = o1;
    LDS_WAIT(); asm volatile("" ::: "memory");
}
__device__ __forceinline__ void p0_prologue(const Params& p, LAS unsigned char* lds, int gw, int ngw, int wave, int lane) {
    unsigned char* ws = p.ws;
    LAS float* scr = (LAS float*)(lds + wave * 8448);
    bf16_t* WINT = (bf16_t*)(ws + WS_WINT); bf16_t* WQ2T = (bf16_t*)(ws + WS_WQ2T); bf16_t* WO2T = (bf16_t*)(ws + WS_WOUT2T); bf16_t* WQST = (bf16_t*)(ws + WS_WQST);
    constexpr int I_IN = 16 * 88, I_QI = 4 * 32, I_WO = 8 * 32, F_QK = 256, F_QS = 2048, F_VO = 1024;
    constexpr int NITEMS = I_IN + I_QI + I_WO + F_QK + F_QS + F_VO;
    for (int it = gw; it < NITEMS; it += ngw) {
        int r = it;
        if (r < I_IN) { const int kb = r / 88, nb = r % 88; tr_item(p.w_in, IN_W, in_src_col(32 * nb + (lane & 31)), WINT, 1024, 32 * nb, 64 * kb, scr, lane); continue; } r -= I_IN;
        if (r < I_QI) { const int kb = r / 32, nb = r % 32; tr_item(p.w_qidx_up, 1024, 32 * nb + (lane & 31), WQ2T + (size_t)1024 * 256, 256, 32 * nb, 64 * kb, scr, lane); continue; } r -= I_QI;
        if (r < I_WO) { const int kb = r / 32, nb = r % 32; tr_item(p.w_out, 1024, 32 * nb + (lane & 31), WO2T, 1536, 32 * nb, 64 * kb, scr, lane); continue; } r -= I_WO;
        if (r < F_QK) {
            const int h = r >> 6, jt = (r >> 2) & 15, kt = r & 3;
            fold_nt(p.w_q_up + (size_t)(64 * kt) * 512 + h * 128, 512, p.w_kv_up + (size_t)(16 * jt) * 1024 + h * 256, 1024,
                    WQ2T + (size_t)(h * 256 + 16 * jt) * 256 + 64 * kt, 256, 0.08838834764831845f, scr, lane);
            continue; } r -= F_QK;
        if (r < F_QS) {
            const int hs = r >> 7, nt = (r >> 4) & 7, kt = r & 15; const int h = hs >> 1, side = hs & 1;
            const float* sk = (side ? p.peer_k2 : p.peer_k1) + (size_t)(h * 128 + 16 * nt) * 128;
            fold_nt(p.peer_wq + (size_t)(64 * kt) * 2048 + hs * 128, 2048, sk, 128, WQST + (size_t)(hs * 128 + 16 * nt) * 1024 + 64 * kt, 1024, p.ln2_g[64 * kt + lane], scr, lane);
            continue; } r -= F_QS;
        {
            const int h = r >> 8, jt = (r >> 4) & 15, nt = r & 15;
            fold_vo(p.w_out + (size_t)(512 + h * 128) * 1024 + 64 * nt, p.w_kv_up + (size_t)(16 * jt) * 1024 + h * 256 + 128, WO2T + (size_t)(64 * nt) * 1536 + 512 + h * 256 + 16 * jt, 1536, scr, lane);
        }
    }
    bf16_t* HB = (bf16_t*)(ws + WS_HB);
    {
        const f32x4* gr = (const f32x4*)p.ln1_g + lane; f32x4 gv[4];
#pragma unroll
        for (int j = 0; j < 4; ++j) gv[j] = gr[64 * j];
        for (int m4 = 4 * gw; m4 < MT; m4 += 4 * ngw) {
            f32x4 v[4][4];
#pragma unroll
            for (int r = 0; r < 4; ++r) { const f32x4* xr = (const f32x4*)(p.x + (size_t)(m4 + r) * DM) + lane;
#pragma unroll
                for (int j = 0; j < 4; ++j) v[r][j] = xr[64 * j]; }
#pragma unroll
            for (int r = 0; r < 4; ++r) { float s2 = 0.f;
#pragma unroll
                for (int j = 0; j < 4; ++j) s2 += (v[r][j][0] * v[r][j][0] + v[r][j][1] * v[r][j][1]) + (v[r][j][2] * v[r][j][2] + v[r][j][3] * v[r][j][3]);
                const float rstd = rsqrtf(wave_sum(s2) * (1.f / DM) + EPS);
                u32x2* o8 = (u32x2*)(HB + (size_t)(m4 + r) * DM) + lane;
#pragma unroll
                for (int j = 0; j < 4; ++j) { const f32x4 g4 = gv[j]; u32x2 w; w.x = cvt_pk_bf16(v[r][j][0] * rstd * g4[0], v[r][j][1] * rstd * g4[1]); w.y = cvt_pk_bf16(v[r][j][2] * rstd * g4[2], v[r][j][3] * rstd * g4[3]); o8[64 * j] = w; } }
        }
    }
}

struct EpiIn {
    static constexpr bool PERM = true, AFTER_DRAIN = false;
    unsigned char* ws;
    __device__ __forceinline__ void operator()(const f32x4 (&acc)[2][2][4][2], const pg8::Unit& u, int wr, int wc, int fr, int fq) const {
        const int row0 = u.pm * 256 + wr * 64 + fr, cl0 = wc * 32 + 8 * fq, pn = u.pn;
        if (pn < 10) {
            bf16_t* base; int ld;
            if (pn < 6) { base = (bf16_t*)(ws + WS_QKV) + pn * 256; ld = 1536; }
            else if (pn < 8) { base = (bf16_t*)(ws + WS_ZB) + (pn - 6) * 256; ld = 512; }
            else if (pn == 8) { base = (bf16_t*)(ws + WS_CQ); ld = 256; }
            else { base = (bf16_t*)(ws + WS_CKV); ld = 256; }
#pragma unroll
            for (int ai = 0; ai < 2; ++ai)
#pragma unroll
                for (int m = 0; m < 4; ++m) { bf16_t* rowp = base + (size_t)(row0 + ai * 128 + m * 16) * ld + cl0;
#pragma unroll
                    for (int bj = 0; bj < 2; ++bj)
                        { const f32x4 v0 = acc[ai][bj][m][0], v1 = acc[ai][bj][m][1]; u32x4 w; w.x = cvt_pk_bf16(v0[0], v0[1]); w.y = cvt_pk_bf16(v0[2], v0[3]); w.z = cvt_pk_bf16(v1[0], v1[1]); w.w = cvt_pk_bf16(v1[2], v1[3]); *(u32x4*)(rowp + bj * 128) = w; }
                    asm volatile("" ::: "memory"); }
        } else {
            float* base = (float*)(ws + WS_MISC);
#pragma unroll
            for (int ai = 0; ai < 2; ++ai)
#pragma unroll
                for (int m = 0; m < 4; ++m) { float* rowp = base + (size_t)(row0 + ai * 128 + m * 16) * 128 + cl0;
#pragma unroll
                    for (int n = 0; n < 2; ++n) *(f32x4*)(rowp + n * 4) = acc[ai][0][m][n]; }
        }
    }
};
struct EpiQ {
    static constexpr bool PERM = true, AFTER_DRAIN = false;
    unsigned char* ws;
    __device__ __forceinline__ void operator()(const f32x4 (&acc)[2][2][4][2], const pg8::Unit& u, int wr, int wc, int fr, int fq) const {
        const int row0 = u.pm * 256 + wr * 64 + fr, cl0 = wc * 32 + 8 * fq, pn = u.pn;
        bf16_t* base; int ld;
        if (pn < 4) { base = (bf16_t*)(ws + WS_AOUT) + 512 + pn * 256; ld = 1536; } else { base = (bf16_t*)(ws + WS_QIDX) + (pn - 4) * 256; ld = 1024; }
#pragma unroll
        for (int ai = 0; ai < 2; ++ai)
#pragma unroll
            for (int m = 0; m < 4; ++m) { bf16_t* rowp = base + (size_t)(row0 + ai * 128 + m * 16) * ld + cl0;
#pragma unroll
                for (int bj = 0; bj < 2; ++bj)
                    { const f32x4 v0 = acc[ai][bj][m][0], v1 = acc[ai][bj][m][1]; u32x4 w; w.x = cvt_pk_bf16(v0[0], v0[1]); w.y = cvt_pk_bf16(v0[2], v0[3]); w.z = cvt_pk_bf16(v1[0], v1[1]); w.w = cvt_pk_bf16(v1[2], v1[3]); *(u32x4*)(rowp + bj * 128) = w; }
                asm volatile("" ::: "memory"); }
    }
};
struct EpiOut {
    static constexpr bool PERM = true, AFTER_DRAIN = false;
    const float* x; bf16_t* x1b; float* rss;
    __device__ __forceinline__ void operator()(const f32x4 (&acc)[2][2][4][2], const pg8::Unit& u, int wr, int wc, int fr, int fq) const {
        const int row0 = u.pm * 256 + wr * 64 + fr, col0 = u.pn * 256 + wc * 32 + 8 * fq;
        f32x4 xv[8][4];
        { const size_t off = (size_t)row0 * DM + col0; xv[0][0] = *(const f32x4*)(x + off); xv[0][1] = *(const f32x4*)(x + off + 4); xv[0][2] = *(const f32x4*)(x + off + 128); xv[0][3] = *(const f32x4*)(x + off + 132); }
#pragma unroll
        for (int it = 0; it < 8; ++it) { const int ai = it >> 2, m = it & 3; const int row = row0 + ai * 128 + m * 16; const size_t off = (size_t)row * DM + col0; float ss = 0.f;
                if (it < 7) { const int nrow = row0 + ((it + 1) >> 2) * 128 + ((it + 1) & 3) * 16; const size_t noff = (size_t)nrow * DM + col0;
                    xv[it + 1][0] = *(const f32x4*)(x + noff); xv[it + 1][1] = *(const f32x4*)(x + noff + 4); xv[it + 1][2] = *(const f32x4*)(x + noff + 128); xv[it + 1][3] = *(const f32x4*)(x + noff + 132); }
#pragma unroll
                for (int bj = 0; bj < 2; ++bj) { const f32x4 v0 = acc[ai][bj][m][0] + xv[it][2 * bj], v1 = acc[ai][bj][m][1] + xv[it][2 * bj + 1];
                        u32x4 w; w.x = cvt_pk_bf16(v0[0], v0[1]); w.y = cvt_pk_bf16(v0[2], v0[3]); w.z = cvt_pk_bf16(v1[0], v1[1]); w.w = cvt_pk_bf16(v1[2], v1[3]); *(u32x4*)(x1b + off + bj * 128) = w;
                        ss += ((v0[0] * v0[0] + v0[1] * v0[1]) + (v0[2] * v0[2] + v0[3] * v0[3])) + ((v1[0] * v1[0] + v1[1] * v1[1]) + (v1[2] * v1[2] + v1[3] * v1[3])); }
                ss += __shfl_xor(ss, 16); ss += __shfl_xor(ss, 32);
                if (fq == 0) __hip_atomic_fetch_add(rss + row, ss, __ATOMIC_RELAXED, __HIP_MEMORY_SCOPE_AGENT);
                asm volatile("" ::: "memory"); }
    }
};
struct EpiS {
    static constexpr bool PERM = true, AFTER_DRAIN = false;
    _Float16* S; const float* rss;
    __device__ __forceinline__ void operator()(const f32x4 (&acc)[2][2][4][2], const pg8::Unit& u, int wr, int wc, int fr, int fq) const {
        const int row0 = u.pm * 256 + wr * 64 + fr, col0 = u.pn * 256 + wc * 32 + 8 * fq;
#pragma unroll
        for (int ai = 0; ai < 2; ++ai)
#pragma unroll
            for (int m = 0; m < 4; ++m) { const int row = row0 + ai * 128 + m * 16; const float rs = rsqrtf(rss[row] * (1.f / DM) + EPS); _Float16* rowp = S + (size_t)row * 2048 + col0;
#pragma unroll
                for (int bj = 0; bj < 2; ++bj) { const f32x4 v0 = acc[ai][bj][m][0] * rs, v1 = acc[ai][bj][m][1] * rs; u32x4 w; w.x = __builtin_bit_cast(unsigned, (h2_t){(_Float16)v0[0], (_Float16)v0[1]}); w.y = __builtin_bit_cast(unsigned, (h2_t){(_Float16)v0[2], (_Float16)v0[3]});
                    w.z = __builtin_bit_cast(unsigned, (h2_t){(_Float16)v1[0], (_Float16)v1[1]}); w.w = __builtin_bit_cast(unsigned, (h2_t){(_Float16)v1[2], (_Float16)v1[3]}); *(u32x4*)(rowp + bj * 128) = w; } }
    }
};

__device__ __forceinline__ void p3_token(const Params& p, const LAS float* cw, int m, int lane, const u32x4 (&x0)[3], const u32x4 (&x1)[3], const u32x4 (&x2)[3], const u32x4 (&x3)[3]) {
    unsigned char* ws = p.ws;
    const int b = m >> 13, t = m & (SEQ - 1);
#pragma unroll
    for (int i = 0; i < 3; ++i) {
        const int piece = lane + 64 * i, hv = piece >> 4;
        float y[8];
#pragma unroll
        for (int e = 0; e < 8; ++e) y[e] = 0.f;
#pragma unroll
        for (int jj = 0; jj < 4; ++jj) { const f32x4 w0 = *(const LAS f32x4*)(cw + jj * 1536 + 8 * piece), w1 = *(const LAS f32x4*)(cw + jj * 1536 + 8 * piece + 4); const u32x4 v = (jj == 0) ? x0[i] : (jj == 1) ? x1[i] : (jj == 2) ? x2[i] : x3[i];
            y[0] = fmaf(w0[0], bf_lo(v.x), y[0]); y[1] = fmaf(w0[1], bf_hi(v.x), y[1]); y[2] = fmaf(w0[2], bf_lo(v.y), y[2]); y[3] = fmaf(w0[3], bf_hi(v.y), y[3]);
            y[4] = fmaf(w1[0], bf_lo(v.z), y[4]); y[5] = fmaf(w1[1], bf_hi(v.z), y[5]); y[6] = fmaf(w1[2], bf_lo(v.w), y[6]); y[7] = fmaf(w1[3], bf_hi(v.w), y[7]); }
        float ss = 0.f;
#pragma unroll
        for (int e = 0; e < 8; ++e) { y[e] = silu_f(y[e]); ss = fmaf(y[e], y[e], ss); }
        ss = row16_sum(ss);
        float r = 1.f;
        if (i < 2) { r = rsqrtf(ss + EPS); if (i == 0) r *= 0.08838834764831845f; }
        bf16_t* dst = (bf16_t*)(ws + (i == 0 ? WS_QH : (i == 1 ? WS_KH : WS_VH)));
        const int h = hv & 3;
        const size_t idx = ((((size_t)(b * 4 + h)) * NCHUNK + (t >> 6)) * 64 + (t & 63)) * 128 + 8 * (piece & 15);
        u32x4 o; o.x = cvt_pk_bf16(y[0] * r, y[1] * r); o.y = cvt_pk_bf16(y[2] * r, y[3] * r); o.z = cvt_pk_bf16(y[4] * r, y[5] * r); o.w = cvt_pk_bf16(y[6] * r, y[7] * r);
        *(u32x4*)(dst + idx) = o;
#ifdef PROBE_GDN
        if (b == 0 && t < 512 && (hv & 3) == 0) { float* rf = (float*)(ws + WS_REF) + ((size_t)i * 512 + t) * 128 + 8 * (piece & 15);
#pragma unroll
            for (int e = 0; e < 8; ++e) rf[e] = y[e] * r; }
#endif
    }
    const float* misc = (const float*)(ws + WS_MISC) + (size_t)m * 128;
    if (lane < 4) {
        const float a = misc[80 + lane] + p.dt_bias[lane], bb = misc[84 + lane];
        const float ea = __expf(a), ua = 1.f + ea, da = ua - 1.f;
        const float sp = (a > 20.f) ? a : (da == 0.f ? ea : __logf(ua) * ea * __builtin_amdgcn_rcpf(da));
        ((float*)(ws + WS_GARR))[(size_t)(b * 4 + lane) * SEQ + t] = -__expf(p.a_log[lane]) * sp;
        ((float*)(ws + WS_BARR))[(size_t)(b * 4 + lane) * SEQ + t] = __builtin_amdgcn_rcpf(1.f + __expf(-bb));
#ifdef PROBE_GDN
        if (b == 0 && lane == 0 && t < 512) { ((float*)(ws + WS_RES))[256 + t] = -__expf(p.a_log[0]) * sp; ((float*)(ws + WS_RES))[1024 + t] = 1.f / (1.f + __expf(-bb)); }
#endif
    }
    {
        u32x2* cq = (u32x2*)((bf16_t*)(ws + WS_CQ) + (size_t)m * 256) + lane; const u32x2 v = *cq;
        float f0 = bf_lo(v.x), f1 = bf_hi(v.x), f2 = bf_lo(v.y), f3 = bf_hi(v.y);
        float rs = rsqrtf(wave_sum((f0 * f0 + f1 * f1) + (f2 * f2 + f3 * f3)) * (1.f / 256.f) + EPS);
        f32x4 g = ((const f32x4*)p.q_norm_g)[lane]; u32x2 w; w.x = cvt_pk_bf16(f0 * rs * g[0], f1 * rs * g[1]); w.y = cvt_pk_bf16(f2 * rs * g[2], f3 * rs * g[3]); *cq = w;
        u32x2* ck = (u32x2*)((bf16_t*)(ws + WS_CKV) + (size_t)m * 256) + lane; const u32x2 v2 = *ck;
        f0 = bf_lo(v2.x); f1 = bf_hi(v2.x); f2 = bf_lo(v2.y); f3 = bf_hi(v2.y);
        rs = rsqrtf(wave_sum((f0 * f0 + f1 * f1) + (f2 * f2 + f3 * f3)) * (1.f / 256.f) + EPS);
        g = ((const f32x4*)p.kv_norm_g)[lane];
        { int w8 = __builtin_amdgcn_cvt_pk_fp8_f32(f0 * rs * g[0], f1 * rs * g[1], 0, false); w8 = __builtin_amdgcn_cvt_pk_fp8_f32(f2 * rs * g[2], f3 * rs * g[3], w8, true); ((unsigned*)(ws + WS_CKV8))[(size_t)m * 64 + lane] = (unsigned)w8; }
    }
    {
        const float xk = misc[lane]; const float mu = wave_sum(xk) * (1.f / 64.f); const float d = xk - mu; const float var = wave_sum(d * d) * (1.f / 64.f);
        ((bf16_t*)(ws + WS_KIDXN))[(size_t)m * 64 + lane] = f2bf(d * rsqrtf(var + EPS) * p.idx_ln_g[lane] + p.idx_ln_b[lane]);
        if (lane < 16) ((float*)(ws + WS_WIDX))[(size_t)m * 16 + lane] = misc[64 + lane] * (0.5f / 32.f);
    }
}

constexpr int G2_KL = 0, G2_QL = 17408, G2_VT = 34816, G2_KBT = 53248, G2_TL = 71680, G2_AM = 80896, G2_GC = 97280, G2_VT2 = 98304, G2_KBT2 = 116736, G2_TL2 = 135168, G2_TF = 144384;
__device__ __forceinline__ float bf_elem(const u32x4& v, int e) { const unsigned w = v[e >> 1]; return (e & 1) ? bf_hi(w) : bf_lo(w); }
struct G2In { u32x4 k[2], q[2], v[2]; float g, b; };
__device__ __forceinline__ void g2_load(const Params& p, G2In& in, int cb, int tid, int lane) {
    unsigned char* ws = p.ws;
    const u32x4* qB = (const u32x4*)((const bf16_t*)(ws + WS_QH) + (size_t)cb * 8192); const u32x4* kB = (const u32x4*)((const bf16_t*)(ws + WS_KH) + (size_t)cb * 8192); const u32x4* vB = (const u32x4*)((const bf16_t*)(ws + WS_VH) + (size_t)cb * 8192);
    const int bh = cb >> 7, c = cb & 127;
#pragma unroll
    for (int i = 0; i < 2; ++i) { const int piece = tid + 512 * i; in.k[i] = kB[piece]; in.q[i] = qB[piece]; in.v[i] = vB[piece]; }
    in.g = ((const float*)(ws + WS_GARR))[(size_t)bh * SEQ + c * 64 + lane]; in.b = ((const float*)(ws + WS_BARR))[(size_t)bh * SEQ + c * 64 + lane];
}
__device__ __forceinline__ void g2_chunk(const Params& p, LAS unsigned char* lds, int cb, int cb_next, G2In& in, int tid_in, int wave, int lane_in) {
    unsigned char* ws = p.ws;
    int tid = tid_in; asm volatile("" : "+v"(tid));
    const int lane = tid & 63; (void)lane_in;
    bf16_t* qB = (bf16_t*)(ws + WS_QH) + (size_t)cb * 8192; bf16_t* kB = (bf16_t*)(ws + WS_KH) + (size_t)cb * 8192; bf16_t* vB = (bf16_t*)(ws + WS_VH) + (size_t)cb * 8192;
    bf16_t* wB = (bf16_t*)(ws + WS_WBUF) + (size_t)cb * 8192; bf16_t* aB = (bf16_t*)(ws + WS_ATTN) + (size_t)cb * 4096;
    const int bh = cb >> 7, c = cb & 127;
    const float* gsrc = (const float*)(ws + WS_GARR) + (size_t)bh * SEQ + c * 64; const float* bsrc = (const float*)(ws + WS_BARR) + (size_t)bh * SEQ + c * 64;
    LAS bf16_t* KL = (LAS bf16_t*)(lds + G2_KL); LAS bf16_t* QL = (LAS bf16_t*)(lds + G2_QL); LAS bf16_t* VT = (LAS bf16_t*)(lds + G2_VT);
    LAS bf16_t* KBT = (LAS bf16_t*)(lds + G2_KBT); LAS bf16_t* TL = (LAS bf16_t*)(lds + G2_TL); LAS float* AM = (LAS float*)(lds + G2_AM);
    LAS float* GC = (LAS float*)(lds + G2_GC); LAS float* BT = GC + 64;
    const int g = lane >> 4, fr = lane & 15;
#ifdef PROBE_NAN
    unsigned pbad = 0u;
#define PCHK(idx, v) do { if (!(fabsf(v) < 1e30f)) pbad |= 1u << ((idx) - 30); } while (0)
#else
#define PCHK(idx, v) do {} while (0)
#endif
    u32x4 kp[2], qp[2], vp[2];
#pragma unroll
    for (int i = 0; i < 2; ++i) { kp[i] = in.k[i]; qp[i] = in.q[i]; vp[i] = in.v[i]; }
    if (wave == 0) {
        float gv = in.g;
#pragma unroll
        for (int o = 1; o < 64; o <<= 1) { const float t = __shfl_up(gv, o); if (lane >= o) gv += t; }
        GC[lane] = gv; BT[lane] = in.b;
    }
    __syncthreads();
#pragma unroll
    for (int i = 0; i < 2; ++i) { const int piece = tid + 512 * i, row = piece >> 4, ch = piece & 15;
        *(LAS u32x4*)(KL + row * 136 + ch * 8) = kp[i]; *(LAS u32x4*)(QL + row * 136 + ch * 8) = qp[i];
        const float bj = BT[row], be = bj * __expf(GC[row]);
#pragma unroll
        for (int e = 0; e < 8; ++e) { const float vv = bf_elem(vp[i], e) * bj, kk = bf_elem(kp[i], e) * be; const bf16_t vh = f2bf(vv), kh = f2bf(kk);
            VT[(ch * 8 + e) * 72 + row] = vh; KBT[(ch * 8 + e) * 72 + row] = kh; } }
    __syncthreads();
#pragma unroll
    for (int tt = 0; tt < 2; ++tt) { const int idx = wave + 8 * tt, ti = idx >> 2, tj = idx & 3;
        f32x4 accA = {0.f, 0.f, 0.f, 0.f}, accT = {0.f, 0.f, 0.f, 0.f};
        if (tj <= ti) {
#pragma unroll
            for (int s = 0; s < 4; ++s) { const bf16x8 ki = *(const LAS bf16x8*)(KL + (16 * ti + fr) * 136 + 32 * s + 8 * g), kj = *(const LAS bf16x8*)(KL + (16 * tj + fr) * 136 + 32 * s + 8 * g),
                                                       qi = *(const LAS bf16x8*)(QL + (16 * ti + fr) * 136 + 32 * s + 8 * g);
                accA = MFMA16(ki, kj, accA);
                accT = MFMA16(kj, qi, accT); }
        }
#pragma unroll
        for (int reg = 0; reg < 4; ++reg) { const int i = 16 * ti + 4 * g + reg, j = 16 * tj + fr;
            const float amv = (j < i) ? BT[i] * accA[reg] * __expf(GC[i] - GC[j]) : 0.f; AM[i * 64 + j] = amv; }
        { const int i = 16 * ti + fr; float v[4];
#pragma unroll
            for (int reg = 0; reg < 4; ++reg) { const int j = 16 * tj + 4 * g + reg; v[reg] = (j <= i) ? accT[reg] * __expf(GC[i] - GC[j]) : 0.f; }
            u32x2 w; w.x = cvt_pk_bf16(v[0], v[1]); w.y = cvt_pk_bf16(v[2], v[3]); *(u32x2*)(aB + i * 64 + 32 * (tj >> 1) + 8 * g + 4 * (tj & 1)) = w; }
    }
#pragma unroll
    for (int q = 0; q < 8; ++q) ((LAS float*)(lds + G2_TF))[tid + 512 * q] = 0.f;
    __syncthreads();
    LAS float* TF = (LAS float*)(lds + G2_TF); LAS float* XB = (LAS float*)(lds + G2_QL);
    if (wave == 0) {
        const int o = 16 * (lane >> 4), c = lane & 15;
        for (int i = 0; i < 16; ++i) { float acc = (i == c) ? 1.f : 0.f;
            for (int j = 0; j < i; ++j) acc = fmaf(-AM[(o + i) * 64 + o + j], TF[(o + j) * 64 + o + c], acc);
            TF[(o + i) * 64 + o + c] = acc; }
    } else {
        const int t2 = tid - 64; const float gl = GC[63];
        for (int piece = t2; piece < 1024; piece += 448) { const int row = piece >> 4, ch = piece & 15; const u32x4 v = *(const LAS u32x4*)(QL + row * 136 + ch * 8); const float e = __expf(GC[row]);
            u32x4 o; o.x = cvt_pk_bf16(bf_lo(v.x) * e, bf_hi(v.x) * e); o.y = cvt_pk_bf16(bf_lo(v.y) * e, bf_hi(v.y) * e); o.z = cvt_pk_bf16(bf_lo(v.z) * e, bf_hi(v.z) * e); o.w = cvt_pk_bf16(bf_lo(v.w) * e, bf_hi(v.w) * e);
            { const int kb = ch >> 2, u0 = 2 * (ch & 3), u1 = u0 + 1; bf16_t* rp = qB + row * 128 + 32 * kb;
              u32x2 lo2; lo2.x = o.x; lo2.y = o.y; u32x2 hi2; hi2.x = o.z; hi2.y = o.w;
              *(u32x2*)(rp + 4 * (2 * (u0 & 3) + (u0 >> 2))) = lo2; *(u32x2*)(rp + 4 * (2 * (u1 & 3) + (u1 >> 2))) = hi2; } }
        for (int piece = t2; piece < 1024; piece += 448) { const int d = piece >> 3, jc = piece & 7; float v[8];
#pragma unroll
            for (int e = 0; e < 8; ++e) { const int j = 8 * jc + e; v[e] = bf2f(KL[j * 136 + d]) * __expf(gl - GC[j]); }
            u32x4 o; o.x = cvt_pk_bf16(v[0], v[1]); o.y = cvt_pk_bf16(v[2], v[3]); o.z = cvt_pk_bf16(v[4], v[5]); o.w = cvt_pk_bf16(v[6], v[7]);
            { const int kb = jc >> 2, u0 = 2 * (jc & 3), u1 = u0 + 1; bf16_t* rp = kB + d * 64 + 32 * kb;
              u32x2 lo2; lo2.x = o.x; lo2.y = o.y; u32x2 hi2; hi2.x = o.z; hi2.y = o.w;
              *(u32x2*)(rp + 4 * (2 * (u0 & 3) + (u0 >> 2))) = lo2; *(u32x2*)(rp + 4 * (2 * (u1 & 3) + (u1 >> 2))) = hi2; } }
        if (t2 == 0) ((float*)(ws + WS_GAMMA))[cb] = __expf(gl);
    }
    __syncthreads();
    {
        const int pr = tid >> 8, r = (tid >> 4) & 15, c = tid & 15, o = 32 * pr; float x = 0.f;
#pragma unroll 4
        for (int k = 0; k < 16; ++k) x = fmaf(AM[(o + 16 + r) * 64 + o + k], TF[(o + k) * 64 + o + c], x);
        XB[tid] = x;
    }
    __syncthreads();
    {
        const int pr = tid >> 8, r = (tid >> 4) & 15, c = tid & 15, o = 32 * pr; float y = 0.f;
#pragma unroll 4
        for (int k = 0; k < 16; ++k) y = fmaf(TF[(o + 16 + r) * 64 + o + 16 + k], XB[pr * 256 + k * 16 + c], y);
        TF[(o + 16 + r) * 64 + o + c] = -y;
    }
    __syncthreads();
    {
        const int r = tid >> 4, c0 = (tid & 15) * 2; float x0 = 0.f, x1 = 0.f;
#pragma unroll 8
        for (int k = 0; k < 32; ++k) { const float a = AM[(32 + r) * 64 + k]; const f32x2 t = *(const LAS f32x2*)(TF + k * 64 + c0); x0 = fmaf(a, t[0], x0); x1 = fmaf(a, t[1], x1); }
        *(LAS f32x2*)(XB + r * 32 + c0) = (f32x2){x0, x1};
    }
    __syncthreads();
    {
        const int r = tid >> 4, c0 = (tid & 15) * 2; float x0 = 0.f, x1 = 0.f;
#pragma unroll 8
        for (int k = 0; k < 32; ++k) { const float a = TF[(32 + r) * 64 + 32 + k]; const f32x2 t = *(const LAS f32x2*)(XB + k * 32 + c0); x0 = fmaf(a, t[0], x0); x1 = fmaf(a, t[1], x1); }
        *(LAS f32x2*)(TF + (32 + r) * 64 + c0) = (f32x2){-x0, -x1};
    }
    __syncthreads();
#ifdef PROBE_GDN
    if (cb == 0) { float* dmp = (float*)(ws + 15 * MiB + 880000);
#pragma unroll 1
        for (int idx = tid; idx < 4096; idx += NTHR) { dmp[idx] = AM[idx]; dmp[4096 + idx] = TF[idx]; } }
#endif
#pragma unroll
    for (int q = 0; q < 8; ++q) { const int idx = tid + 512 * q, i = idx >> 6, j = idx & 63; TL[i * 72 + j] = f2bf(TF[idx]); }
    __syncthreads();
    if (cb_next < 16 * NCHUNK) g2_load(p, in, cb_next, tid, lane);
#pragma unroll
    for (int tt = 0; tt < 4; ++tt) { const int t = wave * 4 + tt, ti = t >> 3, te = t & 7; f32x4 acc = {0.f, 0.f, 0.f, 0.f};
#pragma unroll
        for (int s = 0; s < 2; ++s) { const int oa = (16 * ti + fr) * 72 + 32 * s + 8 * g, ob = (16 * te + fr) * 72 + 32 * s + 8 * g;
            const bf16x8 fa = *(const LAS bf16x8*)(TL + oa), fb = *(const LAS bf16x8*)(VT + ob);
            acc = MFMA16(fa, fb, acc); }
        u32x2 w; w.x = cvt_pk_bf16(acc[0], acc[1]); w.y = cvt_pk_bf16(acc[2], acc[3]); *(u32x2*)(vB + (16 * te + fr) * 64 + 16 * ti + 4 * g) = w; }
#pragma unroll
    for (int tt = 0; tt < 4; ++tt) { const int t = wave * 4 + tt, td = t >> 2, ti = t & 3; f32x4 acc = {0.f, 0.f, 0.f, 0.f};
#pragma unroll
        for (int s = 0; s < 2; ++s) { const int oa = (16 * td + fr) * 72 + 32 * s + 8 * g, ob = (16 * ti + fr) * 72 + 32 * s + 8 * g;
            const bf16x8 fa = *(const LAS bf16x8*)(KBT + oa), fb = *(const LAS bf16x8*)(TL + ob);
            acc = MFMA16(fa, fb, acc); }
        u32x2 w; w.x = cvt_pk_bf16(acc[0], acc[1]); w.y = cvt_pk_bf16(acc[2], acc[3]); *(u32x2*)(wB + (16 * ti + fr) * 128 + 32 * (td >> 1) + 8 * g + 4 * (td & 1)) = w; }
#ifdef PROBE_NAN
    if (pbad) { unsigned* pfl = (unsigned*)(ws + WS_CTL) + 1024; for (int k = 0; k < 7; ++k) if (pbad & (1u << k)) atomicOr(pfl + 30 + k, 1u); }
#endif
    __syncthreads();
}

constexpr int G3_W = 0, G3_Q = 16384, G3_KT = 32768, G3_AT = 49152, G3_BUF = 57344, G3_OB = 2 * G3_BUF, G3_OBS = 132;
static_assert(G3_OB + 64 * G3_OBS * 4 <= LDS_MISC, "scan LDS map");
__device__ __forceinline__ unsigned g3_off256(unsigned r, unsigned c) { return r * 256u + ((c ^ (r & 15u)) << 4); }
__device__ __forceinline__ unsigned g3_off128(unsigned r, unsigned c) { return r * 128u + ((c ^ ((r >> 1) & 7u)) << 4); }
__device__ __forceinline__ void g3_scan(const Params& p, LAS unsigned char* lds, int bh, int wave, int lane) {
    unsigned char* ws = p.ws;
    const int b = bh >> 2, h = bh & 3, e0 = 16 * wave;
    LAS float* OB = (LAS float*)(lds + G3_OB);
    f32x4 S[8];
#pragma unroll
    for (int i = 0; i < 8; ++i) S[i] = (f32x4){0.f, 0.f, 0.f, 0.f};
    const bf16_t* ZB = (const bf16_t*)(ws + WS_ZB); bf16_t* AO = (bf16_t*)(ws + WS_AOUT);
    const int tid = wave * 64 + lane;
    {
        const size_t cb = (size_t)bh * NCHUNK;
        const u32x4* s0 = (const u32x4*)((const bf16_t*)(ws + WS_WBUF) + cb * 8192); const u32x4* s1 = (const u32x4*)((const bf16_t*)(ws + WS_QH) + cb * 8192);
        const u32x4* s2 = (const u32x4*)((const bf16_t*)(ws + WS_KH) + cb * 8192); const u32x4* s4 = (const u32x4*)((const bf16_t*)(ws + WS_ATTN) + cb * 4096);
#pragma unroll
        for (int i = 0; i < 2; ++i) { const unsigned pp = tid + 512 * i;
            *(LAS u32x4*)(lds + G3_W + g3_off256(pp >> 4, pp & 15u)) = s0[pp]; *(LAS u32x4*)(lds + G3_Q + g3_off256(pp >> 4, pp & 15u)) = s1[pp]; *(LAS u32x4*)(lds + G3_KT + g3_off128(pp >> 3, pp & 7u)) = s2[pp]; }
        *(LAS u32x4*)(lds + G3_AT + g3_off128((unsigned)tid >> 3, (unsigned)tid & 7u)) = s4[tid];
    }
    __syncthreads();
#pragma unroll 1
    for (int c = 0; c < NCHUNK; ++c) {
        int lane_o = threadIdx.x & 63; asm volatile("" : "+v"(lane_o));
        const unsigned g = (unsigned)lane_o >> 4, fr = (unsigned)lane_o & 15u;
        const unsigned tid2 = wave * 64 + lane_o;
        const size_t cb = (size_t)bh * NCHUNK + c;
        LAS unsigned char* buf = lds + (c & 1) * G3_BUF; LAS unsigned char* nbuf = lds + ((c + 1) & 1) * G3_BUF;
        const float gam = ((const float*)(ws + WS_GAMMA))[cb];
        u32x4 zp[2]; u32x2 uu[4];
        {
            const size_t nb = (c + 1 < NCHUNK) ? cb + 1 : cb;
            const u32x4* s0 = (const u32x4*)((const bf16_t*)(ws + WS_WBUF) + nb * 8192); const u32x4* s1 = (const u32x4*)((const bf16_t*)(ws + WS_QH) + nb * 8192);
            const u32x4* s2 = (const u32x4*)((const bf16_t*)(ws + WS_KH) + nb * 8192); const u32x4* s4 = (const u32x4*)((const bf16_t*)(ws + WS_ATTN) + nb * 4096);
#pragma unroll
            for (int i = 0; i < 2; ++i) { const unsigned sl = tid2 + 512u * i, r = sl >> 4, cs = (sl & 15u) ^ (r & 15u); const unsigned wb = (unsigned)(wave * 64 + 512 * i) * 16u;
                __builtin_amdgcn_global_load_lds((const unsigned*)(s0 + r * 16u + cs), (LAS unsigned*)(nbuf + G3_W + wb), 16, 0, 0);
                __builtin_amdgcn_global_load_lds((const unsigned*)(s1 + r * 16u + cs), (LAS unsigned*)(nbuf + G3_Q + wb), 16, 0, 0);
                const unsigned r8 = sl >> 3, c8s = (sl & 7u) ^ ((r8 >> 1) & 7u);
                __builtin_amdgcn_global_load_lds((const unsigned*)(s2 + r8 * 8u + c8s), (LAS unsigned*)(nbuf + G3_KT + wb), 16, 0, 0); }
            { const unsigned r8 = tid2 >> 3, c8s = (tid2 & 7u) ^ ((r8 >> 1) & 7u);
                __builtin_amdgcn_global_load_lds((const unsigned*)(s4 + r8 * 8u + c8s), (LAS unsigned*)(nbuf + G3_AT + (unsigned)(wave * 64) * 16u), 16, 0, 0); }
            const bf16_t* uT = (const bf16_t*)(ws + WS_VH) + cb * 8192;
#pragma unroll
            for (int mt = 0; mt < 4; ++mt) uu[mt] = *(const u32x2*)(uT + (e0 + fr) * 64 + 16 * mt + 4 * g);
#pragma unroll
            for (int q = 0; q < 2; ++q) { const unsigned pp = tid2 + 512u * q; const size_t m = (size_t)b * SEQ + c * 64 + (pp >> 4); zp[q] = *(const u32x4*)(ZB + m * 512 + h * 128 + 8 * (pp & 15u)); }
        }
        bf16x8 Sb[4];
#pragma unroll
        for (int kb = 0; kb < 4; ++kb) Sb[kb] = pk8(S[2 * kb], S[2 * kb + 1]);
        f32x4 vn[4], ot[4];
#define G3_FRAG256(base, R, kb) (*(const LAS bf16x8*)(buf + (base) + g3_off256((R), 4 * (kb) + g)))
#define G3_FRAG128(base, R, k2) (*(const LAS bf16x8*)(buf + (base) + g3_off128((R), 4 * (k2) + g)))
        {
#pragma unroll
            for (int hf = 0; hf < 2; ++hf) {
                bf16x8 af[8];
#pragma unroll
                for (int m2 = 0; m2 < 2; ++m2)
#pragma unroll
                    for (int kb = 0; kb < 4; ++kb) af[4 * m2 + kb] = G3_FRAG256(G3_W, 16 * (2 * hf + m2) + fr, kb);
                asm volatile("" ::: "memory");
#pragma unroll
                for (int m2 = 0; m2 < 2; ++m2) { const int mt = 2 * hf + m2; f32x4 acc = {0.f, 0.f, 0.f, 0.f};
#pragma unroll
                    for (int kb = 0; kb < 4; ++kb) acc = MFMA16(af[4 * m2 + kb], Sb[kb], acc);
                    vn[mt] = (f32x4){bf_lo(uu[mt].x) - acc[0], bf_hi(uu[mt].x) - acc[1], bf_lo(uu[mt].y) - acc[2], bf_hi(uu[mt].y) - acc[3]}; }
            }
        }
        bf16x8 vb[2]; vb[0] = pk8(vn[0], vn[1]); vb[1] = pk8(vn[2], vn[3]);
        {
#pragma unroll
            for (int mt = 0; mt < 4; ++mt) {
                bf16x8 af[6];
#pragma unroll
                for (int kb = 0; kb < 4; ++kb) af[kb] = G3_FRAG256(G3_Q, 16 * mt + fr, kb);
#pragma unroll
                for (int k2 = 0; k2 < 2; ++k2) af[4 + k2] = G3_FRAG128(G3_AT, 16 * mt + fr, k2);
                asm volatile("" ::: "memory");
                f32x4 acc = {0.f, 0.f, 0.f, 0.f};
#pragma unroll
                for (int kb = 0; kb < 4; ++kb) acc = MFMA16(af[kb], Sb[kb], acc);
#pragma unroll
                for (int k2 = 0; k2 < 2; ++k2) acc = MFMA16(af[4 + k2], vb[k2], acc);
                ot[mt] = acc; }
        }
        {
#pragma unroll
            for (int hf = 0; hf < 4; ++hf) {
                bf16x8 af[4];
#pragma unroll
                for (int r2 = 0; r2 < 2; ++r2)
#pragma unroll
                    for (int k2 = 0; k2 < 2; ++k2) af[2 * r2 + k2] = G3_FRAG128(G3_KT, 16 * (2 * hf + r2) + fr, k2);
                asm volatile("" ::: "memory");
#pragma unroll
                for (int r2 = 0; r2 < 2; ++r2) { const int rt = 2 * hf + r2; f32x4 acc = S[rt] * gam;
#pragma unroll
                    for (int k2 = 0; k2 < 2; ++k2) acc = MFMA16(af[2 * r2 + k2], vb[k2], acc);
                    S[rt] = acc; }
            }
        }
#undef G3_FRAG256
#undef G3_FRAG128
        __syncthreads();
#pragma unroll
        for (int mt = 0; mt < 4; ++mt)
#pragma unroll
            for (int reg = 0; reg < 4; ++reg) OB[(16 * mt + 4 * g + reg) * G3_OBS + e0 + fr] = ot[mt][reg];
        asm volatile("s_waitcnt vmcnt(0)" ::: "memory");
        __syncthreads();
#pragma unroll
        for (int q = 0; q < 2; ++q) { const unsigned pp = tid2 + 512u * q, i = pp >> 4, c8 = pp & 15u;
            const f32x4 o0 = *(const LAS f32x4*)(OB + i * G3_OBS + 8 * c8), o1 = *(const LAS f32x4*)(OB + i * G3_OBS + 8 * c8 + 4);
            const float tot = row16_sum((o0[0] * o0[0] + o0[1] * o0[1]) + (o0[2] * o0[2] + o0[3] * o0[3]) + (o1[0] * o1[0] + o1[1] * o1[1]) + (o1[2] * o1[2] + o1[3] * o1[3]));
            const float rstd = rsqrtf(tot * (1.f / 128.f) + EPS);
            const u32x4 z = zp[q]; f32x4 gnv[2]; { const f32x4* gp4 = (const f32x4*)(p.gdn_norm_g + 8 * c8); gnv[0] = gp4[0]; gnv[1] = gp4[1]; }
            float r[8];
            r[0] = o0[0] * rstd * gnv[0][0] * silu_f(bf_lo(z.x)); r[1] = o0[1] * rstd * gnv[0][1] * silu_f(bf_hi(z.x)); r[2] = o0[2] * rstd * gnv[0][2] * silu_f(bf_lo(z.y)); r[3] = o0[3] * rstd * gnv[0][3] * silu_f(bf_hi(z.y));
            r[4] = o1[0] * rstd * gnv[1][0] * silu_f(bf_lo(z.z)); r[5] = o1[1] * rstd * gnv[1][1] * silu_f(bf_hi(z.z)); r[6] = o1[2] * rstd * gnv[1][2] * silu_f(bf_lo(z.w)); r[7] = o1[3] * rstd * gnv[1][3] * silu_f(bf_hi(z.w));
#ifdef ZERO_GDN
#pragma unroll
            for (int e = 0; e < 8; ++e) r[e] = 0.f;
#elif defined(DOUBLE_GDN)
#pragma unroll
            for (int e = 0; e < 8; ++e) r[e] *= 2.f;
#endif
            u32x4 w; w.x = cvt_pk_bf16(r[0], r[1]); w.y = cvt_pk_bf16(r[2], r[3]); w.z = cvt_pk_bf16(r[4], r[5]); w.w = cvt_pk_bf16(r[6], r[7]);
            const size_t m = (size_t)b * SEQ + c * 64 + i;
            *(u32x4*)(AO + m * 1536 + h * 128 + 8 * c8) = w; }
    }
}

constexpr int DL_QS = 0;
constexpr int DL_IMG = 0;
constexpr int DL_SEL = 131072;
constexpr int DL_HIST = 139264;
constexpr int DL_WQ = 147456;
constexpr int DL_BKT = 148480;
constexpr int DL_RB = 156672;
static_assert(DL_RB + 512 <= LDS_MISC, "DSA LDS map");

__device__ __forceinline__ unsigned img_off(unsigned row, unsigned ch) { return 256u * row + 16u * (ch ^ (((row & 3u) << 2) | ((row >> 2) & 3u))); }
__device__ __forceinline__ unsigned key16(unsigned u) { return (u & 0x8000u) ? (~u & 0xffffu) : (u | 0x8000u); }
__device__ __forceinline__ void radix_find(const LAS unsigned* hist, unsigned need, int lane, unsigned& bsel, unsigned& above) {
    const u32x4 hv = *(const LAS u32x4*)(hist + 4 * lane);
    const unsigned s4 = hv.x + hv.y + hv.z + hv.w;
    unsigned incl = s4;
#pragma unroll
    for (int o = 1; o < 64; o <<= 1) { const unsigned t = __shfl_down(incl, o); if (lane + o < 64) incl += t; }
    const unsigned excl = incl - s4;
    const bool hit = (excl < need) && (incl >= need);
    const unsigned c3 = excl + hv.w, c2 = c3 + hv.z, c1 = c2 + hv.y;
    unsigned bb, ab;
    if (c3 >= need) { bb = 3; ab = excl; } else if (c2 >= need) { bb = 2; ab = c3; } else if (c1 >= need) { bb = 1; ab = c2; } else { bb = 0; ab = c1; }
    const unsigned long long mask = __ballot(hit);
    const int src = mask ? (__ffsll((long long)mask) - 1) : 0;
    bsel = __shfl(4u * lane + bb, src); above = __shfl(ab, src);
}
__device__ __forceinline__ void dsa_tables(const Params& p, LAS unsigned char* lds, int tid) {
    LAS unsigned char* BK = lds + DL_BKT; LAS float* RB = (LAS float*)(lds + DL_RB);
    for (int d = tid; d < SEQ; d += NTHR) { int bk = d;
        if (d >= 16) { bk = 16 + (d >= 21) + (d >= 27) + (d >= 35) + (d >= 46) + (d >= 59) + (d >= 77) + (d >= 99) + (d >= 128) + (d >= 166) + (d >= 216) + (d >= 280) + (d >= 363) + (d >= 470) + (d >= 609) + (d >= 790); }
        BK[d] = (unsigned char)bk; }
    if (tid < 128) RB[tid] = p.rel_bias[tid];
    __syncthreads();
}
struct TabJob { f32x4 a[4], b[4], g[4]; int pair; };
__device__ __forceinline__ void tab_load(const Params& p, TabJob& tj, int pair, int lane) {
    tj.pair = pair; const int tb = pair >> 13, r0 = (pair & 8191) * 2;
    const float* src = (tb ? p.peer_v : p.peer_u) + (size_t)r0 * 1024 + 16 * lane;
#pragma unroll
    for (int q = 0; q < 4; ++q) { tj.a[q] = ((const f32x4*)src)[q]; tj.b[q] = ((const f32x4*)(src + 1024))[q]; tj.g[q] = ((const f32x4*)p.ln2_g)[4 * lane + q]; }
}
__device__ __forceinline__ void tab_finish(unsigned char* ws, const TabJob& tj, int lane) {
    const int tb = tj.pair >> 13, r0 = (tj.pair & 8191) * 2;
    float va[16], vb[16];
#pragma unroll
    for (int q = 0; q < 4; ++q)
#pragma unroll
        for (int e = 0; e < 4; ++e) { const float gq = tb ? 1.f : tj.g[q][e]; va[4 * q + e] = tj.a[q][e] * gq; vb[4 * q + e] = tj.b[q][e] * gq; }
    float ma = 0.f, mb = 0.f;
#pragma unroll
    for (int e = 0; e < 16; ++e) { ma = fmaxf(ma, __builtin_fabsf(va[e])); mb = fmaxf(mb, __builtin_fabsf(vb[e])); }
#pragma unroll
    for (int o = 32; o >= 1; o >>= 1) { ma = fmaxf(ma, __shfl_xor(ma, o)); mb = fmaxf(mb, __shfl_xor(mb, o)); }
    ma = fmaxf(ma, 1e-30f); mb = fmaxf(mb, 1e-30f);
    const float ia = 7.5f / ma, ib = 7.5f / mb;
    h32_t hv;
#pragma unroll
    for (int e = 0; e < 16; ++e) { hv[e] = (_Float16)(va[e] * ia); hv[16 + e] = (_Float16)(vb[e] * ib); }
    const u32x6 enc = __builtin_amdgcn_cvt_scalef32_pk32_fp6_f16(hv, 1.0f);
    unsigned char* dst = ws + (tb ? WS_VB : WS_UB) + (size_t)r0 * 768 + lane * 12;
    *(u32x3a*)dst = (u32x3a){enc[0], enc[1], enc[2]}; *(u32x3a*)(dst + 768) = (u32x3a){enc[3], enc[4], enc[5]};
    if (lane == 0) { float* SUVp = (float*)(ws + WS_SUV); SUVp[tb * 16384 + r0] = ma * (1.f / 7.5f); SUVp[tb * 16384 + r0 + 1] = mb * (1.f / 7.5f); }
}
__device__ __forceinline__ void dsa_unit(const Params& p, LAS unsigned char* lds, int b, int qb16, const TabJob& tj) {
    unsigned char* ws = p.ws;
    int tid = threadIdx.x; asm volatile("" : "+v"(tid));
    const int lane = tid & 63, wave = __builtin_amdgcn_readfirstlane(tid >> 6);
    const int g = lane >> 4, fr = lane & 15, t0 = 16 * qb16, nkt = qb16 + 1;
    const size_t m0 = (size_t)b * SEQ + t0;
    LAS bf16_t* QS = (LAS bf16_t*)(lds + DL_QS); LAS float* WQ = (LAS float*)(lds + DL_WQ);
    LAS unsigned short* SEL = (LAS unsigned short*)(lds + DL_SEL); LAS unsigned* HIST = (LAS unsigned*)(lds + DL_HIST) + wave * 256;
    const LAS unsigned char* BK = lds + DL_BKT; const LAS float* RB = (const LAS float*)(lds + DL_RB);
    _Float16* scr = (_Float16*)(ws + WS_SCR) + (size_t)blockIdx.x * (16 * SEQ);
#ifdef PROBE_TIME
    const unsigned long long td0 = __builtin_amdgcn_s_memrealtime();
#endif
    {
        const bf16_t* qsrc = (const bf16_t*)(ws + WS_QIDX) + m0 * 1024;
#pragma unroll
        for (int i = 0; i < 4; ++i) { const int piece = tid + 512 * i, qi = piece >> 7, rem = piece & 127, h = rem >> 3, ch = rem & 7;
            *(LAS u32x4*)(QS + (h * 16 + qi) * 72 + ch * 8) = *(const u32x4*)(qsrc + (size_t)qi * 1024 + h * 64 + ch * 8); }
        if (tid < 256) WQ[tid] = ((const float*)(ws + WS_WIDX))[m0 * 16 + tid];
        __syncthreads();
        tab_finish(ws, tj, lane);
        { const int qi = tid >> 5, d = (tid & 31) * 2; float s0 = 0.f, s1 = 0.f;
#pragma unroll
            for (int h = 0; h < 16; ++h) { const unsigned w2 = *(const LAS unsigned*)(QS + (h * 16 + qi) * 72 + d); const float wh = WQ[qi * 16 + h]; s0 = fmaf(wh, bf_lo(w2), s0); s1 = fmaf(wh, bf_hi(w2), s1); }
            *(LAS unsigned*)(QS + (16 * 16 + qi) * 72 + d) = cvt_pk_bf16(s0, s1); }
        __syncthreads();
    }
    {
        float wreg[16];
#pragma unroll
        for (int h = 0; h < 16; ++h) wreg[h] = WQ[fr * 16 + h];
        const bf16_t* kbase = (const bf16_t*)(ws + WS_KIDXN) + (size_t)b * SEQ * 64;
        constexpr int NQR = 11;
        bf16x8 qfr[NQR][2];
#pragma unroll
        for (int h = 0; h < NQR; ++h) { qfr[h][0] = *(const LAS bf16x8*)(QS + (h * 16 + fr) * 72 + 8 * g); qfr[h][1] = *(const LAS bf16x8*)(QS + (h * 16 + fr) * 72 + 32 + 8 * g); }
        bf16x8 kn[2];
        { int kt = wave; if (kt >= nkt) kt = 0; const bf16_t* kr = kbase + (size_t)(16 * kt + fr) * 64 + 8 * g; kn[0] = *(const bf16x8*)kr; kn[1] = *(const bf16x8*)(kr + 32); }
#pragma unroll 1
        for (int kt = wave; kt < nkt; kt += 8) {
            const bf16x8 ka0 = kn[0], ka1 = kn[1];
            { int k2 = kt + 8; if (k2 >= nkt) k2 = 0; const bf16_t* kr = kbase + (size_t)(16 * k2 + fr) * 64 + 8 * g; kn[0] = *(const bf16x8*)kr; kn[1] = *(const bf16x8*)(kr + 32); }
            f32x4 sc = {0.f, 0.f, 0.f, 0.f};
            unsigned oz1; asm volatile("v_mov_b32 %0, 0" : "=v"(oz1));
            const LAS bf16_t* QSz = QS + oz1;
            bf16x8 ql[17 - NQR][2];
#pragma unroll
            for (int h = NQR; h < 17; ++h) { ql[h - NQR][0] = *(const LAS bf16x8*)(QSz + (h * 16 + fr) * 72 + 8 * g); ql[h - NQR][1] = *(const LAS bf16x8*)(QSz + (h * 16 + fr) * 72 + 32 + 8 * g); }
#pragma unroll
            for (int h = 0; h < 17; ++h) { f32x4 c = {0.f, 0.f, 0.f, 0.f}; const bf16x8 q0 = (h < NQR) ? qfr[h < NQR ? h : 0][0] : ql[h >= NQR ? h - NQR : 0][0], q1 = (h < NQR) ? qfr[h < NQR ? h : 0][1] : ql[h >= NQR ? h - NQR : 0][1];
                c = MFMA16(ka0, q0, c); c = MFMA16(ka1, q1, c);
                if (h < 16) {
#pragma unroll
                    for (int r = 0; r < 4; ++r) { float t = fmaf(__builtin_fabsf(c[r]), wreg[h < 16 ? h : 0], sc[r]); asm volatile("" : "+v"(t)); sc[r] = t; }
                } else sc += c; }
            { _Float16 hv[4];
#pragma unroll
                for (int r = 0; r < 4; ++r) { const int key = 16 * kt + 4 * g + r; float v = sc[r]; if (kt == nkt - 1 && key > t0 + fr) v = -INFINITY; hv[r] = (_Float16)v; }
                typedef _Float16 h4 __attribute__((ext_vector_type(4))); h4 o; o[0] = hv[0]; o[1] = hv[1]; o[2] = hv[2]; o[3] = hv[3];
                *(h4*)(scr + (size_t)fr * SEQ + 16 * kt + 4 * g) = o; }
        }
    }
    VM_WAIT(); __syncthreads();
#ifdef PROBE_TIME
    const unsigned long long td1 = __builtin_amdgcn_s_memrealtime(); unsigned long long t2acc = 0, t3acc = 0;
#endif
    const unsigned char* ckv8 = ws + WS_CKV8 + (size_t)b * SEQ * 256;
    bf16_t* AO = (bf16_t*)(ws + WS_AOUT);
    LAS unsigned char* img = lds + DL_IMG + wave * 16384;
#pragma unroll 1
    for (int qq = 0; qq < 2; ++qq) {
#ifdef PROBE_TIME
        const unsigned long long tdq = __builtin_amdgcn_s_memrealtime();
#endif
        int lane3 = threadIdx.x & 63; asm volatile("" : "+v"(lane3));
        const int lane = lane3, g = lane >> 4, fr = lane & 15;
        const unsigned long long lt_mask = (1ull << lane) - 1ull;
        const int qi = wave + 8 * qq, t = t0 + qi, n = t + 1; const size_t m = m0 + qi;
        LAS unsigned short* sel = SEL + qi * 256;
        int cnt;
        if (n <= 256) { cnt = n; for (int k = lane; k < 256; k += 64) sel[k] = (unsigned short)((k < n) ? k : 0); }
        else {
            cnt = 256;
            const unsigned* srow = (const unsigned*)(scr + (size_t)qi * SEQ); const int nw = (n + 1) >> 1;
            unsigned sv[64];
            const int nfull = n >> 1;
#pragma unroll
            for (int blk = 0; blk < 4; ++blk) {
                if (1024 * blk < nw) {
#pragma unroll
                    for (int jj = 0; jj < 16; ++jj) { const int j = 16 * blk + jj; sv[j] = srow[lane + 64 * j]; }
                } else {
#pragma unroll
                    for (int jj = 0; jj < 16; ++jj) sv[16 * blk + jj] = 0u;
                }
            }
            LAS unsigned* H = (LAS unsigned*)img;
#pragma unroll
            for (int k = 0; k < 8; ++k) *(LAS u32x4*)(H + 4 * (lane + 64 * k)) = (u32x4){0u, 0u, 0u, 0u};
            LDS_WAIT();
#pragma unroll
            for (int blk = 0; blk < 4; ++blk) if (1024 * blk < nw) {
#pragma unroll
                for (int jj = 0; jj < 16; ++jj) { const int j = 16 * blk + jj; const unsigned v = sv[j];
                    const unsigned neg = (v >> 15) & 0x00010001u, msk = (neg << 16) - neg;
                    unsigned kk = v ^ (msk | 0x80008000u);
                    if (64 * j + 64 <= nfull) {
                        sv[j] = kk;
                        __hip_atomic_fetch_add(H + ((kk & 0xffffu) >> 5), 1u, __ATOMIC_RELAXED, __HIP_MEMORY_SCOPE_WORKGROUP);
                        __hip_atomic_fetch_add(H + (kk >> 21), 1u, __ATOMIC_RELAXED, __HIP_MEMORY_SCOPE_WORKGROUP);
                    } else {
                        const int w = lane + 64 * j;
                        kk = (w < nw) ? kk : 0u; if (2 * w + 1 >= n) kk &= 0xFFFFu;
                        sv[j] = kk;
                        const unsigned k0 = kk & 0xffffu, k1 = kk >> 16;
                        if (k0) __hip_atomic_fetch_add(H + (k0 >> 5), 1u, __ATOMIC_RELAXED, __HIP_MEMORY_SCOPE_WORKGROUP);
                        if (k1) __hip_atomic_fetch_add(H + (k1 >> 5), 1u, __ATOMIC_RELAXED, __HIP_MEMORY_SCOPE_WORKGROUP);
                    } }
            }
            LDS_WAIT();
            unsigned b1, need1;
            {
                unsigned hb[32];
#pragma unroll
                for (int k = 0; k < 8; ++k) { const u32x4 t = *(const LAS u32x4*)(H + 32 * lane + 4 * k); hb[4 * k] = t.x; hb[4 * k + 1] = t.y; hb[4 * k + 2] = t.z; hb[4 * k + 3] = t.w; }
                unsigned s32 = 0u;
#pragma unroll
                for (int k = 0; k < 32; ++k) s32 += hb[k];
                unsigned incl = s32;
#pragma unroll
                for (int o = 1; o < 64; o <<= 1) { const unsigned t = __shfl_down(incl, o); if (lane + o < 64) incl += t; }
                const unsigned excl = incl - s32; const bool hit = (excl < 256u) && (incl >= 256u);
                unsigned run = excl, bb = 0u, ab = excl; bool found = false;
#pragma unroll
                for (int k = 31; k >= 0; --k) { const unsigned nr = run + hb[k]; if (!found && nr >= 256u) { found = true; bb = (unsigned)k; ab = run; } run = nr; }
                const unsigned long long mask = __ballot(hit); const int src = mask ? (__ffsll((long long)mask) - 1) : 0;
                b1 = __shfl(32u * lane + bb, src); need1 = 256u - __shfl(ab, src);
            }
            LDS_WAIT();
            if (lane < 32) H[lane] = 0u;
            LDS_WAIT();
#pragma unroll
            for (int blk = 0; blk < 4; ++blk) if (1024 * blk < nw) {
#pragma unroll
                for (int jj = 0; jj < 16; ++jj) { const unsigned v = sv[16 * blk + jj]; const unsigned k0 = v & 0xffffu, k1 = v >> 16;
                    if ((k0 >> 5) == b1) __hip_atomic_fetch_add(H + (k0 & 31u), 1u, __ATOMIC_RELAXED, __HIP_MEMORY_SCOPE_WORKGROUP);
                    if ((k1 >> 5) == b1) __hip_atomic_fetch_add(H + (k1 & 31u), 1u, __ATOMIC_RELAXED, __HIP_MEMORY_SCOPE_WORKGROUP); }
            }
            LDS_WAIT();
            unsigned thr, need2;
            {
                const unsigned hv = (lane < 32) ? H[lane] : 0u; unsigned incl = hv;
#pragma unroll
                for (int o = 1; o < 32; o <<= 1) { const unsigned t = __shfl_down(incl, o); if (lane + o < 32) incl += t; }
                const unsigned excl = incl - hv; const bool hit = (lane < 32) && (excl < need1) && (incl >= need1);
                const unsigned long long mask = __ballot(hit); const int src = mask ? (__ffsll((long long)mask) - 1) : 0;
                thr = (b1 << 5) | (unsigned)src; need2 = need1 - __shfl(excl, src);
            }
            unsigned mg[4], me[4];
#pragma unroll
            for (int blk = 0; blk < 4; ++blk) { unsigned g1 = 0u, e1 = 0u;
                if (1024 * blk < nw) {
#pragma unroll
                    for (int jj = 0; jj < 16; ++jj) { const unsigned v = sv[16 * blk + jj]; const unsigned k0 = v & 0xffffu, k1 = v >> 16;
                        asm("v_cmp_gt_u32 vcc, %2, %4\n\tv_addc_co_u32 %0, vcc, %0, %0, vcc\n\tv_cmp_gt_u32 vcc, %3, %4\n\tv_addc_co_u32 %0, vcc, %0, %0, vcc\n\t"
                            "v_cmp_eq_u32 vcc, %2, %4\n\tv_addc_co_u32 %1, vcc, %1, %1, vcc\n\tv_cmp_eq_u32 vcc, %3, %4\n\tv_addc_co_u32 %1, vcc, %1, %1, vcc"
                            : "+v"(g1), "+v"(e1) : "v"(k0), "v"(k1), "v"(thr) : "vcc"); }
                }
                mg[blk] = g1; me[blk] = e1; }
            const unsigned cgt = (unsigned)(__builtin_popcount(mg[0]) + __builtin_popcount(mg[1]) + __builtin_popcount(mg[2]) + __builtin_popcount(mg[3]));
            const unsigned ceq = (unsigned)(__builtin_popcount(me[0]) + __builtin_popcount(me[1]) + __builtin_popcount(me[2]) + __builtin_popcount(me[3]));
            unsigned pg = cgt, pe = ceq;
#pragma unroll
            for (int o = 1; o < 64; o <<= 1) { const unsigned tg = __shfl_up(pg, o), te = __shfl_up(pe, o); if (lane >= o) { pg += tg; pe += te; } }
            unsigned og = pg - cgt, oe = pe - ceq;
#pragma unroll
            for (int blk = 0; blk < 4; ++blk) {
                unsigned m = mg[blk];
                while (__any(m != 0u)) {
                    if (m) { const int bp = __builtin_ctz(m); const int pq = 31 - bp; sel[og] = (unsigned short)(2 * (lane + 64 * (16 * blk + (pq >> 1))) + (pq & 1)); ++og; m &= m - 1u; } }
                m = me[blk];
                while (__any(m != 0u)) {
                    if (m) { const int bp = __builtin_ctz(m); const int pq = 31 - bp; if (oe < need2) sel[255u - oe] = (unsigned short)(2 * (lane + 64 * (16 * blk + (pq >> 1))) + (pq & 1)); ++oe; m &= m - 1u; } }
            }
        }
        LDS_WAIT();
#ifdef PROBE_TIME
        const unsigned long long td2 = __builtin_amdgcn_s_memrealtime();
#endif
        bf16x8 qf[8];
        { const bf16_t* qrow = AO + m * 1536 + 512 + (fr & 3) * 256;
#pragma unroll
            for (int s = 0; s < 8; ++s) { bf16x8 v = *(const bf16x8*)(qrow + 64 * (s >> 1) + 16 * g + 8 * (s & 1)); if (fr >= 4) v = (bf16x8){0, 0, 0, 0, 0, 0, 0, 0}; qf[s] = v; } }
        f32x4 O[16];
#pragma unroll
        for (int c = 0; c < 16; ++c) O[c] = (f32x4){0.f, 0.f, 0.f, 0.f};
        float mrun = -1e30f, lrun = 0.f;
        const int nchunk = (cnt + 31) >> 5;
        const unsigned img_base = (unsigned)(size_t)img;
        u32x4 gp[8];
#pragma unroll
        for (int rb = 0; rb < 2; ++rb) { const int slot = 16 * rb + fr; const unsigned kraw = sel[slot]; const unsigned key = (slot < cnt) ? kraw : 0u; const unsigned char* kp = ckv8 + (size_t)key * 256 + 16 * g;
#pragma unroll
            for (int pq = 0; pq < 4; ++pq) gp[4 * rb + pq] = *(const u32x4*)(kp + 64 * pq); }
        const unsigned swz_w = ((fr & 3u) << 2) | ((fr >> 2) & 3u), wb = img_base + 256u * fr + 16u * ((2u * g) ^ swz_w);
        const unsigned q4 = (unsigned)fr >> 2, pp = (unsigned)fr & 3u, rrow = 4u * g + q4, swz_r = ((rrow & 3u) << 2) | ((rrow >> 2) & 3u);
        const unsigned rbs = img_base + 256u * rrow + 16u * ((pp >> 1) ^ swz_r) + 8u * (pp & 1u);
#pragma unroll 1
        for (int ck = 0; ck < nchunk; ++ck) {
            f32x4 sacc[2] = {(f32x4){0.f, 0.f, 0.f, 0.f}, (f32x4){0.f, 0.f, 0.f, 0.f}};
#pragma unroll
            for (int i = 0; i < 8; ++i) {
                u32x4 lo, hi;
#pragma unroll
                for (int q = 0; q < 2; ++q) { lo[2 * q] = __builtin_bit_cast(unsigned, __builtin_amdgcn_cvt_scalef32_pk_bf16_fp8(gp[i][q], 1.0f, false)); lo[2 * q + 1] = __builtin_bit_cast(unsigned, __builtin_amdgcn_cvt_scalef32_pk_bf16_fp8(gp[i][q], 1.0f, true));
                    hi[2 * q] = __builtin_bit_cast(unsigned, __builtin_amdgcn_cvt_scalef32_pk_bf16_fp8(gp[i][2 + q], 1.0f, false)); hi[2 * q + 1] = __builtin_bit_cast(unsigned, __builtin_amdgcn_cvt_scalef32_pk_bf16_fp8(gp[i][2 + q], 1.0f, true)); }
                sacc[i >> 2] = MFMA16(__builtin_bit_cast(bf16x8, lo), qf[2 * (i & 3)], sacc[i >> 2]); sacc[i >> 2] = MFMA16(__builtin_bit_cast(bf16x8, hi), qf[2 * (i & 3) + 1], sacc[i >> 2]);
                const unsigned wa = wb ^ (128u * (i & 1)), cst = 8192u * ((i & 3) >> 1) + 4096u * (i >> 2);
                *(LAS u32x4*)(size_t)(wa + cst) = lo; *(LAS u32x4*)(size_t)((wa ^ 16u) + cst) = hi; }
            if (ck + 1 < nchunk) {
#pragma unroll
                for (int rb = 0; rb < 2; ++rb) { const int slot = 32 * (ck + 1) + 16 * rb + fr; const unsigned kraw = sel[slot]; const unsigned key = (slot < cnt) ? kraw : 0u; const unsigned char* kp = ckv8 + (size_t)key * 256 + 16 * g;
#pragma unroll
                    for (int pq = 0; pq < 4; ++pq) gp[4 * rb + pq] = *(const u32x4*)(kp + 64 * pq); }
            }
            float lg[8]; float mx = -1e30f;
#pragma unroll
            for (int rb = 0; rb < 2; ++rb) { const u32x2 kk = *(const LAS u32x2*)(sel + 32 * ck + 16 * rb + 4 * g);
#pragma unroll
                for (int r = 0; r < 4; ++r) { const int slot = 32 * ck + 16 * rb + 4 * g + r; const unsigned kw = (r < 2) ? kk.x : kk.y; const int key = (r & 1) ? (int)(kw >> 16) : (int)(kw & 0xffffu);
                    int dist = t - key; dist = dist < 0 ? 0 : dist; const int bk = BK[dist];
                    float v = sacc[rb][r] + RB[bk * 4 + (fr & 3)]; if (slot >= cnt) v = -1e30f; if (fr >= 4) v = 0.f; lg[4 * rb + r] = v; mx = fmaxf(mx, v); } }
            mx = fmaxf(mx, __shfl_xor(mx, 16)); mx = fmaxf(mx, __shfl_xor(mx, 32));
            const float mnew = fmaxf(mrun, mx), alpha = __expf(mrun - mnew);
            float pv[8], ps = 0.f;
#pragma unroll
            for (int j = 0; j < 8; ++j) { pv[j] = __expf(lg[j] - mnew); ps += pv[j]; }
            lrun = lrun * alpha + ps; mrun = mnew;
            const bf16x8 pf = pk8((f32x4){pv[0], pv[1], pv[2], pv[3]}, (f32x4){pv[4], pv[5], pv[6], pv[7]});
            if (__any(alpha != 1.f)) {
#pragma unroll
                for (int c = 0; c < 16; ++c) O[c] *= alpha;
            }
#pragma unroll
            for (int c4 = 0; c4 < 4; ++c4) {
                u32x2 rr[8];
                const unsigned a0 = rbs ^ (32u * ((4 * c4) & 7)), a1 = rbs ^ (32u * ((4 * c4 + 1) & 7)), a2 = rbs ^ (32u * ((4 * c4 + 2) & 7)), a3 = rbs ^ (32u * ((4 * c4 + 3) & 7));
                asm volatile("ds_read_b64_tr_b16 %0, %8 offset:%12\n\tds_read_b64_tr_b16 %1, %8 offset:%13\n\tds_read_b64_tr_b16 %2, %9 offset:%12\n\tds_read_b64_tr_b16 %3, %9 offset:%13\n\t"
                             "ds_read_b64_tr_b16 %4, %10 offset:%12\n\tds_read_b64_tr_b16 %5, %10 offset:%13\n\tds_read_b64_tr_b16 %6, %11 offset:%12\n\tds_read_b64_tr_b16 %7, %11 offset:%13\n\ts_waitcnt lgkmcnt(0)"
                             : "=&v"(rr[0]), "=&v"(rr[1]), "=&v"(rr[2]), "=&v"(rr[3]), "=&v"(rr[4]), "=&v"(rr[5]), "=&v"(rr[6]), "=&v"(rr[7])
                             : "v"(a0), "v"(a1), "v"(a2), "v"(a3), "n"(8192 * (c4 >> 1)), "n"(8192 * (c4 >> 1) + 4096) : "memory");
#pragma unroll
                for (int j = 0; j < 4; ++j) O[4 * c4 + j] = MFMA16(mk8(rr[2 * j], rr[2 * j + 1]), pf, O[4 * c4 + j]);
            }
        }
        lrun += __shfl_xor(lrun, 16); lrun += __shfl_xor(lrun, 32);
        const float inv = 1.f / lrun;
        if (fr < 4) {
#pragma unroll
            for (int c = 0; c < 16; ++c) {
#ifdef ZERO_DSA
                const f32x4 v = O[c] * 0.f; (void)inv;
#elif defined(DOUBLE_DSA)
                const f32x4 v = O[c] * (2.f * inv);
#else
                const f32x4 v = O[c] * inv;
#endif
                u32x2 w; w.x = cvt_pk_bf16(v[0], v[1]); w.y = cvt_pk_bf16(v[2], v[3]); *(LAS u32x2*)(img + 2 * (fr * 256 + 16 * c + 4 * g)) = w; } }
        LDS_WAIT(); asm volatile("" ::: "memory");
        { const u32x4 t0 = *(const LAS u32x4*)(img + 16 * lane), t1 = *(const LAS u32x4*)(img + 1024 + 16 * lane);
          u32x4* orow = (u32x4*)(AO + m * 1536 + 512); orow[lane] = t0; orow[64 + lane] = t1; }
        LDS_WAIT(); asm volatile("" ::: "memory");
#ifdef PROBE_TIME
        { const unsigned long long td3 = __builtin_amdgcn_s_memrealtime(); t2acc += td2 - tdq; t3acc += td3 - td2; }
#endif
    }
#ifdef PROBE_TIME
    const unsigned long long tdw = __builtin_amdgcn_s_memrealtime();
#endif
    __syncthreads();
#ifdef PROBE_TIME
    if (blockIdx.x == 255 && threadIdx.x == 0) { ((volatile float*)(ws + WS_CTL))[2048 + 28] += (float)(__builtin_amdgcn_s_memrealtime() - tdw) * 0.01f; }
    if (blockIdx.x == 255 && threadIdx.x == 0) { volatile float* ct = (volatile float*)(ws + WS_CTL) + 2048; ct[20] += (float)(td1 - td0) * 0.01f; ct[21] += (float)t2acc * 0.01f; ct[22] += (float)t3acc * 0.01f; ct[23] += 1.f; ct[27] += (float)(__builtin_amdgcn_s_memrealtime() - td0) * 0.01f; }
#endif
}

__device__ __forceinline__ float erf_as(float x) {
    const float ax = __builtin_fabsf(x);
    const float t = __builtin_amdgcn_rcpf(fmaf(0.3275911f, ax, 1.f));
    float pl = fmaf(1.061405429f, t, -1.453152027f); pl = fmaf(pl, t, 1.421413741f); pl = fmaf(pl, t, -0.284496736f); pl = fmaf(pl, t, 0.254829592f); pl *= t;
    const float e = __builtin_amdgcn_exp2f(ax * ax * -1.4426950408889634f);
    return __builtin_copysignf(fmaf(-pl, e, 1.f), x);
}
__device__ __forceinline__ unsigned mbcnt64(unsigned long long m) { return __builtin_amdgcn_mbcnt_hi((unsigned)(m >> 32), __builtin_amdgcn_mbcnt_lo((unsigned)m, 0u)); }
__device__ __forceinline__ float pack_idx(float v, unsigned idx, unsigned mask) { return __uint_as_float((__float_as_uint(v) & ~mask) | idx); }
__device__ __forceinline__ void ins16(float (&L)[16], float x) {
#pragma unroll
    for (int i = 15; i >= 1; --i) L[i] = __builtin_amdgcn_fmed3f(L[i - 1], L[i], x);
    L[0] = fmaxf(L[0], x);
}
__device__ __forceinline__ unsigned pk4_fp8(float a, float b, float c, float d) { int w = __builtin_amdgcn_cvt_pk_fp8_f32(a, b, 0, false); w = __builtin_amdgcn_cvt_pk_fp8_f32(c, d, w, true); return (unsigned)w; }
__device__ __forceinline__ float dot2bf(unsigned a, unsigned b, float acc) { return __builtin_amdgcn_fdot2_f32_bf16(__builtin_bit_cast(bf16x2_t, a), __builtin_bit_cast(bf16x2_t, b), acc, false); }
constexpr float P8_K = 256.f;
#define H2AT(r, i) __builtin_shufflevector(r, r, (i), (i) + 1)
typedef unsigned u32x4a8 __attribute__((ext_vector_type(4), aligned(8)));
__device__ __forceinline__ void p8_offsets(const LAS unsigned short* se, int k0, unsigned (&off)[4], unsigned hoff, unsigned hsh) {
    const u32x4 ew = *(const LAS u32x4*)(se + k0);
#pragma unroll
#ifdef PROBE_MASK
    for (int jj = 0; jj < 4; ++jj) off[jj] = ((ew[jj] >> hsh) & PROBE_MASK) * 768u + hoff;
#else
    for (int jj = 0; jj < 4; ++jj) off[jj] = ((ew[jj] >> hsh) & 0xFFFFu) * 768u + hoff;
#endif
}
#ifdef P8_AUX
typedef __amdgpu_buffer_rsrc_t p8_tab_t;
__device__ __forceinline__ p8_tab_t p8_tab(const unsigned char* T) { return __builtin_amdgcn_make_buffer_rsrc((void*)T, 0, 16384 * 768, 0x00020000); }
__device__ __forceinline__ u32x6 p8_ld(p8_tab_t T, unsigned off) { const u32x4 a = __builtin_amdgcn_raw_buffer_load_b128(T, (int)off, 0, P8_AUX); const u32x2 c = __builtin_amdgcn_raw_buffer_load_b64(T, (int)off + 16, 0, P8_AUX); return (u32x6){a[0], a[1], a[2], a[3], c[0], c[1]}; }
#else
typedef const unsigned char* p8_tab_t;
__device__ __forceinline__ p8_tab_t p8_tab(const unsigned char* T) { return T; }
__device__ __forceinline__ u32x6 p8_ld(const unsigned char* T, unsigned off) { const u32x4a8 a = *(const u32x4a8*)(T + off); const u32x2 c = *(const u32x2*)(T + off + 16); return (u32x6){a[0], a[1], a[2], a[3], c[0], c[1]}; }
#endif
__device__ __forceinline__ void p8_u(u32x6 (&up)[4], const unsigned (&offn)[4], p8_tab_t Tn, LAS float* sg, const LAS float* sul, int k0, const h2_t (&xh)[16], float rs, int lane) {
    float part[4];
#pragma unroll
    for (int jj = 0; jj < 4; ++jj) {
        const h32_t r = __builtin_amdgcn_cvt_scalef32_pk32_f16_fp6(up[jj], 1.0f);
        up[jj] = p8_ld(Tn, offn[jj]);
        float d0 = 0.f, d1 = 0.f;
        d0 = __builtin_amdgcn_fdot2(H2AT(r, 0), xh[0], d0, false); d1 = __builtin_amdgcn_fdot2(H2AT(r, 2), xh[1], d1, false);
        d0 = __builtin_amdgcn_fdot2(H2AT(r, 4), xh[2], d0, false); d1 = __builtin_amdgcn_fdot2(H2AT(r, 6), xh[3], d1, false);
        d0 = __builtin_amdgcn_fdot2(H2AT(r, 8), xh[4], d0, false); d1 = __builtin_amdgcn_fdot2(H2AT(r, 10), xh[5], d1, false);
        d0 = __builtin_amdgcn_fdot2(H2AT(r, 12), xh[6], d0, false); d1 = __builtin_amdgcn_fdot2(H2AT(r, 14), xh[7], d1, false);
        d0 = __builtin_amdgcn_fdot2(H2AT(r, 16), xh[8], d0, false); d1 = __builtin_amdgcn_fdot2(H2AT(r, 18), xh[9], d1, false);
        d0 = __builtin_amdgcn_fdot2(H2AT(r, 20), xh[10], d0, false); d1 = __builtin_amdgcn_fdot2(H2AT(r, 22), xh[11], d1, false);
        d0 = __builtin_amdgcn_fdot2(H2AT(r, 24), xh[12], d0, false); d1 = __builtin_amdgcn_fdot2(H2AT(r, 26), xh[13], d1, false);
        d0 = __builtin_amdgcn_fdot2(H2AT(r, 28), xh[14], d0, false); d1 = __builtin_amdgcn_fdot2(H2AT(r, 30), xh[15], d1, false);
        part[jj] = d0 + d1; }
    float r2[2];
#pragma unroll
    for (int k = 0; k < 2; ++k) { const float mine = (lane & 16) ? part[k + 2] : part[k], theirs = (lane & 16) ? part[k] : part[k + 2]; r2[k] = mine + __shfl_xor(theirs, 16); }
    float r1; { const float mine = (lane & 8) ? r2[1] : r2[0], theirs = (lane & 8) ? r2[0] : r2[1]; r1 = mine + dpp_mov<0x128>(theirs); }
    r1 += dpp_mov<0xB1>(r1); r1 += dpp_mov<0x4E>(r1); r1 += dpp_mov<0x141>(r1);
    const int jl = ((lane >> 4) & 1) * 4 + ((lane >> 3) & 1) * 2 + ((lane >> 5) & 1);
    const float a = r1 * rs * sul[k0 + jl]; const float act = 0.5f * a * (1.f + erf_as(a * 0.70710678118654752f));
    const float coef = sg[k0 + jl] * act;
    if ((lane & 7) == 0) sg[k0 + jl] = coef;
}
__device__ __forceinline__ void p8_v(u32x6 (&vp)[4], const unsigned (&offn)[4], p8_tab_t Tn, const LAS float* sg, int k0, h2_t (&y16)[16], int lane) {
    float cj[4];
#pragma unroll
    for (int jj = 0; jj < 4; ++jj) cj[jj] = sg[k0 + 2 * jj + (lane >> 5)];
#pragma unroll
    for (int jj = 0; jj < 4; ++jj) {
        const h32_t r = __builtin_amdgcn_cvt_scalef32_pk32_f16_fp6(vp[jj], 1.0f);
        vp[jj] = p8_ld(Tn, offn[jj]);
        const _Float16 cf = (_Float16)cj[jj]; const h2_t c2 = {cf, cf};
        y16[0] += c2 * H2AT(r, 0); y16[1] += c2 * H2AT(r, 2); y16[2] += c2 * H2AT(r, 4); y16[3] += c2 * H2AT(r, 6);
        y16[4] += c2 * H2AT(r, 8); y16[5] += c2 * H2AT(r, 10); y16[6] += c2 * H2AT(r, 12); y16[7] += c2 * H2AT(r, 14);
        y16[8] += c2 * H2AT(r, 16); y16[9] += c2 * H2AT(r, 18); y16[10] += c2 * H2AT(r, 20); y16[11] += c2 * H2AT(r, 22);
        y16[12] += c2 * H2AT(r, 24); y16[13] += c2 * H2AT(r, 26); y16[14] += c2 * H2AT(r, 28); y16[15] += c2 * H2AT(r, 30); }
}
__device__ __forceinline__ h2_t bf2_to_h2(unsigned w) { return __builtin_bit_cast(h2_t, __builtin_amdgcn_cvt_pkrtz(__uint_as_float(w << 16), __uint_as_float(w & 0xFFFF0000u))); }
__device__ __forceinline__ void p8_peer(const Params& p, LAS unsigned char* lds, int bx, int wave, int lane_in, XcdBarrier& bar) {
    unsigned char* ws = p.ws;
    const _Float16* S = (const _Float16*)(ws + WS_S); const float* rss = (const float*)(ws + WS_CTL + CTL_RSS);
    const p8_tab_t UB6 = p8_tab(ws + WS_UB), VB6 = p8_tab(ws + WS_VB); const bf16_t* X1B = (const bf16_t*)(ws + WS_X1B);
    const float* SU = (const float*)(ws + WS_SUV); const float* SV = SU + 16384;
    LAS unsigned short* EI = (LAS unsigned short*)(lds + wave * 6656);
    LAS float* GT = (LAS float*)(lds + wave * 6656 + 1024);
    LAS unsigned char* IX = lds + wave * 6656 + 3072;
    LAS float* SUL = (LAS float*)(lds + wave * 6656 + 4352);
    LAS float* YL = (LAS float*)(lds + 8 * 6656 + wave * 4096);
#ifdef PROBE_TIME
    unsigned long long pr_acc = 0, ps_acc = 0, pg_acc = 0;
#endif
    unsigned nsync = 0;
#pragma unroll 1
    for (int blk0 = 0; blk0 < MT / 128; blk0 += (int)gridDim.x)
    for (int ds = 0; ds < 4; ++ds) {
#ifdef P8_ALIGN
        if (blk0 + ds > 0) xcd_barrier(bar);
#endif
        const int blk = blk0 + bx; if (blk >= MT / 128) continue;
        int lane = lane_in; asm volatile("" : "+v"(lane));
        const int tq = lane >> 4, hs = lane & 15, head = hs >> 1, side = hs & 1;
        const size_t m0 = ((size_t)blk * 4 + ds) * 32 + wave * 4;
#ifdef PROBE_TIME
        const unsigned long long tp0 = __builtin_amdgcn_s_memrealtime();
#endif
        {
            const size_t m = m0 + tq; const _Float16* srow = S + m * 2048 + hs * 128;
            float L[16];
#pragma unroll
            for (int i = 0; i < 16; ++i) L[i] = -INFINITY;
#pragma unroll 4
            for (int j8 = 0; j8 < 16; ++j8) { const u32x4 v = ((const u32x4*)srow)[j8];
                const unsigned vw[4] = {v.x, v.y, v.z, v.w};
#pragma unroll
                for (int e = 0; e < 4; ++e) { const float lo = (float)__builtin_bit_cast(_Float16, (unsigned short)(vw[e] & 0xFFFFu)), hi = (float)__builtin_bit_cast(_Float16, (unsigned short)(vw[e] >> 16));
                    ins16(L, pack_idx(lo, (unsigned)(8 * j8 + 2 * e), 0x7Fu)); ins16(L, pack_idx(hi, (unsigned)(8 * j8 + 2 * e + 1), 0x7Fu)); } }
            float A[16], B[16];
#pragma unroll
            for (int i = 0; i < 16; ++i) { const float o = dpp_mov<0xB1>(L[i]); A[i] = side ? o : L[i]; B[i] = side ? L[i] : o; }
            float C[16];
#pragma unroll
            for (int i = 0; i < 16; ++i) C[i] = -INFINITY;
#pragma unroll
            for (int i = 0; i < 16; ++i)
#pragma unroll
                for (int j = 0; j < 16; ++j) if ((i + 1) * (j + 1) <= 16) {
                    const unsigned ab = __float_as_uint(A[i]), bb = __float_as_uint(B[j]);
                    const float sum = __uint_as_float(ab & ~0x7Fu) + __uint_as_float(bb & ~0x7Fu);
                    ins16(C, pack_idx(sum, (unsigned)(i * 16 + j), 0xFFu)); }
            { u32x4 w;
                w.x = (__float_as_uint(L[0]) & 0x7Fu) | ((__float_as_uint(L[1]) & 0x7Fu) << 8) | ((__float_as_uint(L[2]) & 0x7Fu) << 16) | ((__float_as_uint(L[3]) & 0x7Fu) << 24);
                w.y = (__float_as_uint(L[4]) & 0x7Fu) | ((__float_as_uint(L[5]) & 0x7Fu) << 8) | ((__float_as_uint(L[6]) & 0x7Fu) << 16) | ((__float_as_uint(L[7]) & 0x7Fu) << 24);
                w.z = (__float_as_uint(L[8]) & 0x7Fu) | ((__float_as_uint(L[9]) & 0x7Fu) << 8) | ((__float_as_uint(L[10]) & 0x7Fu) << 16) | ((__float_as_uint(L[11]) & 0x7Fu) << 24);
                w.w = (__float_as_uint(L[12]) & 0x7Fu) | ((__float_as_uint(L[13]) & 0x7Fu) << 8) | ((__float_as_uint(L[14]) & 0x7Fu) << 16) | ((__float_as_uint(L[15]) & 0x7Fu) << 24);
                *(LAS u32x4*)(IX + lane * 16) = w; }
            LDS_WAIT(); asm volatile("" ::: "memory");
            float tv[16]; unsigned ei[16]; float mx = -INFINITY;
#pragma unroll
            for (int k = 0; k < 16; ++k) { const unsigned rk = __float_as_uint(C[k]) & 0xFFu; const unsigned i1 = IX[(lane & ~1) * 16 + (rk >> 4)], i2 = IX[(lane | 1) * 16 + (rk & 15u)];
                ei[k] = (i1 << 7) | i2; tv[k] = (float)S[m * 2048 + head * 256 + i1] + (float)S[m * 2048 + head * 256 + 128 + i2]; mx = fmaxf(mx, tv[k]); }
            float z = 0.f;
#pragma unroll
            for (int k = 0; k < 16; ++k) { tv[k] = __expf(tv[k] - mx); z += tv[k]; }
            const float iz = 1.f / z;
#pragma unroll
            for (int k = 0; k < 16; ++k) { EI[tq * 128 + head * 16 + k] = (unsigned short)ei[k]; GT[tq * 128 + head * 16 + k] = tv[k] * iz * (SV[ei[k]] * P8_K); SUL[tq * 128 + head * 16 + k] = SU[ei[k]]; }
        }
        LDS_WAIT(); asm volatile("" ::: "memory");
#ifdef PROBE_TIME
        const unsigned long long tp1 = __builtin_amdgcn_s_memrealtime();
#endif
#pragma unroll 1
        for (int t4 = 0; t4 < 4; ++t4) {
            const unsigned e0 = EI[t4 * 128 + lane], e1 = EI[t4 * 128 + 64 + lane]; const float g0 = GT[t4 * 128 + lane], g1 = GT[t4 * 128 + 64 + lane], s0 = SUL[t4 * 128 + lane], s1 = SUL[t4 * 128 + 64 + lane];
            LDS_WAIT(); asm volatile("" ::: "memory");
            unsigned base = 0u;
#pragma unroll 1
            for (unsigned s = 0; s < 16; ++s) {
                const bool h0 = (e0 >> 10) == s, h1 = (e1 >> 10) == s;
                const unsigned long long b0 = __ballot(h0), b1 = __ballot(h1);
                if (h0) { const unsigned pos = base + mbcnt64(b0); EI[t4 * 128 + pos] = (unsigned short)e0; GT[t4 * 128 + pos] = g0; SUL[t4 * 128 + pos] = s0; }
                if (h1) { const unsigned pos = base + (unsigned)__popcll(b0) + mbcnt64(b1); EI[t4 * 128 + pos] = (unsigned short)e1; GT[t4 * 128 + pos] = g1; SUL[t4 * 128 + pos] = s1; }
                base += (unsigned)__popcll(b0) + (unsigned)__popcll(b1);
            }
        }
        LDS_WAIT(); asm volatile("" ::: "memory");
#ifdef PROBE_TIME
        const unsigned long long tp2 = __builtin_amdgcn_s_memrealtime();
#endif
        {
            const int hf = lane >> 5, sl = lane & 31; const unsigned hoff = 24u * sl, hsh = 16u * hf;
            u32x6 uT[4][4];
#pragma unroll
            for (int tk = 0; tk < 4; ++tk) { unsigned o0[4]; p8_offsets(EI, 128 * tk, o0, hoff, hsh);
#pragma unroll
              for (int jj = 0; jj < 4; ++jj) uT[tk][jj] = p8_ld(UB6, o0[jj]); }
            {
                h2_t y4[4][16];
                {
                h2_t xh[4][16]; float rs4[4];
#pragma unroll
                for (int tk = 0; tk < 4; ++tk) { const u32x4* xr = (const u32x4*)(X1B + (m0 + tk) * 1024) + 4 * sl;
#pragma unroll
                  for (int q = 0; q < 4; ++q) { const u32x4 ta = xr[q];
#pragma unroll
                      for (int e = 0; e < 4; ++e) xh[tk][4 * q + e] = bf2_to_h2(ta[e]); }
                  rs4[tk] = rsqrtf(rss[m0 + tk] * (1.f / DM) + EPS); }
                xcd_local_sync(bar, ++nsync);
#pragma unroll 1
                for (int hp = 0; hp < 2; ++hp) {
                if (hp) xcd_local_sync(bar, ++nsync);
#pragma unroll 1
                for (int i = 8 * hp; i < 8 * hp + 8; ++i) {
                    const int kN = (i < 15) ? 8 * i + 8 : 0; const p8_tab_t Tn = (i < 15) ? UB6 : VB6;
#pragma unroll
                    for (int tk = 0; tk < 4; ++tk) {
                        unsigned offn[4];
                        p8_offsets(EI, 128 * tk + kN, offn, hoff, hsh);
                        p8_u(uT[tk], offn, Tn, GT, SUL, 128 * tk + 8 * i, xh[tk], rs4[tk], lane);
                    }
                }
                }
                }
#pragma unroll
                for (int tk = 0; tk < 4; ++tk)
#pragma unroll
                    for (int i = 0; i < 16; ++i) y4[tk][i] = (h2_t){(_Float16)0.f, (_Float16)0.f};
                xcd_local_sync(bar, ++nsync);
#pragma unroll 1
                for (int hp = 0; hp < 2; ++hp) {
                if (hp) xcd_local_sync(bar, ++nsync);
#pragma unroll 1
                for (int i = 8 * hp; i < 8 * hp + 8; ++i) {
                    const int kN = (i < 15) ? 8 * i + 8 : 120;
#pragma unroll
                    for (int tk = 0; tk < 4; ++tk) {
                        unsigned offn[4];
                        p8_offsets(EI, 128 * tk + kN, offn, hoff, hsh);
                        p8_v(uT[tk], offn, VB6, GT, 128 * tk + 8 * i, y4[tk], lane);
                    }
                }
                }
                int lz = lane; asm volatile("" : "+v"(lz));
                const int hf_e = lz >> 5, sl_e = lz & 31;
#pragma unroll
                for (int tk = 0; tk < 4; ++tk) {
                    const size_t mm = m0 + tk;
                    float y[16];
#pragma unroll
                    for (int q = 0; q < 8; ++q) { const h2_t lo = y4[tk][q], hi = y4[tk][8 + q];
                        const h2_t mine = hf_e ? hi : lo, send = hf_e ? lo : hi; const h2_t recv = __builtin_bit_cast(h2_t, __shfl_xor(__builtin_bit_cast(int, send), 32));
                        y[2 * q] = ((float)mine[0] + (float)recv[0]) * (1.f / P8_K); y[2 * q + 1] = ((float)mine[1] + (float)recv[1]) * (1.f / P8_K); }
#ifdef DOUBLE_PEER
#pragma unroll
                    for (int i = 0; i < 16; ++i) y[i] *= 2.f;
#endif
#ifdef ZERO_PEER
#pragma unroll
                    for (int i = 0; i < 16; ++i) y[i] = 0.f;
#endif
                    LAS float* yl = YL + 32 * sl_e + 16 * hf_e;
#pragma unroll
                    for (int q = 0; q < 4; ++q) *(LAS f32x4*)(yl + 4 * q) = (f32x4){y[4 * q], y[4 * q + 1], y[4 * q + 2], y[4 * q + 3]};
                    LDS_WAIT(); asm volatile("" ::: "memory");
                    f32x4 o[4]; float ss = 0.f;
#pragma unroll
                    for (int k = 0; k < 4; ++k) { const f32x4 yy = *(const LAS f32x4*)(YL + 4 * lz + 256 * k); const u32x2 xw = *(const u32x2*)(X1B + mm * 1024 + 4 * lz + 256 * k);
                        o[k] = (f32x4){bf_lo(xw.x), bf_hi(xw.x), bf_lo(xw.y), bf_hi(xw.y)} + yy; ss += (o[k][0] * o[k][0] + o[k][1] * o[k][1]) + (o[k][2] * o[k][2] + o[k][3] * o[k][3]); }
                    const float rf = rsqrtf(wave_sum(ss) * (1.f / DM) + EPS);
#pragma unroll
                    for (int k = 0; k < 4; ++k) { const f32x4 fgk = *((const f32x4*)p.final_g + lz + 64 * k); *((f32x4*)(p.out + mm * 1024) + lz + 64 * k) = o[k] * rf * fgk; }
                    LDS_WAIT(); asm volatile("" ::: "memory");
                }
            }
        }
        LDS_WAIT(); asm volatile("" ::: "memory");
#ifdef PROBE_TIME
        { const unsigned long long tp3 = __builtin_amdgcn_s_memrealtime(); pr_acc += tp1 - tp0; ps_acc += tp2 - tp1; pg_acc += tp3 - tp2;
          if (blockIdx.x == 1 && threadIdx.x == 0) { volatile float* ct = (volatile float*)(ws + WS_CTL) + 2048; ct[24] = (float)pr_acc * 0.01f; ct[25] = (float)ps_acc * 0.01f; ct[26] = (float)pg_acc * 0.01f; } }
#endif
    }
}


#ifdef PROBE_GDN
__device__ __forceinline__ void gdn_reference(const Params& p, LAS unsigned char* lds) {
    unsigned char* ws = p.ws; const int tid = threadIdx.x, e = tid & 127, rg = tid >> 7;
    LAS float* KQ = (LAS float*)lds;
    LAS float* RED = (LAS float*)(lds + 1024);
    LAS float* OSQ = (LAS float*)(lds + 4096);
    const float* qf = (const float*)(ws + WS_REF); const float* kf = qf + 512 * 128; const float* vf = kf + 512 * 128;
    const float* garr = (const float*)(ws + WS_RES) + 256; const float* barr = (const float*)(ws + WS_RES) + 1024;
    const bf16_t* ZB = (const bf16_t*)(ws + WS_ZB); const bf16_t* AO = (const bf16_t*)(ws + WS_AOUT);
    float S[32];
#pragma unroll
    for (int i = 0; i < 32; ++i) S[i] = 0.f;
    float d2 = 0.f, r2 = 0.f;
    for (int t = 0; t < 512; ++t) {
        __syncthreads();
        if (tid < 128) KQ[tid] = kf[t * 128 + tid]; else if (tid < 256) KQ[tid] = qf[t * 128 + tid - 128];
        __syncthreads();
        const float al = __expf(garr[t]), be = barr[t], v = vf[t * 128 + e];
        float ks = 0.f;
#pragma unroll
        for (int i = 0; i < 32; ++i) ks = fmaf(KQ[32 * rg + i], S[i], ks);
        RED[rg * 128 + e] = ks;
        __syncthreads();
        const float kS = (RED[e] + RED[128 + e]) + (RED[256 + e] + RED[384 + e]);
        const float dv = be * (v - al * kS);
        float os = 0.f;
#pragma unroll
        for (int i = 0; i < 32; ++i) { S[i] = fmaf(KQ[32 * rg + i], dv, al * S[i]); os = fmaf(KQ[128 + 32 * rg + i], S[i], os); }
        __syncthreads();
        RED[rg * 128 + e] = os;
        __syncthreads();
        const float o = (RED[e] + RED[128 + e]) + (RED[256 + e] + RED[384 + e]);
        if (rg == 0) { const float sq = wave_sum(o * o); if ((tid & 63) == 0) OSQ[tid >> 6] = sq; }
        __syncthreads();
        if (rg == 0) { const float rstd = rsqrtf((OSQ[0] + OSQ[1]) * (1.f / 128.f) + EPS); const float zf = bf2f(ZB[(size_t)t * 512 + e]);
            const float ref = o * rstd * p.gdn_norm_g[e] * silu_f(zf); const float got = bf2f(AO[(size_t)t * 1536 + e]);
            if (t >= PROBE_T0 && t < PROBE_T1) { d2 += (got - ref) * (got - ref); r2 += ref * ref; } }
    }
    if (rg == 0) { d2 = wave_sum(d2); r2 = wave_sum(r2); if ((tid & 63) == 0) { atomicAdd((float*)(ws + WS_RES), d2); atomicAdd((float*)(ws + WS_RES) + 1, r2); } }
}
#endif

#ifdef PROBE_GDN
__device__ __forceinline__ void gdn_chunk0_reference(const Params& p, LAS unsigned char* lds) {
    unsigned char* ws = p.ws; const int tid = threadIdx.x;
    LAS float* A = (LAS float*)lds;
    LAS float* Tm = (LAS float*)(lds + 16384);
    LAS float* GCs = (LAS float*)(lds + 32768);
    const float* qf = (const float*)(ws + WS_REF); const float* kf = qf + 512 * 128; const float* vf = kf + 512 * 128;
    const float* garr = (const float*)(ws + WS_RES) + 256; const float* barr = (const float*)(ws + WS_RES) + 1024;
    if (tid == 0) { float acc = 0.f; for (int i = 0; i < 64; ++i) { acc += garr[i]; GCs[i] = acc; GCs[64 + i] = barr[i]; } }
    __syncthreads();
    for (int idx = tid; idx < 4096; idx += NTHR) { const int i = idx >> 6, j = idx & 63; float d = 0.f;
        if (j < i) { for (int e = 0; e < 128; ++e) d = fmaf(kf[i * 128 + e], kf[j * 128 + e], d); d *= GCs[64 + i] * __expf(GCs[i] - GCs[j]); }
        A[idx] = d; Tm[idx] = 0.f; }
    __syncthreads();
#if PROBE_WHAT == 8
    { const float* dmpA = (const float*)(ws + 15 * MiB + 880000); for (int idx = tid; idx < 4096; idx += NTHR) A[idx] = dmpA[idx]; }
    __syncthreads();
#endif
    if (tid < 64) { const int c = tid; for (int i = 0; i < 64; ++i) { float acc = (i == c) ? 1.f : 0.f; for (int j = 0; j < i; ++j) acc = fmaf(-A[i * 64 + j], Tm[j * 64 + c], acc); Tm[i * 64 + c] = acc; } }
    __syncthreads();
    float d2 = 0.f, r2 = 0.f;
#if PROBE_WHAT == 0
    const bf16_t* uT = (const bf16_t*)(ws + WS_VH);
    for (int idx = tid; idx < 8192; idx += NTHR) { const int i = idx >> 7, e = idx & 127; float acc = 0.f;
        for (int j = 0; j <= i; ++j) acc = fmaf(Tm[i * 64 + j] * GCs[64 + j], vf[j * 128 + e], acc);
        const float got = bf2f(uT[e * 64 + i]); d2 += (got - acc) * (got - acc); r2 += acc * acc; }
#elif PROBE_WHAT == 1
    const bf16_t* wB = (const bf16_t*)(ws + WS_WBUF);
    for (int idx = tid; idx < 8192; idx += NTHR) { const int i = idx >> 7, d = idx & 127; float acc = 0.f;
        for (int j = 0; j <= i; ++j) acc = fmaf(Tm[i * 64 + j] * GCs[64 + j] * __expf(GCs[j]), kf[j * 128 + d], acc);
        const int kb = d >> 5, u = (d & 31) >> 2, nu = 2 * (u & 3) + (u >> 2); const float got = bf2f(wB[i * 128 + 32 * kb + 4 * nu + (d & 3)]);
        d2 += (got - acc) * (got - acc); r2 += acc * acc; }
#elif PROBE_WHAT == 3
    { const float* dmp = (const float*)(ws + 15 * MiB + 880000); for (int idx = tid; idx < 4096; idx += NTHR) { const float got = dmp[idx], acc = A[idx]; d2 += (got - acc) * (got - acc); r2 += acc * acc; } }
#elif PROBE_WHAT == 4 || PROBE_WHAT == 8
    { const float* dmp = (const float*)(ws + 15 * MiB + 880000) + 4096; for (int idx = tid; idx < 4096; idx += NTHR) { const float got = dmp[idx], acc = Tm[idx]; d2 += (got - acc) * (got - acc); r2 += acc * acc; } }
#elif PROBE_WHAT >= 5 && PROBE_WHAT <= 7
    { const float* dmp = (const float*)(ws + 15 * MiB + 880000) + 4096; for (int idx = tid; idx < 4096; idx += NTHR) { const int i = idx >> 6, j = idx & 63;
        const bool in = (PROBE_WHAT == 5) ? (i < 32 && j < 32) : ((PROBE_WHAT == 6) ? (i >= 32 && j >= 32) : (i >= 32 && j < 32));
        if (in) { const float got = dmp[idx], acc = Tm[idx]; d2 += (got - acc) * (got - acc); r2 += acc * acc; } } }
#else
    const bf16_t* qB = (const bf16_t*)(ws + WS_QH);
    for (int idx = tid; idx < 8192; idx += NTHR) { const int i = idx >> 7, d = idx & 127; const float acc = qf[i * 128 + d] * __expf(GCs[i]);
        const int kb = d >> 5, u = (d & 31) >> 2, nu = 2 * (u & 3) + (u >> 2); const float got = bf2f(qB[i * 128 + 32 * kb + 4 * nu + (d & 3)]);
        d2 += (got - acc) * (got - acc); r2 += acc * acc; }
#endif
    d2 = wave_sum(d2); r2 = wave_sum(r2);
    if ((tid & 63) == 0) { atomicAdd((float*)(ws + WS_RES), d2); atomicAdd((float*)(ws + WS_RES) + 1, r2); }
}
#endif
__global__ void __launch_bounds__(NTHR, 2) hybrid_fwd(Params p) {
    extern __shared__ __attribute__((aligned(16))) unsigned char lds_raw[];
    LAS unsigned char* lds = (LAS unsigned char*)lds_raw;
    volatile LAS unsigned* MISCW = (volatile LAS unsigned*)(lds + LDS_MISC);
#define PHASE_IDS int tid = threadIdx.x; asm volatile("" : "+v"(tid)); const int lane = tid & 63, wave = __builtin_amdgcn_readfirstlane(tid >> 6); \
    const int gw = bx * NWAVES + wave, ngw = G * NWAVES; (void)lane; (void)gw; (void)ngw;
    const int G = gridDim.x, bx = blockIdx.x;
    unsigned char* ws = p.ws;
    const int tid0 = threadIdx.x;
    unsigned* ctl = (unsigned*)(ws + WS_CTL);
    if (tid0 < 16) MISCW[tid0] = 0u;
    __syncthreads();
    XcdBarrier bar = xcd_barrier_post(ctl + CW_BAR, MISCW);
#if defined(PROBE_TIME) || defined(PROBE_P8)
    unsigned long long tprev = __builtin_amdgcn_s_memrealtime(); int tk = 0;
#define TSTAMP() do { const unsigned long long tn = __builtin_amdgcn_s_memrealtime(); if (threadIdx.x == 0) { const float us = (float)(tn - tprev) * 0.01f; \
        ((volatile LAS float*)(lds + LDS_MISC))[16 + tk] = us; if (blockIdx.x == 0) ((volatile float*)ctl)[2048 + tk] = us; } tprev = tn; ++tk; } while (0)
#else
#define TSTAMP() do {} while (0)
#endif

    { PHASE_IDS p0_prologue(p, lds, gw, ngw, wave, lane); }
    xcd_barrier(bar);
    TSTAMP();
    { pg8::Gemm g{(const bf16_t*)(ws + WS_HB), (const bf16_t*)(ws + WS_WINT), MT, NIN, DM}; pg8::StaticOrder So; So.init(MT, NIN, G, bx); EpiIn E{ws};
      pg8::gemm_phase<EpiIn, pg8::StaticOrder, false>(lds, g, So, E, nullptr); }
    xcd_barrier(bar);
    TSTAMP();
    { PHASE_IDS
#ifdef PROBE_GDN
      if (bx == 0 && tid < 2) ((float*)(ws + WS_RES))[tid] = 0.f;
#endif
      LAS float* cw = (LAS float*)lds;
      for (int i = tid; i < 4 * 1536 / 4; i += NTHR) ((LAS f32x4*)cw)[i] = ((const f32x4*)p.conv_w)[i];
      __syncthreads();
      for (int m = 2 * gw; m < MT; m += 2 * ngw) {
          const int t = m & (SEQ - 1); const bf16_t* pre = (const bf16_t*)(ws + WS_QKV);
          u32x4 xr[5][3];
#pragma unroll
          for (int jj = 0; jj < 5; ++jj)
#pragma unroll
              for (int i = 0; i < 3; ++i) { xr[jj][i] = (u32x4){0u, 0u, 0u, 0u}; if (t - 3 + jj >= 0) xr[jj][i] = *(const u32x4*)(pre + (size_t)(m - 3 + jj) * 1536 + 8 * (lane + 64 * i)); }
          p3_token(p, cw, m, lane, xr[0], xr[1], xr[2], xr[3]);
          p3_token(p, cw, m + 1, lane, xr[1], xr[2], xr[3], xr[4]);
      } }
    xcd_barrier(bar);
    TSTAMP();
    { pg8::Gemm g{(const bf16_t*)(ws + WS_CQ), (const bf16_t*)(ws + WS_WQ2T), MT, 2048, 256}; pg8::StaticOrder So; So.init(MT, 2048, G, bx); EpiQ E{ws};
      pg8::gemm_phase<EpiQ, pg8::StaticOrder, false>(lds, g, So, E, nullptr); }
    __syncthreads();
    { PHASE_IDS G2In gin; if (bx < 16 * NCHUNK) g2_load(p, gin, bx, tid, lane);
      for (int cb = bx; cb < 16 * NCHUNK; cb += G) g2_chunk(p, lds, cb, cb + G, gin, tid, wave, lane); }
    xcd_barrier(bar);
    TSTAMP();
    if (bx < 16) { PHASE_IDS g3_scan(p, lds, bx, wave, lane); __syncthreads();
#ifdef PROBE_TIME
        { const unsigned long long tn = __builtin_amdgcn_s_memrealtime(); if (threadIdx.x == 0) { const float us = (float)(tn - tprev) * 0.01f; ((volatile LAS float*)(lds + LDS_MISC))[16 + 10] = us; if (blockIdx.x == 0) ((volatile float*)ctl)[2048 + 10] = us; } }
#endif
    }
#ifdef SCAN_ALONE
    xcd_barrier(bar);
#endif
    { PHASE_IDS
    dsa_tables(p, lds, tid);
    for (int qi = 0; qi < 4; ++qi) {
        const int b = (int)((bar.x + (unsigned)qi) & 3u);
        for (;;) {
            if (tid == 0) MISCW[2] = __hip_atomic_fetch_add(ctl + CW_QUEUE + 16 * b, 1u, __ATOMIC_RELAXED, __HIP_MEMORY_SCOPE_AGENT);
            __syncthreads();
            const unsigned u = MISCW[2];
            __syncthreads();
            if (u >= 512u) break;
            TabJob tj; tab_load(p, tj, (int)((unsigned)b * 512u + u) * 8 + wave, lane);
            dsa_unit(p, lds, b, 511 - (int)u, tj);
        }
    } }
    xcd_barrier(bar);
    TSTAMP();
#ifdef PROBE_GDN
#ifdef PROBE_WHAT
    if (bx == 255) { gdn_chunk0_reference(p, lds); __syncthreads(); }
#else
    if (bx == 255) { gdn_reference(p, lds); __syncthreads(); }
#endif
#endif
    {
        PHASE_IDS
        pg8::Gemm g{(const bf16_t*)(ws + WS_AOUT), (const bf16_t*)(ws + WS_WOUT2T), MT, DM, 1536}; pg8::StaticOrder So; So.init(MT, DM, G, bx);
        EpiOut E{p.x, (bf16_t*)(ws + WS_X1B), (float*)(ws + WS_CTL + CTL_RSS)};
        pg8::gemm_phase<EpiOut, pg8::StaticOrder, false>(lds, g, So, E, nullptr);
    }
    xcd_barrier(bar);
    TSTAMP();
    { pg8::Gemm g{(const bf16_t*)(ws + WS_X1B), (const bf16_t*)(ws + WS_WQST), MT, 2048, DM}; pg8::StaticOrder So; So.init(MT, 2048, G, bx);
      EpiS E{(_Float16*)(ws + WS_S), (const float*)(ws + WS_CTL + CTL_RSS)};
      pg8::gemm_phase<EpiS, pg8::StaticOrder, false>(lds, g, So, E, nullptr); }
    xcd_barrier(bar);
    TSTAMP();
    { PHASE_IDS p8_peer(p, lds, bx, wave, lane, bar); }
#ifdef PROBE_P8
    xcd_barrier(bar);
    TSTAMP();
    xcd_barrier(bar);
    { PHASE_IDS
      const float tp = ((const volatile float*)ctl)[2048 + PROBE_TA];
      const float qa = rintf(PROBE_SCALE * log2f(fmaxf(tp, 1.f)) + PROBE_SHIFT) - PROBE_BASE, qb = rintf(PROBE_SCALE * log2f(fmaxf(tp, 1.f)) + 0.5f + PROBE_SHIFT) - PROBE_BASE;
      const float sc = 1.f + 0.25f * qa;
      for (int m = gw; m < MT; m += ngw) {
          const f32x4* xr4 = (const f32x4*)(p.x + (size_t)m * 1024) + 4 * lane; f32x4* orow = (f32x4*)(p.out + (size_t)m * 1024) + 4 * lane;
          f32x4 w0 = xr4[0] * sc; if (m == 0 && lane == 0) w0[0] = 10.f * qb;
          orow[0] = w0; orow[1] = xr4[1] * sc; orow[2] = xr4[2] * sc; orow[3] = xr4[3] * sc; } }
#endif
}

extern "C" void kernel_launch(void* const* d_in, const int* in_sizes, int n_in, void* d_out, int out_size, void* d_ws, size_t ws_size, hipStream_t stream) {
    static int grid = 0;
    if (grid == 0) {
        if (n_in != 23 || in_sizes[0] != MT * DM || out_size != MT * DM || ws_size < WS_END) {
            fprintf(stderr, "kernel_launch: unexpected problem shape (n_in %d, in0 %d, out %d, ws %zu); nothing launched\n", n_in, n_in > 0 ? in_sizes[0] : -1, out_size, ws_size); grid = -1; return; }
        int dev = 0, cus = 0, per_cu = 0;
        if (hipGetDevice(&dev) != hipSuccess || hipDeviceGetAttribute(&cus, hipDeviceAttributeMultiprocessorCount, dev) != hipSuccess) { grid = -1; return; }
        if (hipFuncSetAttribute((const void*)hybrid_fwd, hipFuncAttributeMaxDynamicSharedMemorySize, LDS_BYTES) != hipSuccess) { fprintf(stderr, "kernel_launch: hipFuncSetAttribute failed\n"); grid = -1; return; }
        if (hipOccupancyMaxActiveBlocksPerMultiprocessor(&per_cu, (const void*)hybrid_fwd, NTHR, LDS_BYTES) != hipSuccess || per_cu < 1) { fprintf(stderr, "kernel_launch: occupancy query says %d\n", per_cu); }
        (void)hipGetLastError();
        grid = cus;
    }
    if (grid < 0) return;
    (void)hipMemsetAsync((char*)d_ws + WS_CTL, 0, CTL_BYTES, stream);
    Params p{};
    const float** pp = (const float**)&p;
    for (int i = 0; i < 23; ++i) pp[i] = (const float*)d_in[i];
    p.out = (float*)d_out; p.ws = (unsigned char*)d_ws;
    hipLaunchKernelGGL(hybrid_fwd, dim3(grid), dim3(NTHR), LDS_BYTES, stream, p);
}
```

```cpp
#include <hip/hip_runtime.h>
#include <cstdio>
#include <cstdint>

#define LAS __attribute__((address_space(3)))
#define CAS __attribute__((address_space(4)))
typedef unsigned short bf16_t;
typedef short bf16x8 __attribute__((ext_vector_type(8)));
typedef float f32x4 __attribute__((ext_vector_type(4)));
typedef float f32x2 __attribute__((ext_vector_type(2)));
typedef unsigned u32x4 __attribute__((ext_vector_type(4)));
typedef unsigned u32x2 __attribute__((ext_vector_type(2)));
typedef __bf16 bf16x2_t __attribute__((ext_vector_type(2)));
typedef _Float16 h2_t __attribute__((ext_vector_type(2)));
typedef unsigned u32x3a __attribute__((ext_vector_type(3), aligned(4)));
typedef unsigned u32x6 __attribute__((ext_vector_type(6)));
typedef _Float16 h32_t __attribute__((ext_vector_type(32)));

constexpr int BATCH = 4, SEQ = 8192, DM = 1024, MT = BATCH * SEQ;
constexpr int IN_W = 2648, NIN = 2816;
constexpr int NCHUNK = SEQ / 64;
constexpr float EPS = 1e-6f;
constexpr int NWAVES = 8, NTHR = 512;

constexpr size_t MiB = 1u << 20;
constexpr size_t WS_CTL = 0, CTL_BYTES = 1 * MiB;
constexpr size_t WS_WINT = 1 * MiB;
constexpr size_t WS_WQ2T = 7 * MiB;
constexpr size_t WS_WOUT2T = 8 * MiB;
constexpr size_t WS_WQST = 11 * MiB;
constexpr size_t WS_GAMMA = 15 * MiB;
constexpr size_t WS_UB = 368 * MiB;
constexpr size_t WS_VB = 384 * MiB;
constexpr size_t WS_SUV = 400 * MiB;
constexpr size_t WS_SCR = 16 * MiB;
constexpr size_t WS_HB = 80 * MiB;
constexpr size_t WS_KIDXN = 80 * MiB;
constexpr size_t WS_WIDX = 84 * MiB;
constexpr size_t WS_GARR = 86 * MiB;
constexpr size_t WS_BARR = 87 * MiB;
constexpr size_t WS_ATTN = 88 * MiB;
constexpr size_t WS_CKV8 = 104 * MiB;
constexpr size_t WS_REF = 15 * MiB + 65536;
constexpr size_t WS_RES = 15 * MiB + 32768;
constexpr size_t WS_X1B = 80 * MiB;
constexpr size_t WS_AOUT = 144 * MiB;
constexpr size_t WS_QKV = 240 * MiB;
constexpr size_t WS_QIDX = 240 * MiB;
constexpr size_t WS_WBUF = 304 * MiB;
constexpr size_t WS_ZB = 336 * MiB;
constexpr size_t WS_CQ = 368 * MiB;
constexpr size_t WS_CKV = 384 * MiB;
constexpr size_t WS_MISC = 400 * MiB;
constexpr size_t WS_QH = 416 * MiB;
constexpr size_t WS_KH = 448 * MiB;
constexpr size_t WS_VH = 480 * MiB;
constexpr size_t WS_S = 144 * MiB;
constexpr size_t WS_END = 512 * MiB;
constexpr int CW_QUEUE = 64;
constexpr int CW_BAR = 4096;
constexpr size_t CTL_RSS = 256 * 1024;

constexpr int LDS_BYTES = 160 * 1024;
constexpr int LDS_MISC = LDS_BYTES - 256;

__device__ __forceinline__ unsigned cvt_pk_bf16(float lo, float hi) { const f32x2 v = {lo, hi}; return __builtin_bit_cast(unsigned, __builtin_convertvector(v, bf16x2_t)); }
__device__ __forceinline__ float bf_lo(unsigned w) { return __uint_as_float(w << 16); }
__device__ __forceinline__ float bf_hi(unsigned w) { return __uint_as_float(w & 0xffff0000u); }
__device__ __forceinline__ float bf2f(bf16_t b) { return __uint_as_float(((unsigned)b) << 16); }
__device__ __forceinline__ bf16_t f2bf(float f) { return (bf16_t)(cvt_pk_bf16(f, 0.f) & 0xffffu); }
template <int CTRL> __device__ __forceinline__ float dpp_mov(float v) { return __builtin_bit_cast(float, __builtin_amdgcn_update_dpp(0, __builtin_bit_cast(int, v), CTRL, 0xF, 0xF, true)); }
__device__ __forceinline__ float row16_sum(float s) {
    s += dpp_mov<0xB1>(s); s += dpp_mov<0x4E>(s); s += dpp_mov<0x141>(s); s += dpp_mov<0x140>(s); return s; }
__device__ __forceinline__ float rl_f(float v, int l) { return __builtin_bit_cast(float, __builtin_amdgcn_readlane(__builtin_bit_cast(int, v), l)); }
__device__ __forceinline__ float wave_sum(float v) { v = row16_sum(v); return (rl_f(v, 0) + rl_f(v, 16)) + (rl_f(v, 32) + rl_f(v, 48)); }
__device__ __forceinline__ float silu_f(float x) { return x * __builtin_amdgcn_rcpf(1.f + __expf(-x)); }
#define LDS_WAIT() asm volatile("s_waitcnt lgkmcnt(0)" ::: "memory")
#define VM_WAIT() asm volatile("s_waitcnt vmcnt(0)" ::: "memory")
__device__ __forceinline__ bf16x8 mk8(u32x2 lo, u32x2 hi) { u32x4 t; t.x = lo.x; t.y = lo.y; t.z = hi.x; t.w = hi.y; return __builtin_bit_cast(bf16x8, t); }
__device__ __forceinline__ bf16x8 pk8(f32x4 a, f32x4 b) { u32x4 t; t.x = cvt_pk_bf16(a[0], a[1]); t.y = cvt_pk_bf16(a[2], a[3]); t.z = cvt_pk_bf16(b[0], b[1]); t.w = cvt_pk_bf16(b[2], b[3]); return __builtin_bit_cast(bf16x8, t); }
__device__ __forceinline__ bf16x8 pk8lo(f32x4 a, f32x4 b, bf16x8 hi) { const u32x4 h = __builtin_bit_cast(u32x4, hi); f32x4 ra, rb;
    ra[0] = a[0] - bf_lo(h.x); ra[1] = a[1] - bf_hi(h.x); ra[2] = a[2] - bf_lo(h.y); ra[3] = a[3] - bf_hi(h.y);
    rb[0] = b[0] - bf_lo(h.z); rb[1] = b[1] - bf_hi(h.z); rb[2] = b[2] - bf_lo(h.w); rb[3] = b[3] - bf_hi(h.w); return pk8(ra, rb); }
#define MFMA16(a, b, c) __builtin_amdgcn_mfma_f32_16x16x32_bf16((a), (b), (c), 0, 0, 0)

#define XB_TMO      128
#define XB_XCNT(j)  (256  + 64 * (j))
#define XB_XSUB(j)  (1280 + 64 * (j))
#define XB_XGEN(j)  (2304 + 64 * (j))
#define XB_TOP      3328
#define XB_TOPGEN   3392
#define XCD_BAR_WORDS 3456
#define XB_SPIN_CAP (1u << 23)
__device__ __forceinline__ unsigned xb_ld(unsigned* p)              { return __hip_atomic_load(p, __ATOMIC_RELAXED, __HIP_MEMORY_SCOPE_AGENT); }
__device__ __forceinline__ unsigned xb_add(unsigned* p, unsigned v) { return __hip_atomic_fetch_add(p, v, __ATOMIC_RELAXED, __HIP_MEMORY_SCOPE_AGENT); }
__device__ __forceinline__ unsigned xb_xcc_id() { return (unsigned)__builtin_amdgcn_s_getreg((3 << 11) | 20) & 0xFu; }
#define XB_SPIN(cond, bar) do { unsigned _sp = 0; while (cond) { __builtin_amdgcn_s_sleep(1); \
    if ((++_sp & 255u) == 0u) { if (xb_ld(&(bar)[XB_TMO])) break; if (_sp > XB_SPIN_CAP) { atomicAdd(&(bar)[XB_TMO], 1u); break; } } } } while (0)
struct XcdBarrier { unsigned* bar; unsigned x; volatile LAS unsigned* st; };
__device__ __forceinline__ XcdBarrier xcd_barrier_post(unsigned* bar, volatile LAS unsigned* st) {
    XcdBarrier b; b.bar = bar; b.x = xb_xcc_id(); b.st = st;
    if (threadIdx.x == 0) (void)xb_add(&bar[XB_XCNT(b.x)], 1u);
    return b;
}
__device__ __forceinline__ void xcd_barrier_complete(unsigned* bar, unsigned x, unsigned& nloc, unsigned& nx) {
    const unsigned G = gridDim.x * gridDim.y * gridDim.z;
    unsigned sum, cnt, mine, sp = 0u;
    for (;;) {
        sum = 0u; cnt = 0u; mine = 0u;
#pragma unroll
        for (unsigned j = 0; j < 16; ++j) { const unsigned c = xb_ld(&bar[XB_XCNT(j)]); sum += c; cnt += (c > 0u) ? 1u : 0u; mine = (j == x) ? c : mine; }
        if (sum == G) break;
        __builtin_amdgcn_s_sleep(1);
        if ((++sp & 255u) == 0u) { if (xb_ld(&bar[XB_TMO])) break; if (sp > XB_SPIN_CAP) { atomicAdd(&bar[XB_TMO], 1u); break; } }
    }
    nloc = mine > 0u ? mine : 1u; nx = cnt > 0u ? cnt : 1u;
}
__device__ __forceinline__ void xcd_barrier(const XcdBarrier& b) {
    asm volatile("s_waitcnt vmcnt(0)" ::: "memory");
    __syncthreads();
    if (threadIdx.x == 0) {
        unsigned* bar = b.bar;
        __builtin_amdgcn_s_waitcnt(0);
        unsigned nloc = b.st[0], nx = b.st[1];
        if (nloc == 0u) { xcd_barrier_complete(bar, b.x, nloc, nx); b.st[0] = nloc; b.st[1] = nx; }
        const unsigned old = xb_add(&bar[XB_XSUB(b.x)], 1u);
        const unsigned gen = old / nloc;
        if (old + 1u == (gen + 1u) * nloc) {
            __builtin_amdgcn_fence(__ATOMIC_RELEASE, "agent");
            asm volatile("s_waitcnt vmcnt(0)" ::: "memory");
            const unsigned og = xb_add(&bar[XB_TOP], 1u);
            const unsigned tg = og / nx;
            if (og + 1u == (tg + 1u) * nx) xb_add(&bar[XB_TOPGEN], 1u);
            else XB_SPIN(xb_ld(&bar[XB_TOPGEN]) == tg, bar);
            __builtin_amdgcn_fence(__ATOMIC_ACQUIRE, "agent");
            xb_add(&bar[XB_XGEN(b.x)], 1u);
            asm volatile("s_waitcnt vmcnt(0)" ::: "memory");
        } else {
            XB_SPIN(xb_ld(&bar[XB_XGEN(b.x)]) == gen, bar);
            __builtin_amdgcn_fence(__ATOMIC_ACQUIRE, "agent");
            asm volatile("s_waitcnt vmcnt(0)" ::: "memory");
        }
    }
    __syncthreads();
}

__device__ __forceinline__ void xcd_local_sync(const XcdBarrier& b, unsigned k) {
    __syncthreads();
    if (threadIdx.x == 0) {
        unsigned* c = b.bar + (8192 - 4096) + 64 * b.x;
        const unsigned nloc = b.st[0];
        (void)xb_add(c, 1u);
        const unsigned target = k * nloc;
        XB_SPIN(xb_ld(c) < target, b.bar);
    }
    __syncthreads();
}

struct Params {
    const float *x, *ln1_g, *w_in, *conv_w, *a_log, *dt_bias, *gdn_norm_g, *q_norm_g, *kv_norm_g, *w_q_up, *w_qidx_up, *w_kv_up,
                *idx_ln_g, *idx_ln_b, *w_out, *ln2_g, *peer_wq, *peer_k1, *peer_k2, *peer_u, *peer_v, *rel_bias, *final_g;
    float* out; unsigned char* ws;
};

namespace pg8 {
#define PG8_LAS __attribute__((address_space(3)))
typedef unsigned short bf16_t;
typedef short bf16x8 __attribute__((ext_vector_type(8)));
typedef float f32x4 __attribute__((ext_vector_type(4)));
typedef unsigned u32x4 __attribute__((ext_vector_type(4)));
constexpr int BM = 256, BK = 64, HALF = 128, HTB = HALF * BK * 2  , STAGE_BYTES = 8 * HTB, NXCD = 8, WGM = 8;

__host__ __device__ __forceinline__ int lds_byte(int r, int c) { const int st = (r >> 4) * 2 + (c >> 5), rr = r & 15, cc = c & 31, ob = rr * 64 + cc * 2; return st * 1024 + (ob ^ (((ob >> 9) & 1) << 5)); }
__host__ __device__ __forceinline__ void stage_rc(int b, int& R, int& C) { const int st = b / 1024, sb = b % 1024, swz = sb ^ (((sb >> 9) & 1) << 5); R = (st >> 1) * 16 + swz / 64; C = (st & 1) * 32 + (swz % 64) / 2; }
__host__ __device__ __forceinline__ int perm32(int rho) { const int n = rho >> 4, i = rho & 15; return 8 * (i >> 2) + 4 * n + (i & 3); }

struct Unit { int pm, pn; };
struct Gemm { const bf16_t* A; const bf16_t* Bt; int M, N, K; };

struct StaticOrder {
    int nM, nN, nwg, G, c;
    __host__ __device__ void init(int M, int N, int G_, int c_) { nM = M / BM; nN = N / BM; nwg = nM * nN; G = G_; c = c_; }
    __host__ __device__ bool next(int i, Unit& u) const {
        const long L = (long)i * G + c; if (L >= nwg) return false;
        int wgid = (int)L; { const int q = nwg / NXCD, r = nwg % NXCD, xcd = wgid % NXCD, off = wgid / NXCD; wgid = (xcd < r ? xcd * (q + 1) : r * (q + 1) + (xcd - r) * q) + off; }
        const int nig = WGM * nN, gid = wgid / nig, fm = gid * WGM, gsz = (nM - fm) < WGM ? (nM - fm) : WGM;
        u.pm = fm + ((wgid % nig) % gsz); u.pn = (wgid % nig) / gsz; return true;
    }
    __device__ __forceinline__ void a_ready(const Unit&) const {}
    __device__ __forceinline__ void done(const Unit&) const {}
};
template <class Epi, class Sched, bool STAMP = false>
__device__ __forceinline__ void gemm_phase(PG8_LAS unsigned char* lds, const Gemm g, const Sched& S, const Epi& E, unsigned long long* stamps) {
    int tid_o = threadIdx.x; asm volatile("" : "+v"(tid_o));
    const int tid = tid_o, wid = __builtin_amdgcn_readfirstlane(tid >> 6), lane = tid & 63, wr = wid >> 2, wc = wid & 3, fr = lane & 15, fq = lane >> 4;
    const int K = g.K, nt = K / BK;
    int ts_lo = 0, ts_hi = 0, nts = 0; const unsigned long long rt_entry = STAMP ? (unsigned long long)wall_clock64() : 0ull;
#define PG8_STAMP() do { if (STAMP && wid == 0 && nts < 64) { const unsigned long long _c = (unsigned long long)clock64(); \
        ts_lo = (lane == nts) ? (int)(unsigned)_c : ts_lo; ts_hi = (lane == nts) ? (int)(unsigned)(_c >> 32) : ts_hi; ++nts; } } while (0)
    PG8_STAMP();
    unsigned voffA[2], voffB[2];
#pragma unroll
    for (int i = 0; i < 2; ++i) { int R, C; stage_rc(tid * 16 + i * 8192, R, C); const int Rb = Epi::PERM ? ((R & ~31) + perm32(R & 31)) : R;
        voffA[i] = (unsigned)(R * K + C) * 2u; voffB[i] = (unsigned)(Rb * K + C) * 2u; }
    const size_t kstep = (size_t)(BK * 2);
    const size_t hstep = (size_t)HALF * K * 2;
    const size_t tstep = 2 * hstep;
    const unsigned ldsw = (unsigned)wid * 1024u;
    const int aoff = lds_byte(wr * 64 + fr, fq * 8), boff = lds_byte(wc * 32 + fr, fq * 8);
#define PG8_SA(b, h) (((b) * 2 + (h)) * HTB)
#define PG8_SB(b, h) ((4 + (b) * 2 + (h)) * HTB)
#define PG8_STAGE(bufoff, gbase, voff) do { _Pragma("unroll") for (int _i = 0; _i < 2; ++_i) \
        __builtin_amdgcn_global_load_lds((const unsigned*)((const char*)(gbase) + (voff)[_i]), (PG8_LAS unsigned*)(lds + (bufoff) + ldsw + _i * 8192), 16, 0, 0); } while (0)
#define PG8_LDA(dst, b, h) do { _Pragma("unroll") for (int m = 0; m < 4; ++m) _Pragma("unroll") for (int k = 0; k < 2; ++k) dst[m][k] = *(const PG8_LAS bf16x8*)(lds + PG8_SA(b, h) + aoff + m * 2048 + k * 1024); } while (0)
#define PG8_LDB(dst, b, h) do { _Pragma("unroll") for (int n = 0; n < 2; ++n) _Pragma("unroll") for (int k = 0; k < 2; ++k) dst[n][k] = *(const PG8_LAS bf16x8*)(lds + PG8_SB(b, h) + boff + n * 2048 + k * 1024); } while (0)
#define PG8_MMA(ai, bj, At, Bt) do { __builtin_amdgcn_s_setprio(1); _Pragma("unroll") for (int m = 0; m < 4; ++m) _Pragma("unroll") for (int n = 0; n < 2; ++n) _Pragma("unroll") for (int k = 0; k < 2; ++k) \
        acc[ai][bj][m][n] = __builtin_amdgcn_mfma_f32_16x16x32_bf16(Bt[n][k], At[m][k], acc[ai][bj][m][n], 0, 0, 0); __builtin_amdgcn_s_setprio(0); } while (0)
#define PG8_WAIT_V(n) asm volatile("s_waitcnt vmcnt(" #n ")" ::: "memory")
#define PG8_WAIT_L(n) asm volatile("s_waitcnt lgkmcnt(" #n ")" ::: "memory")
#define PG8_BAR __builtin_amdgcn_s_barrier()
#define PG8_SCHED __builtin_amdgcn_sched_barrier(0)
    Unit cur, nxt; int ui = 0;
    if (!S.next(0, cur)) return;
    f32x4 acc[2][2][4][2];
#pragma unroll
    for (int a = 0; a < 2; ++a)
#pragma unroll
        for (int b = 0; b < 2; ++b)
#pragma unroll
            for (int m = 0; m < 4; ++m)
#pragma unroll
                for (int n = 0; n < 2; ++n) acc[a][b][m][n] = (f32x4){0.f, 0.f, 0.f, 0.f};
    bf16x8 At[4][2], B0[2][2], B1[2][2];
    const char* cA = (const char*)g.A + (size_t)cur.pm * tstep; const char* cB = (const char*)g.Bt + (size_t)cur.pn * tstep;
    S.a_ready(cur);
    PG8_STAGE(PG8_SB(0, 0), cB, voffB); PG8_STAGE(PG8_SA(0, 0), cA, voffA); PG8_STAGE(PG8_SB(0, 1), cB + hstep, voffB); PG8_STAGE(PG8_SA(0, 1), cA + hstep, voffA);
    if (wr == 1) PG8_BAR;
    PG8_WAIT_V(4); PG8_BAR;
    PG8_STAGE(PG8_SB(1, 0), cB + kstep, voffB); PG8_STAGE(PG8_SA(1, 0), cA + kstep, voffA); PG8_STAGE(PG8_SB(1, 1), cB + hstep + kstep, voffB);
    PG8_WAIT_V(6); PG8_BAR;
    PG8_STAMP();
    for (;;) {
        const bool has_next = S.next(ui + 1, nxt);
        const char* nA = has_next ? (const char*)g.A + (size_t)nxt.pm * tstep : cA; const char* nB = has_next ? (const char*)g.Bt + (size_t)nxt.pn * tstep : cB;
        for (int t = 0; t < nt; t += 2) {
            const bool last = (t == nt - 2);
            const char* a1 = cA + (size_t)(t + 1) * kstep;
            const char* a2 = last ? nA : cA + (size_t)(t + 2) * kstep; const char* b2 = last ? nB : cB + (size_t)(t + 2) * kstep;
            const char* a3 = a2 + kstep; const char* b3 = b2 + kstep;
            if (last && has_next) S.a_ready(nxt);
            PG8_LDB(B0, 0, 0); PG8_SCHED; PG8_LDA(At, 0, 0); PG8_STAGE(PG8_SA(1, 1), a1 + hstep, voffA);
            PG8_WAIT_L(8); PG8_BAR; PG8_WAIT_L(0); PG8_MMA(0, 0, At, B0); PG8_BAR; PG8_SCHED;
            PG8_LDB(B1, 0, 1); PG8_STAGE(PG8_SB(0, 0), b2, voffB);
            PG8_BAR; PG8_WAIT_L(0); PG8_MMA(0, 1, At, B1); PG8_BAR;
            PG8_LDA(At, 0, 1); PG8_STAGE(PG8_SA(0, 0), a2, voffA);
            PG8_BAR; PG8_WAIT_L(0); PG8_MMA(1, 0, At, B0); PG8_BAR; PG8_SCHED;
            PG8_STAGE(PG8_SB(0, 1), b2 + hstep, voffB);
            PG8_WAIT_V(6); PG8_BAR; PG8_MMA(1, 1, At, B1); PG8_BAR;
            PG8_LDB(B0, 1, 0); PG8_SCHED; PG8_LDA(At, 1, 0); PG8_STAGE(PG8_SA(0, 1), a2 + hstep, voffA);
            PG8_WAIT_L(8); PG8_BAR; PG8_WAIT_L(0); PG8_MMA(0, 0, At, B0); PG8_BAR; PG8_SCHED;
            PG8_LDB(B1, 1, 1); PG8_STAGE(PG8_SB(1, 0), b3, voffB);
            PG8_BAR; PG8_WAIT_L(0); PG8_MMA(0, 1, At, B1); PG8_BAR;
            PG8_LDA(At, 1, 1); PG8_STAGE(PG8_SA(1, 0), a3, voffA);
            PG8_BAR; PG8_WAIT_L(0); PG8_MMA(1, 0, At, B0); PG8_BAR; PG8_SCHED;
            PG8_STAGE(PG8_SB(1, 1), b3 + hstep, voffB);
            PG8_WAIT_V(6); PG8_BAR; PG8_MMA(1, 1, At, B1); PG8_BAR;
        }
        PG8_STAMP();
        if constexpr (!Epi::AFTER_DRAIN) { E(acc, cur, wr, wc, fr, fq); S.done(cur); }
        PG8_STAMP();
        if (!has_next) break;
#pragma unroll
        for (int a = 0; a < 2; ++a)
#pragma unroll
            for (int b = 0; b < 2; ++b)
#pragma unroll
                for (int m = 0; m < 4; ++m)
#pragma unroll
                    for (int n = 0; n < 2; ++n) acc[a][b][m][n] = (f32x4){0.f, 0.f, 0.f, 0.f};
        cur = nxt; cA = nA; cB = nB; ++ui;
    }
    PG8_WAIT_V(0);
    if (wr == 0) PG8_BAR;
    PG8_BAR;
    if constexpr (Epi::AFTER_DRAIN) { E.fused(acc, cur, wr, wc, fr, fq, lds, wid, lane); S.done(cur); }
    PG8_STAMP();
    if (STAMP && wid == 0) { stamps[lane] = lane < nts ? (((unsigned long long)(unsigned)ts_hi << 32) | (unsigned)ts_lo) : 0ull;
        if (lane == 62) stamps[62] = rt_entry; if (lane == 63) stamps[63] = (unsigned long long)wall_clock64(); }
#undef PG8_STAMP
#undef PG8_SA
#undef PG8_SB
#undef PG8_STAGE
#undef PG8_LDA
#undef PG8_LDB
#undef PG8_MMA
#undef PG8_WAIT_V
#undef PG8_WAIT_L
#undef PG8_BAR
#undef PG8_SCHED
}
}
__device__ __forceinline__ int in_src_col(int n) {
    if (n < 2048) return n;
    if (n < 2304) return 2056 + (n - 2048);
    if (n < 2560) return 2312 + (n - 2304);
    if (n < 2624) return 2568 + (n - 2560);
    if (n < 2640) return 2632 + (n - 2624);
    if (n < 2644) return 2048 + (n - 2640);
    if (n < 2648) return 2052 + (n - 2644);
    return -1;
}
__device__ __forceinline__ void tr_item(const float* W, int ldw, int srccol, bf16_t* WT, int ldt, int n0, int k0, LAS float* scr, int lane) {
    float tv[32];
#pragma unroll
    for (int i = 0; i < 32; ++i) { const int kk = 2 * i + (lane >> 5); tv[i] = (srccol >= 0) ? W[(size_t)(k0 + kk) * ldw + srccol] : 0.f; }
#pragma unroll
    for (int i = 0; i < 32; ++i) { const int kk = 2 * i + (lane >> 5); scr[kk * 33 + (lane & 31)] = tv[i]; }
    LDS_WAIT(); asm volatile("" ::: "memory");
    const int c = lane & 7;
#pragma unroll
    for (int j = 0; j < 4; ++j) { const int n = (lane >> 3) + 8 * j; const LAS float* s = scr + (8 * c) * 33 + n;
        u32x4 o; o.x = cvt_pk_bf16(s[0 * 33], s[1 * 33]); o.y = cvt_pk_bf16(s[2 * 33], s[3 * 33]); o.z = cvt_pk_bf16(s[4 * 33], s[5 * 33]); o.w = cvt_pk_bf16(s[6 * 33], s[7 * 33]);
        *(u32x4*)(WT + (size_t)(n0 + n) * ldt + k0 + 8 * c) = o; }
    LDS_WAIT(); asm volatile("" ::: "memory");
}
__device__ __forceinline__ void fold_nt(const float* A, int lda, const float* B, int ldb, bf16_t* O, int ldo, float sc, LAS float* scr, int lane) {
#pragma unroll 1
    for (int hf = 0; hf < 2; ++hf) {
        f32x2 a[32];
        const f32x4* ap = (const f32x4*)(A + (size_t)lane * lda + 64 * hf);
#pragma unroll
        for (int i = 0; i < 16; ++i) { const f32x4 t = ap[i]; a[2 * i] = f32x2{t[0], t[1]}; a[2 * i + 1] = f32x2{t[2], t[3]}; }
#pragma unroll 1
        for (int nn = 0; nn < 16; ++nn) {
            const CAS f32x2* bp = (const CAS f32x2*)(B + (size_t)nn * ldb + 64 * hf);
            f32x2 t0 = {0.f, 0.f}, t1 = {0.f, 0.f};
#pragma unroll
            for (int d = 0; d < 32; d += 2) { t0 = __builtin_elementwise_fma(a[d], bp[d], t0); t1 = __builtin_elementwise_fma(a[d + 1], bp[d + 1], t1); }
            const float r = (t0[0] + t0[1]) + (t1[0] + t1[1]);
            if (hf == 0) scr[lane * 17 + nn] = r;
            else O[(size_t)nn * ldo + lane] = f2bf((r + scr[lane * 17 + nn]) * sc);
        }
        LDS_WAIT(); asm volatile("" ::: "memory");
    }
}
__device__ __forceinline__ void fold_vo(const float* wo, const float* wv, bf16_t* O, int ldo, LAS float* scr, int lane) {
#pragma unroll 1
    for (int hf = 0; hf < 2; ++hf) {
        f32x2 a[32];
#pragma unroll
        for (int d = 0; d < 32; ++d) a[d] = f32x2{wo[(size_t)(64 * hf + 2 * d) * 1024 + lane], wo[(size_t)(64 * hf + 2 * d + 1) * 1024 + lane]};
#pragma unroll 1
        for (int nn = 0; nn < 16; ++nn) {
            const CAS f32x2* bp = (const CAS f32x2*)(wv + (size_t)nn * 1024 + 64 * hf);
            f32x2 t0 = {0.f, 0.f}, t1 = {0.f, 0.f};
#pragma unroll
            for (int d = 0; d < 32; d += 2) { t0 = __builtin_elementwise_fma(a[d], bp[d], t0); t1 = __builtin_elementwise_fma(a[d + 1], bp[d + 1], t1); }
            const float r = (t0[0] + t0[1]) + (t1[0] + t1[1]);
            scr[lane * 17 + nn] = (hf == 0) ? r : r + scr[lane * 17 + nn];
        }
        LDS_WAIT(); asm volatile("" ::: "memory");
    }
    const LAS float* sp = scr + lane * 17;
    u32x4 o0, o1; o0.x = cvt_pk_bf16(sp[0], sp[1]); o0.y = cvt_pk_bf16(sp[2], sp[3]); o0.z = cvt_pk_bf16(sp[4], sp[5]); o0.w = cvt_pk_bf16(sp[6], sp[7]);
    o1.x = cvt_pk_bf16(sp[8], sp[9]); o1.y = cvt_pk_bf16(sp[10], sp[11]); o1.z = cvt_pk_bf16(sp[12], sp[13]); o1.w = cvt_pk_bf16(sp[14], sp[15]);
    u32x4* op = (u32x4*)(O + (size_t)lane * ldo); op[0] = o0; op[1] = o1;
    LDS_WAIT(); asm volatile("" ::: "memory");
}
__device__ __forceinline__ void p0_prologue(const Params& p, LAS unsigned char* lds, int gw, int ngw, int wave, int lane) {
    unsigned char* ws = p.ws;
    LAS float* scr = (LAS float*)(lds + wave * 8448);
    bf16_t* WINT = (bf16_t*)(ws + WS_WINT); bf16_t* WQ2T = (bf16_t*)(ws + WS_WQ2T); bf16_t* WO2T = (bf16_t*)(ws + WS_WOUT2T); bf16_t* WQST = (bf16_t*)(ws + WS_WQST);
    constexpr int I_IN = 16 * 88, I_QI = 4 * 32, I_WO = 8 * 32, F_QK = 256, F_QS = 2048, F_VO = 1024;
    constexpr int NITEMS = I_IN + I_QI + I_WO + F_QK + F_QS + F_VO;
    for (int it = gw; it < NITEMS; it += ngw) {
        int r = it;
        if (r < I_IN) { const int kb = r / 88, nb = r % 88; tr_item(p.w_in, IN_W, in_src_col(32 * nb + (lane & 31)), WINT, 1024, 32 * nb, 64 * kb, scr, lane); continue; } r -= I_IN;
        if (r < I_QI) { const int kb = r / 32, nb = r % 32; tr_item(p.w_qidx_up, 1024, 32 * nb + (lane & 31), WQ2T + (size_t)1024 * 256, 256, 32 * nb, 64 * kb, scr, lane); continue; } r -= I_QI;
        if (r < I_WO) { const int kb = r / 32, nb = r % 32; tr_item(p.w_out, 1024, 32 * nb + (lane & 31), WO2T, 1536, 32 * nb, 64 * kb, scr, lane); continue; } r -= I_WO;
        if (r < F_QK) {
            const int h = r >> 6, jt = (r >> 2) & 15, kt = r & 3;
            fold_nt(p.w_q_up + (size_t)(64 * kt) * 512 + h * 128, 512, p.w_kv_up + (size_t)(16 * jt) * 1024 + h * 256, 1024,
                    WQ2T + (size_t)(h * 256 + 16 * jt) * 256 + 64 * kt, 256, 0.08838834764831845f, scr, lane);
            continue; } r -= F_QK;
        if (r < F_QS) {
            const int hs = r >> 7, nt = (r >> 4) & 7, kt = r & 15; const int h = hs >> 1, side = hs & 1;
            const float* sk = (side ? p.peer_k2 : p.peer_k1) + (size_t)(h * 128 + 16 * nt) * 128;
            fold_nt(p.peer_wq + (size_t)(64 * kt) * 2048 + hs * 128, 2048, sk, 128, WQST + (size_t)(hs * 128 + 16 * nt) * 1024 + 64 * kt, 1024, p.ln2_g[64 * kt + lane], scr, lane);
            continue; } r -= F_QS;
        {
            const int h = r >> 8, jt = (r >> 4) & 15, nt = r & 15;
            fold_vo(p.w_out + (size_t)(512 + h * 128) * 1024 + 64 * nt, p.w_kv_up + (size_t)(16 * jt) * 1024 + h * 256 + 128, WO2T + (size_t)(64 * nt) * 1536 + 512 + h * 256 + 16 * jt, 1536, scr, lane);
        }
    }
    bf16_t* HB = (bf16_t*)(ws + WS_HB);
    {
        const f32x4* gr = (const f32x4*)p.ln1_g + lane; f32x4 gv[4];
#pragma unroll
        for (int j = 0; j < 4; ++j) gv[j] = gr[64 * j];
        for (int m4 = 4 * gw; m4 < MT; m4 += 4 * ngw) {
            f32x4 v[4][4];
#pragma unroll
            for (int r = 0; r < 4; ++r) { const f32x4* xr = (const f32x4*)(p.x + (size_t)(m4 + r) * DM) + lane;
#pragma unroll
                for (int j = 0; j < 4; ++j) v[r][j] = xr[64 * j]; }
#pragma unroll
            for (int r = 0; r < 4; ++r) { float s2 = 0.f;
#pragma unroll
                for (int j = 0; j < 4; ++j) s2 += (v[r][j][0] * v[r][j][0] + v[r][j][1] * v[r][j][1]) + (v[r][j][2] * v[r][j][2] + v[r][j][3] * v[r][j][3]);
                const float rstd = rsqrtf(wave_sum(s2) * (1.f / DM) + EPS);
                u32x2* o8 = (u32x2*)(HB + (size_t)(m4 + r) * DM) + lane;
#pragma unroll
                for (int j = 0; j < 4; ++j) { const f32x4 g4 = gv[j]; u32x2 w; w.x = cvt_pk_bf16(v[r][j][0] * rstd * g4[0], v[r][j][1] * rstd * g4[1]); w.y = cvt_pk_bf16(v[r][j][2] * rstd * g4[2], v[r][j][3] * rstd * g4[3]); o8[64 * j] = w; } }
        }
    }
}

struct EpiIn {
    static constexpr bool PERM = true, AFTER_DRAIN = false;
    unsigned char* ws;
    __device__ __forceinline__ void operator()(const f32x4 (&acc)[2][2][4][2], const pg8::Unit& u, int wr, int wc, int fr, int fq) const {
        const int row0 = u.pm * 256 + wr * 64 + fr, cl0 = wc * 32 + 8 * fq, pn = u.pn;
        if (pn < 10) {
            bf16_t* base; int ld;
            if (pn < 6) { base = (bf16_t*)(ws + WS_QKV) + pn * 256; ld = 1536; }
            else if (pn < 8) { base = (bf16_t*)(ws + WS_ZB) + (pn - 6) * 256; ld = 512; }
            else if (pn == 8) { base = (bf16_t*)(ws + WS_CQ); ld = 256; }
            else { base = (bf16_t*)(ws + WS_CKV); ld = 256; }
#pragma unroll
            for (int ai = 0; ai < 2; ++ai)
#pragma unroll
                for (int m = 0; m < 4; ++m) { bf16_t* rowp = base + (size_t)(row0 + ai * 128 + m * 16) * ld + cl0;
#pragma unroll
                    for (int bj = 0; bj < 2; ++bj)
                        { const f32x4 v0 = acc[ai][bj][m][0], v1 = acc[ai][bj][m][1]; u32x4 w; w.x = cvt_pk_bf16(v0[0], v0[1]); w.y = cvt_pk_bf16(v0[2], v0[3]); w.z = cvt_pk_bf16(v1[0], v1[1]); w.w = cvt_pk_bf16(v1[2], v1[3]); *(u32x4*)(rowp + bj * 128) = w; }
                    asm volatile("" ::: "memory"); }
        } else {
            float* base = (float*)(ws + WS_MISC);
#pragma unroll
            for (int ai = 0; ai < 2; ++ai)
#pragma unroll
                for (int m = 0; m < 4; ++m) { float* rowp = base + (size_t)(row0 + ai * 128 + m * 16) * 128 + cl0;
#pragma unroll
                    for (int n = 0; n < 2; ++n) *(f32x4*)(rowp + n * 4) = acc[ai][0][m][n]; }
        }
    }
};
struct EpiQ {
    static constexpr bool PERM = true, AFTER_DRAIN = false;
    unsigned char* ws;
    __device__ __forceinline__ void operator()(const f32x4 (&acc)[2][2][4][2], const pg8::Unit& u, int wr, int wc, int fr, int fq) const {
        const int row0 = u.pm * 256 + wr * 64 + fr, cl0 = wc * 32 + 8 * fq, pn = u.pn;
        bf16_t* base; int ld;
        if (pn < 4) { base = (bf16_t*)(ws + WS_AOUT) + 512 + pn * 256; ld = 1536; } else { base = (bf16_t*)(ws + WS_QIDX) + (pn - 4) * 256; ld = 1024; }
#pragma unroll
        for (int ai = 0; ai < 2; ++ai)
#pragma unroll
            for (int m = 0; m < 4; ++m) { bf16_t* rowp = base + (size_t)(row0 + ai * 128 + m * 16) * ld + cl0;
#pragma unroll
                for (int bj = 0; bj < 2; ++bj)
                    { const f32x4 v0 = acc[ai][bj][m][0], v1 = acc[ai][bj][m][1]; u32x4 w; w.x = cvt_pk_bf16(v0[0], v0[1]); w.y = cvt_pk_bf16(v0[2], v0[3]); w.z = cvt_pk_bf16(v1[0], v1[1]); w.w = cvt_pk_bf16(v1[2], v1[3]); *(u32x4*)(rowp + bj * 128) = w; }
                asm volatile("" ::: "memory"); }
    }
};
struct EpiOut {
    static constexpr bool PERM = true, AFTER_DRAIN = false;
    const float* x; bf16_t* x1b; float* rss;
    __device__ __forceinline__ void operator()(const f32x4 (&acc)[2][2][4][2], const pg8::Unit& u, int wr, int wc, int fr, int fq) const {
        const int row0 = u.pm * 256 + wr * 64 + fr, col0 = u.pn * 256 + wc * 32 + 8 * fq;
        f32x4 xv[8][4];
        { const size_t off = (size_t)row0 * DM + col0; xv[0][0] = *(const f32x4*)(x + off); xv[0][1] = *(const f32x4*)(x + off + 4); xv[0][2] = *(const f32x4*)(x + off + 128); xv[0][3] = *(const f32x4*)(x + off + 132); }
#pragma unroll
        for (int it = 0; it < 8; ++it) { const int ai = it >> 2, m = it & 3; const int row = row0 + ai * 128 + m * 16; const size_t off = (size_t)row * DM + col0; float ss = 0.f;
                if (it < 7) { const int nrow = row0 + ((it + 1) >> 2) * 128 + ((it + 1) & 3) * 16; const size_t noff = (size_t)nrow * DM + col0;
                    xv[it + 1][0] = *(const f32x4*)(x + noff); xv[it + 1][1] = *(const f32x4*)(x + noff + 4); xv[it + 1][2] = *(const f32x4*)(x + noff + 128); xv[it + 1][3] = *(const f32x4*)(x + noff + 132); }
#pragma unroll
                for (int bj = 0; bj < 2; ++bj) { const f32x4 v0 = acc[ai][bj][m][0] + xv[it][2 * bj], v1 = acc[ai][bj][m][1] + xv[it][2 * bj + 1];
                        u32x4 w; w.x = cvt_pk_bf16(v0[0], v0[1]); w.y = cvt_pk_bf16(v0[2], v0[3]); w.z = cvt_pk_bf16(v1[0], v1[1]); w.w = cvt_pk_bf16(v1[2], v1[3]); *(u32x4*)(x1b + off + bj * 128) = w;
                        ss += ((v0[0] * v0[0] + v0[1] * v0[1]) + (v0[2] * v0[2] + v0[3] * v0[3])) + ((v1[0] * v1[0] + v1[1] * v1[1]) + (v1[2] * v1[2] + v1[3] * v1[3])); }
                ss += __shfl_xor(ss, 16); ss += __shfl_xor(ss, 32);
                if (fq == 0) __hip_atomic_fetch_add(rss + row, ss, __ATOMIC_RELAXED, __HIP_MEMORY_SCOPE_AGENT);
                asm volatile("" ::: "memory"); }
    }
};
struct EpiS {
    static constexpr bool PERM = true, AFTER_DRAIN = false;
    _Float16* S; const float* rss;
    __device__ __forceinline__ void operator()(const f32x4 (&acc)[2][2][4][2], const pg8::Unit& u, int wr, int wc, int fr, int fq) const {
        const int row0 = u.pm * 256 + wr * 64 + fr, col0 = u.pn * 256 + wc * 32 + 8 * fq;
#pragma unroll
        for (int ai = 0; ai < 2; ++ai)
#pragma unroll
            for (int m = 0; m < 4; ++m) { const int row = row0 + ai * 128 + m * 16; const float rs = rsqrtf(rss[row] * (1.f / DM) + EPS); _Float16* rowp = S + (size_t)row * 2048 + col0;
#pragma unroll
                for (int bj = 0; bj < 2; ++bj) { const f32x4 v0 = acc[ai][bj][m][0] * rs, v1 = acc[ai][bj][m][1] * rs; u32x4 w; w.x = __builtin_bit_cast(unsigned, (h2_t){(_Float16)v0[0], (_Float16)v0[1]}); w.y = __builtin_bit_cast(unsigned, (h2_t){(_Float16)v0[2], (_Float16)v0[3]});
                    w.z = __builtin_bit_cast(unsigned, (h2_t){(_Float16)v1[0], (_Float16)v1[1]}); w.w = __builtin_bit_cast(unsigned, (h2_t){(_Float16)v1[2], (_Float16)v1[3]}); *(u32x4*)(rowp + bj * 128) = w; } }
    }
};

struct P3C { f32x4 qg, kg; float lg, lb, dtb, alog; };
struct P3In { u32x2 cq, ck; float mk, mw, ma, mb; };
__device__ __forceinline__ void p3_consts(const Params& p, P3C& c, int lane) {
    c.qg = ((const f32x4*)p.q_norm_g)[lane]; c.kg = ((const f32x4*)p.kv_norm_g)[lane]; c.lg = p.idx_ln_g[lane]; c.lb = p.idx_ln_b[lane]; c.dtb = p.dt_bias[lane & 3]; c.alog = p.a_log[lane & 3];
}
__device__ __forceinline__ void p3_load(const Params& p, P3In& in, int m, int lane) {
    unsigned char* ws = p.ws; const float* misc = (const float*)(ws + WS_MISC) + (size_t)m * 128;
    in.cq = ((const u32x2*)((const bf16_t*)(ws + WS_CQ) + (size_t)m * 256))[lane]; in.ck = ((const u32x2*)((const bf16_t*)(ws + WS_CKV) + (size_t)m * 256))[lane];
    in.mk = misc[lane]; in.mw = misc[64 + (lane & 15)]; in.ma = misc[80 + (lane & 3)]; in.mb = misc[84 + (lane & 3)];
}
__device__ __forceinline__ void p3_token(const Params& p, const LAS float* cw, const P3C& c, const P3In& in, int m, int lane, const u32x4 (&x0)[3], const u32x4 (&x1)[3], const u32x4 (&x2)[3], const u32x4 (&x3)[3]) {
    unsigned char* ws = p.ws;
    const int b = m >> 13, t = m & (SEQ - 1);
#pragma unroll
    for (int i = 0; i < 3; ++i) {
        const int piece = lane + 64 * i, hv = piece >> 4;
        float y[8];
#pragma unroll
        for (int e = 0; e < 8; ++e) y[e] = 0.f;
#pragma unroll
        for (int jj = 0; jj < 4; ++jj) { const f32x4 w0 = *(const LAS f32x4*)(cw + jj * 1536 + 8 * piece), w1 = *(const LAS f32x4*)(cw + jj * 1536 + 8 * piece + 4); const u32x4 v = (jj == 0) ? x0[i] : (jj == 1) ? x1[i] : (jj == 2) ? x2[i] : x3[i];
            y[0] = fmaf(w0[0], bf_lo(v.x), y[0]); y[1] = fmaf(w0[1], bf_hi(v.x), y[1]); y[2] = fmaf(w0[2], bf_lo(v.y), y[2]); y[3] = fmaf(w0[3], bf_hi(v.y), y[3]);
            y[4] = fmaf(w1[0], bf_lo(v.z), y[4]); y[5] = fmaf(w1[1], bf_hi(v.z), y[5]); y[6] = fmaf(w1[2], bf_lo(v.w), y[6]); y[7] = fmaf(w1[3], bf_hi(v.w), y[7]); }
        float ss = 0.f;
#pragma unroll
        for (int e = 0; e < 8; ++e) { y[e] = silu_f(y[e]); ss = fmaf(y[e], y[e], ss); }
        ss = row16_sum(ss);
        float r = 1.f;
        if (i < 2) { r = rsqrtf(ss + EPS); if (i == 0) r *= 0.08838834764831845f; }
        bf16_t* dst = (bf16_t*)(ws + (i == 0 ? WS_QH : (i == 1 ? WS_KH : WS_VH)));
        const int h = hv & 3;
        const size_t idx = ((((size_t)(b * 4 + h)) * NCHUNK + (t >> 6)) * 64 + (t & 63)) * 128 + 8 * (piece & 15);
        u32x4 o; o.x = cvt_pk_bf16(y[0] * r, y[1] * r); o.y = cvt_pk_bf16(y[2] * r, y[3] * r); o.z = cvt_pk_bf16(y[4] * r, y[5] * r); o.w = cvt_pk_bf16(y[6] * r, y[7] * r);
        *(u32x4*)(dst + idx) = o;
#ifdef PROBE_GDN
        if (b == 0 && t < 512 && (hv & 3) == 0) { float* rf = (float*)(ws + WS_REF) + ((size_t)i * 512 + t) * 128 + 8 * (piece & 15);
#pragma unroll
            for (int e = 0; e < 8; ++e) rf[e] = y[e] * r; }
#endif
    }
    if (lane < 4) {
        const float a = in.ma + p.dt_bias[lane], bb = in.mb;
        const float ea = __expf(a), ua = 1.f + ea, da = ua - 1.f;
        const float sp = (a > 20.f) ? a : (da == 0.f ? ea : __logf(ua) * ea * __builtin_amdgcn_rcpf(da));
        ((float*)(ws + WS_GARR))[(size_t)(b * 4 + lane) * SEQ + t] = -__expf(p.a_log[lane]) * sp;
        ((float*)(ws + WS_BARR))[(size_t)(b * 4 + lane) * SEQ + t] = __builtin_amdgcn_rcpf(1.f + __expf(-bb));
#ifdef PROBE_GDN
        if (b == 0 && lane == 0 && t < 512) { ((float*)(ws + WS_RES))[256 + t] = -__expf(p.a_log[0]) * sp; ((float*)(ws + WS_RES))[1024 + t] = 1.f / (1.f + __expf(-bb)); }
#endif
    }
    {
        u32x2* cq = (u32x2*)((bf16_t*)(ws + WS_CQ) + (size_t)m * 256) + lane; const u32x2 v = in.cq;
        float f0 = bf_lo(v.x), f1 = bf_hi(v.x), f2 = bf_lo(v.y), f3 = bf_hi(v.y);
        float rs = rsqrtf(wave_sum((f0 * f0 + f1 * f1) + (f2 * f2 + f3 * f3)) * (1.f / 256.f) + EPS);
        f32x4 g = ((const f32x4*)p.q_norm_g)[lane]; u32x2 w; w.x = cvt_pk_bf16(f0 * rs * g[0], f1 * rs * g[1]); w.y = cvt_pk_bf16(f2 * rs * g[2], f3 * rs * g[3]); *cq = w;
        const u32x2 v2 = in.ck;
        f0 = bf_lo(v2.x); f1 = bf_hi(v2.x); f2 = bf_lo(v2.y); f3 = bf_hi(v2.y);
        rs = rsqrtf(wave_sum((f0 * f0 + f1 * f1) + (f2 * f2 + f3 * f3)) * (1.f / 256.f) + EPS);
        g = ((const f32x4*)p.kv_norm_g)[lane];
        { int w8 = __builtin_amdgcn_cvt_pk_fp8_f32(f0 * rs * g[0], f1 * rs * g[1], 0, false); w8 = __builtin_amdgcn_cvt_pk_fp8_f32(f2 * rs * g[2], f3 * rs * g[3], w8, true); ((unsigned*)(ws + WS_CKV8))[(size_t)m * 64 + lane] = (unsigned)w8; }
    }
    {
        const float xk = in.mk; const float mu = wave_sum(xk) * (1.f / 64.f); const float d = xk - mu; const float var = wave_sum(d * d) * (1.f / 64.f);
        ((bf16_t*)(ws + WS_KIDXN))[(size_t)m * 64 + lane] = f2bf(d * rsqrtf(var + EPS) * p.idx_ln_g[lane] + p.idx_ln_b[lane]);
        if (lane < 16) ((float*)(ws + WS_WIDX))[(size_t)m * 16 + lane] = in.mw * (0.5f / 32.f);
    }
}

constexpr int G2_KL = 0, G2_QL = 17408, G2_VT = 34816, G2_KBT = 53248, G2_TL = 71680, G2_AM = 80896, G2_GC = 97280, G2_VT2 = 98304, G2_KBT2 = 116736, G2_TL2 = 135168, G2_TF = 144384;
__device__ __forceinline__ float bf_elem(const u32x4& v, int e) { const unsigned w = v[e >> 1]; return (e & 1) ? bf_hi(w) : bf_lo(w); }
struct G2In { u32x4 k[2], q[2], v[2]; float g, b; };
__device__ __forceinline__ void g2_load(const Params& p, G2In& in, int cb, int tid, int lane) {
    unsigned char* ws = p.ws;
    const u32x4* qB = (const u32x4*)((const bf16_t*)(ws + WS_QH) + (size_t)cb * 8192); const u32x4* kB = (const u32x4*)((const bf16_t*)(ws + WS_KH) + (size_t)cb * 8192); const u32x4* vB = (const u32x4*)((const bf16_t*)(ws + WS_VH) + (size_t)cb * 8192);
    const int bh = cb >> 7, c = cb & 127;
#pragma unroll
    for (int i = 0; i < 2; ++i) { const int piece = tid + 512 * i; in.k[i] = kB[piece]; in.q[i] = qB[piece]; in.v[i] = vB[piece]; }
    in.g = ((const float*)(ws + WS_GARR))[(size_t)bh * SEQ + c * 64 + lane]; in.b = ((const float*)(ws + WS_BARR))[(size_t)bh * SEQ + c * 64 + lane];
}
__device__ __forceinline__ void g2_chunk(const Params& p, LAS unsigned char* lds, int cb, int cb_next, G2In& in, int tid_in, int wave, int lane_in) {
    unsigned char* ws = p.ws;
    int tid = tid_in; asm volatile("" : "+v"(tid));
    const int lane = tid & 63; (void)lane_in;
    bf16_t* qB = (bf16_t*)(ws + WS_QH) + (size_t)cb * 8192; bf16_t* kB = (bf16_t*)(ws + WS_KH) + (size_t)cb * 8192; bf16_t* vB = (bf16_t*)(ws + WS_VH) + (size_t)cb * 8192;
    bf16_t* wB = (bf16_t*)(ws + WS_WBUF) + (size_t)cb * 8192; bf16_t* aB = (bf16_t*)(ws + WS_ATTN) + (size_t)cb * 4096;
    const int bh = cb >> 7, c = cb & 127;
    const float* gsrc = (const float*)(ws + WS_GARR) + (size_t)bh * SEQ + c * 64; const float* bsrc = (const float*)(ws + WS_BARR) + (size_t)bh * SEQ + c * 64;
    LAS bf16_t* KL = (LAS bf16_t*)(lds + G2_KL); LAS bf16_t* QL = (LAS bf16_t*)(lds + G2_QL); LAS bf16_t* VT = (LAS bf16_t*)(lds + G2_VT);
    LAS bf16_t* KBT = (LAS bf16_t*)(lds + G2_KBT); LAS bf16_t* TL = (LAS bf16_t*)(lds + G2_TL); LAS float* AM = (LAS float*)(lds + G2_AM);
    LAS float* GC = (LAS float*)(lds + G2_GC); LAS float* BT = GC + 64;
    const int g = lane >> 4, fr = lane & 15;
#ifdef PROBE_NAN
    unsigned pbad = 0u;
#define PCHK(idx, v) do { if (!(fabsf(v) < 1e30f)) pbad |= 1u << ((idx) - 30); } while (0)
#else
#define PCHK(idx, v) do {} while (0)
#endif
    u32x4 kp[2], qp[2], vp[2];
#pragma unroll
    for (int i = 0; i < 2; ++i) { kp[i] = in.k[i]; qp[i] = in.q[i]; vp[i] = in.v[i]; }
    if (wave == 0) {
        float gv = in.g;
#pragma unroll
        for (int o = 1; o < 64; o <<= 1) { const float t = __shfl_up(gv, o); if (lane >= o) gv += t; }
        GC[lane] = gv; BT[lane] = in.b;
    }
    __syncthreads();
#pragma unroll
    for (int i = 0; i < 2; ++i) { const int piece = tid + 512 * i, row = piece >> 4, ch = piece & 15;
        *(LAS u32x4*)(KL + row * 136 + ch * 8) = kp[i]; *(LAS u32x4*)(QL + row * 136 + ch * 8) = qp[i];
        const float bj = BT[row], be = bj * __expf(GC[row]);
#pragma unroll
        for (int e = 0; e < 8; ++e) { const float vv = bf_elem(vp[i], e) * bj, kk = bf_elem(kp[i], e) * be; const bf16_t vh = f2bf(vv), kh = f2bf(kk);
            VT[(ch * 8 + e) * 72 + row] = vh; KBT[(ch * 8 + e) * 72 + row] = kh; } }
    __syncthreads();
#pragma unroll
    for (int tt = 0; tt < 2; ++tt) { const int idx = wave + 8 * tt, ti = idx >> 2, tj = idx & 3;
        f32x4 accA = {0.f, 0.f, 0.f, 0.f}, accT = {0.f, 0.f, 0.f, 0.f};
        if (tj <= ti) {
#pragma unroll
            for (int s = 0; s < 4; ++s) { const bf16x8 ki = *(const LAS bf16x8*)(KL + (16 * ti + fr) * 136 + 32 * s + 8 * g), kj = *(const LAS bf16x8*)(KL + (16 * tj + fr) * 136 + 32 * s + 8 * g),
                                                       qi = *(const LAS bf16x8*)(QL + (16 * ti + fr) * 136 + 32 * s + 8 * g);
                accA = MFMA16(ki, kj, accA);
                accT = MFMA16(kj, qi, accT); }
        }
#pragma unroll
        for (int reg = 0; reg < 4; ++reg) { const int i = 16 * ti + 4 * g + reg, j = 16 * tj + fr;
            const float amv = (j < i) ? BT[i] * accA[reg] * __expf(GC[i] - GC[j]) : 0.f; AM[i * 64 + j] = amv; }
        { const int i = 16 * ti + fr; float v[4];
#pragma unroll
            for (int reg = 0; reg < 4; ++reg) { const int j = 16 * tj + 4 * g + reg; v[reg] = (j <= i) ? accT[reg] * __expf(GC[i] - GC[j]) : 0.f; }
            u32x2 w; w.x = cvt_pk_bf16(v[0], v[1]); w.y = cvt_pk_bf16(v[2], v[3]); *(u32x2*)(aB + i * 64 + 32 * (tj >> 1) + 8 * g + 4 * (tj & 1)) = w; }
    }
#pragma unroll
    for (int q = 0; q < 8; ++q) ((LAS float*)(lds + G2_TF))[tid + 512 * q] = 0.f;
    __syncthreads();
    LAS float* TF = (LAS float*)(lds + G2_TF); LAS float* XB = (LAS float*)(lds + G2_QL);
    if (wave == 0) {
        const int o = 16 * (lane >> 4), c = lane & 15;
        for (int i = 0; i < 16; ++i) { float acc = (i == c) ? 1.f : 0.f;
            for (int j = 0; j < i; ++j) acc = fmaf(-AM[(o + i) * 64 + o + j], TF[(o + j) * 64 + o + c], acc);
            TF[(o + i) * 64 + o + c] = acc; }
    } else {
        const int t2 = tid - 64; const float gl = GC[63];
        for (int piece = t2; piece < 1024; piece += 448) { const int row = piece >> 4, ch = piece & 15; const u32x4 v = *(const LAS u32x4*)(QL + row * 136 + ch * 8); const float e = __expf(GC[row]);
            u32x4 o; o.x = cvt_pk_bf16(bf_lo(v.x) * e, bf_hi(v.x) * e); o.y = cvt_pk_bf16(bf_lo(v.y) * e, bf_hi(v.y) * e); o.z = cvt_pk_bf16(bf_lo(v.z) * e, bf_hi(v.z) * e); o.w = cvt_pk_bf16(bf_lo(v.w) * e, bf_hi(v.w) * e);
            { const int kb = ch >> 2, u0 = 2 * (ch & 3), u1 = u0 + 1; bf16_t* rp = qB + row * 128 + 32 * kb;
              u32x2 lo2; lo2.x = o.x; lo2.y = o.y; u32x2 hi2; hi2.x = o.z; hi2.y = o.w;
              *(u32x2*)(rp + 4 * (2 * (u0 & 3) + (u0 >> 2))) = lo2; *(u32x2*)(rp + 4 * (2 * (u1 & 3) + (u1 >> 2))) = hi2; } }
        for (int piece = t2; piece < 1024; piece += 448) { const int d = piece >> 3, jc = piece & 7; float v[8];
#pragma unroll
            for (int e = 0; e < 8; ++e) { const int j = 8 * jc + e; v[e] = bf2f(KL[j * 136 + d]) * __expf(gl - GC[j]); }
            u32x4 o; o.x = cvt_pk_bf16(v[0], v[1]); o.y = cvt_pk_bf16(v[2], v[3]); o.z = cvt_pk_bf16(v[4], v[5]); o.w = cvt_pk_bf16(v[6], v[7]);
            { const int kb = jc >> 2, u0 = 2 * (jc & 3), u1 = u0 + 1; bf16_t* rp = kB + d * 64 + 32 * kb;
              u32x2 lo2; lo2.x = o.x; lo2.y = o.y; u32x2 hi2; hi2.x = o.z; hi2.y = o.w;
              *(u32x2*)(rp + 4 * (2 * (u0 & 3) + (u0 >> 2))) = lo2; *(u32x2*)(rp + 4 * (2 * (u1 & 3) + (u1 >> 2))) = hi2; } }
        if (t2 == 0) ((float*)(ws + WS_GAMMA))[cb] = __expf(gl);
    }
    __syncthreads();
    {
        const int pr = tid >> 8, r = (tid >> 4) & 15, c = tid & 15, o = 32 * pr; float x = 0.f;
#pragma unroll 4
        for (int k = 0; k < 16; ++k) x = fmaf(AM[(o + 16 + r) * 64 + o + k], TF[(o + k) * 64 + o + c], x);
        XB[tid] = x;
    }
    __syncthreads();
    {
        const int pr = tid >> 8, r = (tid >> 4) & 15, c = tid & 15, o = 32 * pr; float y = 0.f;
#pragma unroll 4
        for (int k = 0; k < 16; ++k) y = fmaf(TF[(o + 16 + r) * 64 + o + 16 + k], XB[pr * 256 + k * 16 + c], y);
        TF[(o + 16 + r) * 64 + o + c] = -y;
    }
    __syncthreads();
    {
        const int r = tid >> 4, c0 = (tid & 15) * 2; float x0 = 0.f, x1 = 0.f;
#pragma unroll 8
        for (int k = 0; k < 32; ++k) { const float a = AM[(32 + r) * 64 + k]; const f32x2 t = *(const LAS f32x2*)(TF + k * 64 + c0); x0 = fmaf(a, t[0], x0); x1 = fmaf(a, t[1], x1); }
        *(LAS f32x2*)(XB + r * 32 + c0) = (f32x2){x0, x1};
    }
    __syncthreads();
    {
        const int r = tid >> 4, c0 = (tid & 15) * 2; float x0 = 0.f, x1 = 0.f;
#pragma unroll 8
        for (int k = 0; k < 32; ++k) { const float a = TF[(32 + r) * 64 + 32 + k]; const f32x2 t = *(const LAS f32x2*)(XB + k * 32 + c0); x0 = fmaf(a, t[0], x0); x1 = fmaf(a, t[1], x1); }
        *(LAS f32x2*)(TF + (32 + r) * 64 + c0) = (f32x2){-x0, -x1};
    }
    __syncthreads();
#ifdef PROBE_GDN
    if (cb == 0) { float* dmp = (float*)(ws + 15 * MiB + 880000);
#pragma unroll 1
        for (int idx = tid; idx < 4096; idx += NTHR) { dmp[idx] = AM[idx]; dmp[4096 + idx] = TF[idx]; } }
#endif
#pragma unroll
    for (int q = 0; q < 8; ++q) { const int idx = tid + 512 * q, i = idx >> 6, j = idx & 63; TL[i * 72 + j] = f2bf(TF[idx]); }
    __syncthreads();
    if (cb_next < 16 * NCHUNK) g2_load(p, in, cb_next, tid, lane);
#pragma unroll
    for (int tt = 0; tt < 4; ++tt) { const int t = wave * 4 + tt, ti = t >> 3, te = t & 7; f32x4 acc = {0.f, 0.f, 0.f, 0.f};
#pragma unroll
        for (int s = 0; s < 2; ++s) { const int oa = (16 * ti + fr) * 72 + 32 * s + 8 * g, ob = (16 * te + fr) * 72 + 32 * s + 8 * g;
            const bf16x8 fa = *(const LAS bf16x8*)(TL + oa), fb = *(const LAS bf16x8*)(VT + ob);
            acc = MFMA16(fa, fb, acc); }
        u32x2 w; w.x = cvt_pk_bf16(acc[0], acc[1]); w.y = cvt_pk_bf16(acc[2], acc[3]); *(u32x2*)(vB + (16 * te + fr) * 64 + 16 * ti + 4 * g) = w; }
#pragma unroll
    for (int tt = 0; tt < 4; ++tt) { const int t = wave * 4 + tt, td = t >> 2, ti = t & 3; f32x4 acc = {0.f, 0.f, 0.f, 0.f};
#pragma unroll
        for (int s = 0; s < 2; ++s) { const int oa = (16 * td + fr) * 72 + 32 * s + 8 * g, ob = (16 * ti + fr) * 72 + 32 * s + 8 * g;
            const bf16x8 fa = *(const LAS bf16x8*)(KBT + oa), fb = *(const LAS bf16x8*)(TL + ob);
            acc = MFMA16(fa, fb, acc); }
        u32x2 w; w.x = cvt_pk_bf16(acc[0], acc[1]); w.y = cvt_pk_bf16(acc[2], acc[3]); *(u32x2*)(wB + (16 * ti + fr) * 128 + 32 * (td >> 1) + 8 * g + 4 * (td & 1)) = w; }
#ifdef PROBE_NAN
    if (pbad) { unsigned* pfl = (unsigned*)(ws + WS_CTL) + 1024; for (int k = 0; k < 7; ++k) if (pbad & (1u << k)) atomicOr(pfl + 30 + k, 1u); }
#endif
    __syncthreads();
}

constexpr int G3_W = 0, G3_Q = 16384, G3_KT = 32768, G3_AT = 49152, G3_BUF = 57344, G3_OB = 2 * G3_BUF, G3_OBS = 132;
static_assert(G3_OB + 64 * G3_OBS * 4 <= LDS_MISC, "scan LDS map");
__device__ __forceinline__ unsigned g3_off256(unsigned r, unsigned c) { return r * 256u + ((c ^ (r & 15u)) << 4); }
__device__ __forceinline__ unsigned g3_off128(unsigned r, unsigned c) { return r * 128u + ((c ^ ((r >> 1) & 7u)) << 4); }
__device__ __forceinline__ void g3_scan(const Params& p, LAS unsigned char* lds, int bh, int wave, int lane) {
    unsigned char* ws = p.ws;
    const int b = bh >> 2, h = bh & 3, e0 = 16 * wave;
    LAS float* OB = (LAS float*)(lds + G3_OB);
    f32x4 S[8];
#pragma unroll
    for (int i = 0; i < 8; ++i) S[i] = (f32x4){0.f, 0.f, 0.f, 0.f};
    const bf16_t* ZB = (const bf16_t*)(ws + WS_ZB); bf16_t* AO = (bf16_t*)(ws + WS_AOUT);
    const int tid = wave * 64 + lane;
    {
        const size_t cb = (size_t)bh * NCHUNK;
        const u32x4* s0 = (const u32x4*)((const bf16_t*)(ws + WS_WBUF) + cb * 8192); const u32x4* s1 = (const u32x4*)((const bf16_t*)(ws + WS_QH) + cb * 8192);
        const u32x4* s2 = (const u32x4*)((const bf16_t*)(ws + WS_KH) + cb * 8192); const u32x4* s4 = (const u32x4*)((const bf16_t*)(ws + WS_ATTN) + cb * 4096);
#pragma unroll
        for (int i = 0; i < 2; ++i) { const unsigned pp = tid + 512 * i;
            *(LAS u32x4*)(lds + G3_W + g3_off256(pp >> 4, pp & 15u)) = s0[pp]; *(LAS u32x4*)(lds + G3_Q + g3_off256(pp >> 4, pp & 15u)) = s1[pp]; *(LAS u32x4*)(lds + G3_KT + g3_off128(pp >> 3, pp & 7u)) = s2[pp]; }
        *(LAS u32x4*)(lds + G3_AT + g3_off128((unsigned)tid >> 3, (unsigned)tid & 7u)) = s4[tid];
    }
    __syncthreads();
#pragma unroll 1
    for (int c = 0; c < NCHUNK; ++c) {
        int lane_o = threadIdx.x & 63; asm volatile("" : "+v"(lane_o));
        const unsigned g = (unsigned)lane_o >> 4, fr = (unsigned)lane_o & 15u;
        const unsigned tid2 = wave * 64 + lane_o;
        const size_t cb = (size_t)bh * NCHUNK + c;
        LAS unsigned char* buf = lds + (c & 1) * G3_BUF; LAS unsigned char* nbuf = lds + ((c + 1) & 1) * G3_BUF;
        const float gam = ((const float*)(ws + WS_GAMMA))[cb];
        u32x4 zp[2]; u32x2 uu[4];
        {
            const size_t nb = (c + 1 < NCHUNK) ? cb + 1 : cb;
            const u32x4* s0 = (const u32x4*)((const bf16_t*)(ws + WS_WBUF) + nb * 8192); const u32x4* s1 = (const u32x4*)((const bf16_t*)(ws + WS_QH) + nb * 8192);
            const u32x4* s2 = (const u32x4*)((const bf16_t*)(ws + WS_KH) + nb * 8192); const u32x4* s4 = (const u32x4*)((const bf16_t*)(ws + WS_ATTN) + nb * 4096);
#pragma unroll
            for (int i = 0; i < 2; ++i) { const unsigned sl = tid2 + 512u * i, r = sl >> 4, cs = (sl & 15u) ^ (r & 15u); const unsigned wb = (unsigned)(wave * 64 + 512 * i) * 16u;
                __builtin_amdgcn_global_load_lds((const unsigned*)(s0 + r * 16u + cs), (LAS unsigned*)(nbuf + G3_W + wb), 16, 0, 0);
                __builtin_amdgcn_global_load_lds((const unsigned*)(s1 + r * 16u + cs), (LAS unsigned*)(nbuf + G3_Q + wb), 16, 0, 0);
                const unsigned r8 = sl >> 3, c8s = (sl & 7u) ^ ((r8 >> 1) & 7u);
                __builtin_amdgcn_global_load_lds((const unsigned*)(s2 + r8 * 8u + c8s), (LAS unsigned*)(nbuf + G3_KT + wb), 16, 0, 0); }
            { const unsigned r8 = tid2 >> 3, c8s = (tid2 & 7u) ^ ((r8 >> 1) & 7u);
                __builtin_amdgcn_global_load_lds((const unsigned*)(s4 + r8 * 8u + c8s), (LAS unsigned*)(nbuf + G3_AT + (unsigned)(wave * 64) * 16u), 16, 0, 0); }
            const bf16_t* uT = (const bf16_t*)(ws + WS_VH) + cb * 8192;
#pragma unroll
            for (int mt = 0; mt < 4; ++mt) uu[mt] = *(const u32x2*)(uT + (e0 + fr) * 64 + 16 * mt + 4 * g);
#pragma unroll
            for (int q = 0; q < 2; ++q) { const unsigned pp = tid2 + 512u * q; const size_t m = (size_t)b * SEQ + c * 64 + (pp >> 4); zp[q] = *(const u32x4*)(ZB + m * 512 + h * 128 + 8 * (pp & 15u)); }
        }
        bf16x8 Sb[4];
#pragma unroll
        for (int kb = 0; kb < 4; ++kb) Sb[kb] = pk8(S[2 * kb], S[2 * kb + 1]);
        f32x4 vn[4], ot[4];
#define G3_FRAG256(base, R, kb) (*(const LAS bf16x8*)(buf + (base) + g3_off256((R), 4 * (kb) + g)))
#define G3_FRAG128(base, R, k2) (*(const LAS bf16x8*)(buf + (base) + g3_off128((R), 4 * (k2) + g)))
        {
#pragma unroll
            for (int hf = 0; hf < 2; ++hf) {
                bf16x8 af[8];
#pragma unroll
                for (int m2 = 0; m2 < 2; ++m2)
#pragma unroll
                    for (int kb = 0; kb < 4; ++kb) af[4 * m2 + kb] = G3_FRAG256(G3_W, 16 * (2 * hf + m2) + fr, kb);
                asm volatile("" ::: "memory");
#pragma unroll
                for (int m2 = 0; m2 < 2; ++m2) { const int mt = 2 * hf + m2; f32x4 acc = {0.f, 0.f, 0.f, 0.f};
#pragma unroll
                    for (int kb = 0; kb < 4; ++kb) acc = MFMA16(af[4 * m2 + kb], Sb[kb], acc);
                    vn[mt] = (f32x4){bf_lo(uu[mt].x) - acc[0], bf_hi(uu[mt].x) - acc[1], bf_lo(uu[mt].y) - acc[2], bf_hi(uu[mt].y) - acc[3]}; }
            }
        }
        bf16x8 vb[2]; vb[0] = pk8(vn[0], vn[1]); vb[1] = pk8(vn[2], vn[3]);
        {
#pragma unroll
            for (int mt = 0; mt < 4; ++mt) {
                bf16x8 af[6];
#pragma unroll
                for (int kb = 0; kb < 4; ++kb) af[kb] = G3_FRAG256(G3_Q, 16 * mt + fr, kb);
#pragma unroll
                for (int k2 = 0; k2 < 2; ++k2) af[4 + k2] = G3_FRAG128(G3_AT, 16 * mt + fr, k2);
                asm volatile("" ::: "memory");
                f32x4 acc = {0.f, 0.f, 0.f, 0.f};
#pragma unroll
                for (int kb = 0; kb < 4; ++kb) acc = MFMA16(af[kb], Sb[kb], acc);
#pragma unroll
                for (int k2 = 0; k2 < 2; ++k2) acc = MFMA16(af[4 + k2], vb[k2], acc);
                ot[mt] = acc; }
        }
        {
#pragma unroll
            for (int hf = 0; hf < 4; ++hf) {
                bf16x8 af[4];
#pragma unroll
                for (int r2 = 0; r2 < 2; ++r2)
#pragma unroll
                    for (int k2 = 0; k2 < 2; ++k2) af[2 * r2 + k2] = G3_FRAG128(G3_KT, 16 * (2 * hf + r2) + fr, k2);
                asm volatile("" ::: "memory");
#pragma unroll
                for (int r2 = 0; r2 < 2; ++r2) { const int rt = 2 * hf + r2; f32x4 acc = S[rt] * gam;
#pragma unroll
                    for (int k2 = 0; k2 < 2; ++k2) acc = MFMA16(af[2 * r2 + k2], vb[k2], acc);
                    S[rt] = acc; }
            }
        }
#undef G3_FRAG256
#undef G3_FRAG128
        __syncthreads();
#pragma unroll
        for (int mt = 0; mt < 4; ++mt)
#pragma unroll
            for (int reg = 0; reg < 4; ++reg) OB[(16 * mt + 4 * g + reg) * G3_OBS + e0 + fr] = ot[mt][reg];
        asm volatile("s_waitcnt vmcnt(0)" ::: "memory");
        __syncthreads();
#pragma unroll
        for (int q = 0; q < 2; ++q) { const unsigned pp = tid2 + 512u * q, i = pp >> 4, c8 = pp & 15u;
            const f32x4 o0 = *(const LAS f32x4*)(OB + i * G3_OBS + 8 * c8), o1 = *(const LAS f32x4*)(OB + i * G3_OBS + 8 * c8 + 4);
            const float tot = row16_sum((o0[0] * o0[0] + o0[1] * o0[1]) + (o0[2] * o0[2] + o0[3] * o0[3]) + (o1[0] * o1[0] + o1[1] * o1[1]) + (o1[2] * o1[2] + o1[3] * o1[3]));
            const float rstd = rsqrtf(tot * (1.f / 128.f) + EPS);
            const u32x4 z = zp[q]; f32x4 gnv[2]; { const f32x4* gp4 = (const f32x4*)(p.gdn_norm_g + 8 * c8); gnv[0] = gp4[0]; gnv[1] = gp4[1]; }
            float r[8];
            r[0] = o0[0] * rstd * gnv[0][0] * silu_f(bf_lo(z.x)); r[1] = o0[1] * rstd * gnv[0][1] * silu_f(bf_hi(z.x)); r[2] = o0[2] * rstd * gnv[0][2] * silu_f(bf_lo(z.y)); r[3] = o0[3] * rstd * gnv[0][3] * silu_f(bf_hi(z.y));
            r[4] = o1[0] * rstd * gnv[1][0] * silu_f(bf_lo(z.z)); r[5] = o1[1] * rstd * gnv[1][1] * silu_f(bf_hi(z.z)); r[6] = o1[2] * rstd * gnv[1][2] * silu_f(bf_lo(z.w)); r[7] = o1[3] * rstd * gnv[1][3] * silu_f(bf_hi(z.w));
#ifdef ZERO_GDN
#pragma unroll
            for (int e = 0; e < 8; ++e) r[e] = 0.f;
#elif defined(DOUBLE_GDN)
#pragma unroll
            for (int e = 0; e < 8; ++e) r[e] *= 2.f;
#endif
            u32x4 w; w.x = cvt_pk_bf16(r[0], r[1]); w.y = cvt_pk_bf16(r[2], r[3]); w.z = cvt_pk_bf16(r[4], r[5]); w.w = cvt_pk_bf16(r[6], r[7]);
            const size_t m = (size_t)b * SEQ + c * 64 + i;
            *(u32x4*)(AO + m * 1536 + h * 128 + 8 * c8) = w; }
    }
}

constexpr int DL_QS = 0;
constexpr int DL_IMG = 0;
constexpr int DL_SEL = 131072;
constexpr int DL_HIST = 139264;
constexpr int DL_WQ = 147456;
constexpr int DL_BKT = 148480;
constexpr int DL_RB = 156672;
static_assert(DL_RB + 512 <= LDS_MISC, "DSA LDS map");

__device__ __forceinline__ unsigned img_off(unsigned row, unsigned ch) { return 256u * row + 16u * (ch ^ (((row & 3u) << 2) | ((row >> 2) & 3u))); }
__device__ __forceinline__ unsigned key16(unsigned u) { return (u & 0x8000u) ? (~u & 0xffffu) : (u | 0x8000u); }
__device__ __forceinline__ void radix_find(const LAS unsigned* hist, unsigned need, int lane, unsigned& bsel, unsigned& above) {
    const u32x4 hv = *(const LAS u32x4*)(hist + 4 * lane);
    const unsigned s4 = hv.x + hv.y + hv.z + hv.w;
    unsigned incl = s4;
#pragma unroll
    for (int o = 1; o < 64; o <<= 1) { const unsigned t = __shfl_down(incl, o); if (lane + o < 64) incl += t; }
    const unsigned excl = incl - s4;
    const bool hit = (excl < need) && (incl >= need);
    const unsigned c3 = excl + hv.w, c2 = c3 + hv.z, c1 = c2 + hv.y;
    unsigned bb, ab;
    if (c3 >= need) { bb = 3; ab = excl; } else if (c2 >= need) { bb = 2; ab = c3; } else if (c1 >= need) { bb = 1; ab = c2; } else { bb = 0; ab = c1; }
    const unsigned long long mask = __ballot(hit);
    const int src = mask ? (__ffsll((long long)mask) - 1) : 0;
    bsel = __shfl(4u * lane + bb, src); above = __shfl(ab, src);
}
__device__ __forceinline__ void dsa_tables(const Params& p, LAS unsigned char* lds, int tid) {
    LAS unsigned char* BK = lds + DL_BKT; LAS float* RB = (LAS float*)(lds + DL_RB);
    for (int d = tid; d < SEQ; d += NTHR) { int bk = d;
        if (d >= 16) { bk = 16 + (d >= 21) + (d >= 27) + (d >= 35) + (d >= 46) + (d >= 59) + (d >= 77) + (d >= 99) + (d >= 128) + (d >= 166) + (d >= 216) + (d >= 280) + (d >= 363) + (d >= 470) + (d >= 609) + (d >= 790); }
        BK[d] = (unsigned char)bk; }
    if (tid < 128) RB[tid] = p.rel_bias[tid];
    __syncthreads();
}
struct TabJob { f32x4 a[4], b[4], g[4]; int pair; };
__device__ __forceinline__ void tab_load(const Params& p, TabJob& tj, int pair, int lane) {
    tj.pair = pair; const int tb = pair >> 13, r0 = (pair & 8191) * 2;
    const float* src = (tb ? p.peer_v : p.peer_u) + (size_t)r0 * 1024 + 16 * lane;
#pragma unroll
    for (int q = 0; q < 4; ++q) { tj.a[q] = ((const f32x4*)src)[q]; tj.b[q] = ((const f32x4*)(src + 1024))[q]; tj.g[q] = ((const f32x4*)p.ln2_g)[4 * lane + q]; }
}
__device__ __forceinline__ void tab_finish(unsigned char* ws, const TabJob& tj, int lane) {
    const int tb = tj.pair >> 13, r0 = (tj.pair & 8191) * 2;
    float va[16], vb[16];
#pragma unroll
    for (int q = 0; q < 4; ++q)
#pragma unroll
        for (int e = 0; e < 4; ++e) { const float gq = tb ? 1.f : tj.g[q][e]; va[4 * q + e] = tj.a[q][e] * gq; vb[4 * q + e] = tj.b[q][e] * gq; }
    float ma = 0.f, mb = 0.f;
#pragma unroll
    for (int e = 0; e < 16; ++e) { ma = fmaxf(ma, __builtin_fabsf(va[e])); mb = fmaxf(mb, __builtin_fabsf(vb[e])); }
#pragma unroll
    for (int o = 32; o >= 1; o >>= 1) { ma = fmaxf(ma, __shfl_xor(ma, o)); mb = fmaxf(mb, __shfl_xor(mb, o)); }
    ma = fmaxf(ma, 1e-30f); mb = fmaxf(mb, 1e-30f);
    const float ia = 7.5f / ma, ib = 7.5f / mb;
    h32_t hv;
#pragma unroll
    for (int e = 0; e < 16; ++e) { hv[e] = (_Float16)(va[e] * ia); hv[16 + e] = (_Float16)(vb[e] * ib); }
    const u32x6 enc = __builtin_amdgcn_cvt_scalef32_pk32_fp6_f16(hv, 1.0f);
    unsigned char* dst = ws + (tb ? WS_VB : WS_UB) + (size_t)r0 * 768 + lane * 12;
    *(u32x3a*)dst = (u32x3a){enc[0], enc[1], enc[2]}; *(u32x3a*)(dst + 768) = (u32x3a){enc[3], enc[4], enc[5]};
    if (lane == 0) { float* SUVp = (float*)(ws + WS_SUV); SUVp[tb * 16384 + r0] = ma * (1.f / 7.5f); SUVp[tb * 16384 + r0 + 1] = mb * (1.f / 7.5f); }
}
__device__ __forceinline__ void dsa_unit(const Params& p, LAS unsigned char* lds, int b, int qb16, const TabJob& tj) {
    unsigned char* ws = p.ws;
    int tid = threadIdx.x; asm volatile("" : "+v"(tid));
    const int lane = tid & 63, wave = __builtin_amdgcn_readfirstlane(tid >> 6);
    const int g = lane >> 4, fr = lane & 15, t0 = 16 * qb16, nkt = qb16 + 1;
    const size_t m0 = (size_t)b * SEQ + t0;
    LAS bf16_t* QS = (LAS bf16_t*)(lds + DL_QS); LAS float* WQ = (LAS float*)(lds + DL_WQ);
    LAS unsigned short* SEL = (LAS unsigned short*)(lds + DL_SEL); LAS unsigned* HIST = (LAS unsigned*)(lds + DL_HIST) + wave * 256;
    const LAS unsigned char* BK = lds + DL_BKT; const LAS float* RB = (const LAS float*)(lds + DL_RB);
    _Float16* scr = (_Float16*)(ws + WS_SCR) + (size_t)blockIdx.x * (16 * SEQ);
#ifdef PROBE_TIME
    const unsigned long long td0 = __builtin_amdgcn_s_memrealtime();
#endif
    {
        const bf16_t* qsrc = (const bf16_t*)(ws + WS_QIDX) + m0 * 1024;
#pragma unroll
        for (int i = 0; i < 4; ++i) { const int piece = tid + 512 * i, qi = piece >> 7, rem = piece & 127, h = rem >> 3, ch = rem & 7;
            *(LAS u32x4*)(QS + (h * 16 + qi) * 72 + ch * 8) = *(const u32x4*)(qsrc + (size_t)qi * 1024 + h * 64 + ch * 8); }
        if (tid < 256) WQ[tid] = ((const float*)(ws + WS_WIDX))[m0 * 16 + tid];
        __syncthreads();
        tab_finish(ws, tj, lane);
        { const int qi = tid >> 5, d = (tid & 31) * 2; float s0 = 0.f, s1 = 0.f;
#pragma unroll
            for (int h = 0; h < 16; ++h) { const unsigned w2 = *(const LAS unsigned*)(QS + (h * 16 + qi) * 72 + d); const float wh = WQ[qi * 16 + h]; s0 = fmaf(wh, bf_lo(w2), s0); s1 = fmaf(wh, bf_hi(w2), s1); }
            *(LAS unsigned*)(QS + (16 * 16 + qi) * 72 + d) = cvt_pk_bf16(s0, s1); }
        __syncthreads();
    }
    {
        float wreg[16];
#pragma unroll
        for (int h = 0; h < 16; ++h) wreg[h] = WQ[fr * 16 + h];
        const bf16_t* kbase = (const bf16_t*)(ws + WS_KIDXN) + (size_t)b * SEQ * 64;
        constexpr int NQR = 11;
        bf16x8 qfr[NQR][2];
#pragma unroll
        for (int h = 0; h < NQR; ++h) { qfr[h][0] = *(const LAS bf16x8*)(QS + (h * 16 + fr) * 72 + 8 * g); qfr[h][1] = *(const LAS bf16x8*)(QS + (h * 16 + fr) * 72 + 32 + 8 * g); }
        bf16x8 kn[2];
        { int kt = wave; if (kt >= nkt) kt = 0; const bf16_t* kr = kbase + (size_t)(16 * kt + fr) * 64 + 8 * g; kn[0] = *(const bf16x8*)kr; kn[1] = *(const bf16x8*)(kr + 32); }
#pragma unroll 1
        for (int kt = wave; kt < nkt; kt += 8) {
            const bf16x8 ka0 = kn[0], ka1 = kn[1];
            { int k2 = kt + 8; if (k2 >= nkt) k2 = 0; const bf16_t* kr = kbase + (size_t)(16 * k2 + fr) * 64 + 8 * g; kn[0] = *(const bf16x8*)kr; kn[1] = *(const bf16x8*)(kr + 32); }
            f32x4 sc = {0.f, 0.f, 0.f, 0.f};
            unsigned oz1; asm volatile("v_mov_b32 %0, 0" : "=v"(oz1));
            const LAS bf16_t* QSz = QS + oz1;
            bf16x8 ql[17 - NQR][2];
#pragma unroll
            for (int h = NQR; h < 17; ++h) { ql[h - NQR][0] = *(const LAS bf16x8*)(QSz + (h * 16 + fr) * 72 + 8 * g); ql[h - NQR][1] = *(const LAS bf16x8*)(QSz + (h * 16 + fr) * 72 + 32 + 8 * g); }
#pragma unroll
            for (int h = 0; h < 17; ++h) { f32x4 c = {0.f, 0.f, 0.f, 0.f}; const bf16x8 q0 = (h < NQR) ? qfr[h < NQR ? h : 0][0] : ql[h >= NQR ? h - NQR : 0][0], q1 = (h < NQR) ? qfr[h < NQR ? h : 0][1] : ql[h >= NQR ? h - NQR : 0][1];
                c = MFMA16(ka0, q0, c); c = MFMA16(ka1, q1, c);
                if (h < 16) {
#pragma unroll
                    for (int r = 0; r < 4; ++r) { float t = fmaf(__builtin_fabsf(c[r]), wreg[h < 16 ? h : 0], sc[r]); asm volatile("" : "+v"(t)); sc[r] = t; }
                } else sc += c; }
            { _Float16 hv[4];
#pragma unroll
                for (int r = 0; r < 4; ++r) { const int key = 16 * kt + 4 * g + r; float v = sc[r]; if (kt == nkt - 1 && key > t0 + fr) v = -INFINITY; hv[r] = (_Float16)v; }
                typedef _Float16 h4 __attribute__((ext_vector_type(4))); h4 o; o[0] = hv[0]; o[1] = hv[1]; o[2] = hv[2]; o[3] = hv[3];
                *(h4*)(scr + (size_t)fr * SEQ + 16 * kt + 4 * g) = o; }
        }
    }
    VM_WAIT(); __syncthreads();
#ifdef PROBE_TIME
    const unsigned long long td1 = __builtin_amdgcn_s_memrealtime(); unsigned long long t2acc = 0, t3acc = 0;
#endif
    const unsigned char* ckv8 = ws + WS_CKV8 + (size_t)b * SEQ * 256;
    bf16_t* AO = (bf16_t*)(ws + WS_AOUT);
    LAS unsigned char* img = lds + DL_IMG + wave * 16384;
#pragma unroll 1
    for (int qq = 0; qq < 2; ++qq) {
#ifdef PROBE_TIME
        const unsigned long long tdq = __builtin_amdgcn_s_memrealtime();
#endif
        int lane3 = threadIdx.x & 63; asm volatile("" : "+v"(lane3));
        const int lane = lane3, g = lane >> 4, fr = lane & 15;
        const unsigned long long lt_mask = (1ull << lane) - 1ull;
        const int qi = wave + 8 * qq, t = t0 + qi, n = t + 1; const size_t m = m0 + qi;
        LAS unsigned short* sel = SEL + qi * 256;
        int cnt;
        if (n <= 256) { cnt = n; for (int k = lane; k < 256; k += 64) sel[k] = (unsigned short)((k < n) ? k : 0); }
        else {
            cnt = 256;
            const unsigned* srow = (const unsigned*)(scr + (size_t)qi * SEQ); const int nw = (n + 1) >> 1;
            unsigned sv[64];
            const int nfull = n >> 1;
#pragma unroll
            for (int blk = 0; blk < 4; ++blk) {
                if (1024 * blk < nw) {
#pragma unroll
                    for (int jj = 0; jj < 16; ++jj) { const int j = 16 * blk + jj; sv[j] = srow[lane + 64 * j]; }
                } else {
#pragma unroll
                    for (int jj = 0; jj < 16; ++jj) sv[16 * blk + jj] = 0u;
                }
            }
            LAS unsigned* H = (LAS unsigned*)img;
#pragma unroll
            for (int k = 0; k < 8; ++k) *(LAS u32x4*)(H + 4 * (lane + 64 * k)) = (u32x4){0u, 0u, 0u, 0u};
            LDS_WAIT();
#pragma unroll
            for (int blk = 0; blk < 4; ++blk) if (1024 * blk < nw) {
#pragma unroll
                for (int jj = 0; jj < 16; ++jj) { const int j = 16 * blk + jj; const unsigned v = sv[j];
                    const unsigned neg = (v >> 15) & 0x00010001u, msk = (neg << 16) - neg;
                    unsigned kk = v ^ (msk | 0x80008000u);
                    if (64 * j + 64 <= nfull) {
                        sv[j] = kk;
                        __hip_atomic_fetch_add(H + ((kk & 0xffffu) >> 5), 1u, __ATOMIC_RELAXED, __HIP_MEMORY_SCOPE_WORKGROUP);
                        __hip_atomic_fetch_add(H + (kk >> 21), 1u, __ATOMIC_RELAXED, __HIP_MEMORY_SCOPE_WORKGROUP);
                    } else {
                        const int w = lane + 64 * j;
                        kk = (w < nw) ? kk : 0u; if (2 * w + 1 >= n) kk &= 0xFFFFu;
                        sv[j] = kk;
                        const unsigned k0 = kk & 0xffffu, k1 = kk >> 16;
                        if (k0) __hip_atomic_fetch_add(H + (k0 >> 5), 1u, __ATOMIC_RELAXED, __HIP_MEMORY_SCOPE_WORKGROUP);
                        if (k1) __hip_atomic_fetch_add(H + (k1 >> 5), 1u, __ATOMIC_RELAXED, __HIP_MEMORY_SCOPE_WORKGROUP);
                    } }
            }
            LDS_WAIT();
            unsigned b1, need1;
            {
                unsigned hb[32];
#pragma unroll
                for (int k = 0; k < 8; ++k) { const u32x4 t = *(const LAS u32x4*)(H + 32 * lane + 4 * k); hb[4 * k] = t.x; hb[4 * k + 1] = t.y; hb[4 * k + 2] = t.z; hb[4 * k + 3] = t.w; }
                unsigned s32 = 0u;
#pragma unroll
                for (int k = 0; k < 32; ++k) s32 += hb[k];
                unsigned incl = s32;
#pragma unroll
                for (int o = 1; o < 64; o <<= 1) { const unsigned t = __shfl_down(incl, o); if (lane + o < 64) incl += t; }
                const unsigned excl = incl - s32; const bool hit = (excl < 256u) && (incl >= 256u);
                unsigned run = excl, bb = 0u, ab = excl; bool found = false;
#pragma unroll
                for (int k = 31; k >= 0; --k) { const unsigned nr = run + hb[k]; if (!found && nr >= 256u) { found = true; bb = (unsigned)k; ab = run; } run = nr; }
                const unsigned long long mask = __ballot(hit); const int src = mask ? (__ffsll((long long)mask) - 1) : 0;
                b1 = __shfl(32u * lane + bb, src); need1 = 256u - __shfl(ab, src);
            }
            LDS_WAIT();
            if (lane < 32) H[lane] = 0u;
            LDS_WAIT();
#pragma unroll
            for (int blk = 0; blk < 4; ++blk) if (1024 * blk < nw) {
#pragma unroll
                for (int jj = 0; jj < 16; ++jj) { const unsigned v = sv[16 * blk + jj]; const unsigned k0 = v & 0xffffu, k1 = v >> 16;
                    if ((k0 >> 5) == b1) __hip_atomic_fetch_add(H + (k0 & 31u), 1u, __ATOMIC_RELAXED, __HIP_MEMORY_SCOPE_WORKGROUP);
                    if ((k1 >> 5) == b1) __hip_atomic_fetch_add(H + (k1 & 31u), 1u, __ATOMIC_RELAXED, __HIP_MEMORY_SCOPE_WORKGROUP); }
            }
            LDS_WAIT();
            unsigned thr, need2;
            {
                const unsigned hv = (lane < 32) ? H[lane] : 0u; unsigned incl = hv;
#pragma unroll
                for (int o = 1; o < 32; o <<= 1) { const unsigned t = __shfl_down(incl, o); if (lane + o < 32) incl += t; }
                const unsigned excl = incl - hv; const bool hit = (lane < 32) && (excl < need1) && (incl >= need1);
                const unsigned long long mask = __ballot(hit); const int src = mask ? (__ffsll((long long)mask) - 1) : 0;
                thr = (b1 << 5) | (unsigned)src; need2 = need1 - __shfl(excl, src);
            }
            unsigned mg[4], me[4];
#pragma unroll
            for (int blk = 0; blk < 4; ++blk) { unsigned g1 = 0u, e1 = 0u;
                if (1024 * blk < nw) {
#pragma unroll
                    for (int jj = 0; jj < 16; ++jj) { const unsigned v = sv[16 * blk + jj]; const unsigned k0 = v & 0xffffu, k1 = v >> 16;
                        asm("v_cmp_gt_u32 vcc, %2, %4\n\tv_addc_co_u32 %0, vcc, %0, %0, vcc\n\tv_cmp_gt_u32 vcc, %3, %4\n\tv_addc_co_u32 %0, vcc, %0, %0, vcc\n\t"
                            "v_cmp_eq_u32 vcc, %2, %4\n\tv_addc_co_u32 %1, vcc, %1, %1, vcc\n\tv_cmp_eq_u32 vcc, %3, %4\n\tv_addc_co_u32 %1, vcc, %1, %1, vcc"
                            : "+v"(g1), "+v"(e1) : "v"(k0), "v"(k1), "v"(thr) : "vcc"); }
                }
                mg[blk] = g1; me[blk] = e1; }
            const unsigned cgt = (unsigned)(__builtin_popcount(mg[0]) + __builtin_popcount(mg[1]) + __builtin_popcount(mg[2]) + __builtin_popcount(mg[3]));
            const unsigned ceq = (unsigned)(__builtin_popcount(me[0]) + __builtin_popcount(me[1]) + __builtin_popcount(me[2]) + __builtin_popcount(me[3]));
            unsigned pg = cgt, pe = ceq;
#pragma unroll
            for (int o = 1; o < 64; o <<= 1) { const unsigned tg = __shfl_up(pg, o), te = __shfl_up(pe, o); if (lane >= o) { pg += tg; pe += te; } }
            unsigned og = pg - cgt, oe = pe - ceq;
#pragma unroll
            for (int blk = 0; blk < 4; ++blk) {
                unsigned m = mg[blk];
                while (__any(m != 0u)) {
                    if (m) { const int bp = __builtin_ctz(m); const int pq = 31 - bp; sel[og] = (unsigned short)(2 * (lane + 64 * (16 * blk + (pq >> 1))) + (pq & 1)); ++og; m &= m - 1u; } }
                m = me[blk];
                while (__any(m != 0u)) {
                    if (m) { const int bp = __builtin_ctz(m); const int pq = 31 - bp; if (oe < need2) sel[255u - oe] = (unsigned short)(2 * (lane + 64 * (16 * blk + (pq >> 1))) + (pq & 1)); ++oe; m &= m - 1u; } }
            }
        }
        LDS_WAIT();
#ifdef PROBE_TIME
        const unsigned long long td2 = __builtin_amdgcn_s_memrealtime();
#endif
        bf16x8 qf[8];
        { const bf16_t* qrow = AO + m * 1536 + 512 + (fr & 3) * 256;
#pragma unroll
            for (int s = 0; s < 8; ++s) { bf16x8 v = *(const bf16x8*)(qrow + 64 * (s >> 1) + 16 * g + 8 * (s & 1)); if (fr >= 4) v = (bf16x8){0, 0, 0, 0, 0, 0, 0, 0}; qf[s] = v; } }
        f32x4 O[16];
#pragma unroll
        for (int c = 0; c < 16; ++c) O[c] = (f32x4){0.f, 0.f, 0.f, 0.f};
        float mrun = -1e30f, lrun = 0.f;
        const int nchunk = (cnt + 31) >> 5;
        const unsigned img_base = (unsigned)(size_t)img;
        u32x4 gp[8];
#pragma unroll
        for (int rb = 0; rb < 2; ++rb) { const int slot = 16 * rb + fr; const unsigned kraw = sel[slot]; const unsigned key = (slot < cnt) ? kraw : 0u; const unsigned char* kp = ckv8 + (size_t)key * 256 + 16 * g;
#pragma unroll
            for (int pq = 0; pq < 4; ++pq) gp[4 * rb + pq] = *(const u32x4*)(kp + 64 * pq); }
        const unsigned swz_w = ((fr & 3u) << 2) | ((fr >> 2) & 3u), wb = img_base + 256u * fr + 16u * ((2u * g) ^ swz_w);
        const unsigned q4 = (unsigned)fr >> 2, pp = (unsigned)fr & 3u, rrow = 4u * g + q4, swz_r = ((rrow & 3u) << 2) | ((rrow >> 2) & 3u);
        const unsigned rbs = img_base + 256u * rrow + 16u * ((pp >> 1) ^ swz_r) + 8u * (pp & 1u);
#pragma unroll 1
        for (int ck = 0; ck < nchunk; ++ck) {
            f32x4 sacc[2] = {(f32x4){0.f, 0.f, 0.f, 0.f}, (f32x4){0.f, 0.f, 0.f, 0.f}};
#pragma unroll
            for (int i = 0; i < 8; ++i) {
                u32x4 lo, hi;
#pragma unroll
                for (int q = 0; q < 2; ++q) { lo[2 * q] = __builtin_bit_cast(unsigned, __builtin_amdgcn_cvt_scalef32_pk_bf16_fp8(gp[i][q], 1.0f, false)); lo[2 * q + 1] = __builtin_bit_cast(unsigned, __builtin_amdgcn_cvt_scalef32_pk_bf16_fp8(gp[i][q], 1.0f, true));
                    hi[2 * q] = __builtin_bit_cast(unsigned, __builtin_amdgcn_cvt_scalef32_pk_bf16_fp8(gp[i][2 + q], 1.0f, false)); hi[2 * q + 1] = __builtin_bit_cast(unsigned, __builtin_amdgcn_cvt_scalef32_pk_bf16_fp8(gp[i][2 + q], 1.0f, true)); }
                sacc[i >> 2] = MFMA16(__builtin_bit_cast(bf16x8, lo), qf[2 * (i & 3)], sacc[i >> 2]); sacc[i >> 2] = MFMA16(__builtin_bit_cast(bf16x8, hi), qf[2 * (i & 3) + 1], sacc[i >> 2]);
                const unsigned wa = wb ^ (128u * (i & 1)), cst = 8192u * ((i & 3) >> 1) + 4096u * (i >> 2);
                *(LAS u32x4*)(size_t)(wa + cst) = lo; *(LAS u32x4*)(size_t)((wa ^ 16u) + cst) = hi; }
            if (ck + 1 < nchunk) {
#pragma unroll
                for (int rb = 0; rb < 2; ++rb) { const int slot = 32 * (ck + 1) + 16 * rb + fr; const unsigned kraw = sel[slot]; const unsigned key = (slot < cnt) ? kraw : 0u; const unsigned char* kp = ckv8 + (size_t)key * 256 + 16 * g;
#pragma unroll
                    for (int pq = 0; pq < 4; ++pq) gp[4 * rb + pq] = *(const u32x4*)(kp + 64 * pq); }
            }
            float lg[8]; float mx = -1e30f;
#pragma unroll
            for (int rb = 0; rb < 2; ++rb) { const u32x2 kk = *(const LAS u32x2*)(sel + 32 * ck + 16 * rb + 4 * g);
#pragma unroll
                for (int r = 0; r < 4; ++r) { const int slot = 32 * ck + 16 * rb + 4 * g + r; const unsigned kw = (r < 2) ? kk.x : kk.y; const int key = (r & 1) ? (int)(kw >> 16) : (int)(kw & 0xffffu);
                    int dist = t - key; dist = dist < 0 ? 0 : dist; const int bk = BK[dist];
                    float v = sacc[rb][r] + RB[bk * 4 + (fr & 3)]; if (slot >= cnt) v = -1e30f; if (fr >= 4) v = 0.f; lg[4 * rb + r] = v; mx = fmaxf(mx, v); } }
            mx = fmaxf(mx, __shfl_xor(mx, 16)); mx = fmaxf(mx, __shfl_xor(mx, 32));
            const float mnew = fmaxf(mrun, mx), alpha = __expf(mrun - mnew);
            float pv[8], ps = 0.f;
#pragma unroll
            for (int j = 0; j < 8; ++j) { pv[j] = __expf(lg[j] - mnew); ps += pv[j]; }
            lrun = lrun * alpha + ps; mrun = mnew;
            const bf16x8 pf = pk8((f32x4){pv[0], pv[1], pv[2], pv[3]}, (f32x4){pv[4], pv[5], pv[6], pv[7]});
            if (__any(alpha != 1.f)) {
#pragma unroll
                for (int c = 0; c < 16; ++c) O[c] *= alpha;
            }
#pragma unroll
            for (int c4 = 0; c4 < 4; ++c4) {
                u32x2 rr[8];
                const unsigned a0 = rbs ^ (32u * ((4 * c4) & 7)), a1 = rbs ^ (32u * ((4 * c4 + 1) & 7)), a2 = rbs ^ (32u * ((4 * c4 + 2) & 7)), a3 = rbs ^ (32u * ((4 * c4 + 3) & 7));
                asm volatile("ds_read_b64_tr_b16 %0, %8 offset:%12\n\tds_read_b64_tr_b16 %1, %8 offset:%13\n\tds_read_b64_tr_b16 %2, %9 offset:%12\n\tds_read_b64_tr_b16 %3, %9 offset:%13\n\t"
                             "ds_read_b64_tr_b16 %4, %10 offset:%12\n\tds_read_b64_tr_b16 %5, %10 offset:%13\n\tds_read_b64_tr_b16 %6, %11 offset:%12\n\tds_read_b64_tr_b16 %7, %11 offset:%13\n\ts_waitcnt lgkmcnt(0)"
                             : "=&v"(rr[0]), "=&v"(rr[1]), "=&v"(rr[2]), "=&v"(rr[3]), "=&v"(rr[4]), "=&v"(rr[5]), "=&v"(rr[6]), "=&v"(rr[7])
                             : "v"(a0), "v"(a1), "v"(a2), "v"(a3), "n"(8192 * (c4 >> 1)), "n"(8192 * (c4 >> 1) + 4096) : "memory");
#pragma unroll
                for (int j = 0; j < 4; ++j) O[4 * c4 + j] = MFMA16(mk8(rr[2 * j], rr[2 * j + 1]), pf, O[4 * c4 + j]);
            }
        }
        lrun += __shfl_xor(lrun, 16); lrun += __shfl_xor(lrun, 32);
        const float inv = 1.f / lrun;
        if (fr < 4) {
#pragma unroll
            for (int c = 0; c < 16; ++c) {
#ifdef ZERO_DSA
                const f32x4 v = O[c] * 0.f; (void)inv;
#elif defined(DOUBLE_DSA)
                const f32x4 v = O[c] * (2.f * inv);
#else
                const f32x4 v = O[c] * inv;
#endif
                u32x2 w; w.x = cvt_pk_bf16(v[0], v[1]); w.y = cvt_pk_bf16(v[2], v[3]); *(LAS u32x2*)(img + 2 * (fr * 256 + 16 * c + 4 * g)) = w; } }
        LDS_WAIT(); asm volatile("" ::: "memory");
        { const u32x4 t0 = *(const LAS u32x4*)(img + 16 * lane), t1 = *(const LAS u32x4*)(img + 1024 + 16 * lane);
          u32x4* orow = (u32x4*)(AO + m * 1536 + 512); orow[lane] = t0; orow[64 + lane] = t1; }
        LDS_WAIT(); asm volatile("" ::: "memory");
#ifdef PROBE_TIME
        { const unsigned long long td3 = __builtin_amdgcn_s_memrealtime(); t2acc += td2 - tdq; t3acc += td3 - td2; }
#endif
    }
#ifdef PROBE_TIME
    const unsigned long long tdw = __builtin_amdgcn_s_memrealtime();
#endif
    __syncthreads();
#ifdef PROBE_TIME
    if (blockIdx.x == 255 && threadIdx.x == 0) { ((volatile float*)(ws + WS_CTL))[2048 + 28] += (float)(__builtin_amdgcn_s_memrealtime() - tdw) * 0.01f; }
    if (blockIdx.x == 255 && threadIdx.x == 0) { volatile float* ct = (volatile float*)(ws + WS_CTL) + 2048; ct[20] += (float)(td1 - td0) * 0.01f; ct[21] += (float)t2acc * 0.01f; ct[22] += (float)t3acc * 0.01f; ct[23] += 1.f; ct[27] += (float)(__builtin_amdgcn_s_memrealtime() - td0) * 0.01f; }
#endif
}

__device__ __forceinline__ float erf_as(float x) {
    const float ax = __builtin_fabsf(x);
    const float t = __builtin_amdgcn_rcpf(fmaf(0.3275911f, ax, 1.f));
    float pl = fmaf(1.061405429f, t, -1.453152027f); pl = fmaf(pl, t, 1.421413741f); pl = fmaf(pl, t, -0.284496736f); pl = fmaf(pl, t, 0.254829592f); pl *= t;
    const float e = __builtin_amdgcn_exp2f(ax * ax * -1.4426950408889634f);
    return __builtin_copysignf(fmaf(-pl, e, 1.f), x);
}
__device__ __forceinline__ unsigned mbcnt64(unsigned long long m) { return __builtin_amdgcn_mbcnt_hi((unsigned)(m >> 32), __builtin_amdgcn_mbcnt_lo((unsigned)m, 0u)); }
__device__ __forceinline__ float pack_idx(float v, unsigned idx, unsigned mask) { return __uint_as_float((__float_as_uint(v) & ~mask) | idx); }
__device__ __forceinline__ void ins16(float (&L)[16], float x) {
#pragma unroll
    for (int i = 15; i >= 1; --i) L[i] = __builtin_amdgcn_fmed3f(L[i - 1], L[i], x);
    L[0] = fmaxf(L[0], x);
}
__device__ __forceinline__ unsigned pk4_fp8(float a, float b, float c, float d) { int w = __builtin_amdgcn_cvt_pk_fp8_f32(a, b, 0, false); w = __builtin_amdgcn_cvt_pk_fp8_f32(c, d, w, true); return (unsigned)w; }
__device__ __forceinline__ float dot2bf(unsigned a, unsigned b, float acc) { return __builtin_amdgcn_fdot2_f32_bf16(__builtin_bit_cast(bf16x2_t, a), __builtin_bit_cast(bf16x2_t, b), acc, false); }
constexpr float P8_K = 256.f;
#define H2AT(r, i) __builtin_shufflevector(r, r, (i), (i) + 1)
typedef unsigned u32x4a8 __attribute__((ext_vector_type(4), aligned(8)));
__device__ __forceinline__ void p8_offsets(const LAS unsigned short* se, int k0, unsigned (&off)[4], unsigned hoff, unsigned hsh) {
    const u32x4 ew = *(const LAS u32x4*)(se + k0);
#pragma unroll
#ifdef PROBE_MASK
    for (int jj = 0; jj < 4; ++jj) off[jj] = ((ew[jj] >> hsh) & PROBE_MASK) * 768u + hoff;
#else
    for (int jj = 0; jj < 4; ++jj) off[jj] = ((ew[jj] >> hsh) & 0xFFFFu) * 768u + hoff;
#endif
}
#ifdef P8_AUX
typedef __amdgpu_buffer_rsrc_t p8_tab_t;
__device__ __forceinline__ p8_tab_t p8_tab(const unsigned char* T) { return __builtin_amdgcn_make_buffer_rsrc((void*)T, 0, 16384 * 768, 0x00020000); }
__device__ __forceinline__ u32x6 p8_ld(p8_tab_t T, unsigned off) { const u32x4 a = __builtin_amdgcn_raw_buffer_load_b128(T, (int)off, 0, P8_AUX); const u32x2 c = __builtin_amdgcn_raw_buffer_load_b64(T, (int)off + 16, 0, P8_AUX); return (u32x6){a[0], a[1], a[2], a[3], c[0], c[1]}; }
#else
typedef const unsigned char* p8_tab_t;
__device__ __forceinline__ p8_tab_t p8_tab(const unsigned char* T) { return T; }
__device__ __forceinline__ u32x6 p8_ld(const unsigned char* T, unsigned off) { const u32x4a8 a = *(const u32x4a8*)(T + off); const u32x2 c = *(const u32x2*)(T + off + 16); return (u32x6){a[0], a[1], a[2], a[3], c[0], c[1]}; }
#endif
__device__ __forceinline__ void p8_u(u32x6 (&up)[4], const unsigned (&offn)[4], p8_tab_t Tn, LAS float* sg, const LAS float* sul, int k0, const h2_t (&xh)[16], float rs, int lane) {
    float part[4];
#pragma unroll
    for (int jj = 0; jj < 4; ++jj) {
        const h32_t r = __builtin_amdgcn_cvt_scalef32_pk32_f16_fp6(up[jj], 1.0f);
        up[jj] = p8_ld(Tn, offn[jj]);
        float d0 = 0.f, d1 = 0.f;
        d0 = __builtin_amdgcn_fdot2(H2AT(r, 0), xh[0], d0, false); d1 = __builtin_amdgcn_fdot2(H2AT(r, 2), xh[1], d1, false);
        d0 = __builtin_amdgcn_fdot2(H2AT(r, 4), xh[2], d0, false); d1 = __builtin_amdgcn_fdot2(H2AT(r, 6), xh[3], d1, false);
        d0 = __builtin_amdgcn_fdot2(H2AT(r, 8), xh[4], d0, false); d1 = __builtin_amdgcn_fdot2(H2AT(r, 10), xh[5], d1, false);
        d0 = __builtin_amdgcn_fdot2(H2AT(r, 12), xh[6], d0, false); d1 = __builtin_amdgcn_fdot2(H2AT(r, 14), xh[7], d1, false);
        d0 = __builtin_amdgcn_fdot2(H2AT(r, 16), xh[8], d0, false); d1 = __builtin_amdgcn_fdot2(H2AT(r, 18), xh[9], d1, false);
        d0 = __builtin_amdgcn_fdot2(H2AT(r, 20), xh[10], d0, false); d1 = __builtin_amdgcn_fdot2(H2AT(r, 22), xh[11], d1, false);
        d0 = __builtin_amdgcn_fdot2(H2AT(r, 24), xh[12], d0, false); d1 = __builtin_amdgcn_fdot2(H2AT(r, 26), xh[13], d1, false);
        d0 = __builtin_amdgcn_fdot2(H2AT(r, 28), xh[14], d0, false); d1 = __builtin_amdgcn_fdot2(H2AT(r, 30), xh[15], d1, false);
        part[jj] = d0 + d1; }
    float r2[2];
#pragma unroll
    for (int k = 0; k < 2; ++k) { const float mine = (lane & 16) ? part[k + 2] : part[k], theirs = (lane & 16) ? part[k] : part[k + 2]; r2[k] = mine + __shfl_xor(theirs, 16); }
    float r1; { const float mine = (lane & 8) ? r2[1] : r2[0], theirs = (lane & 8) ? r2[0] : r2[1]; r1 = mine + dpp_mov<0x128>(theirs); }
    r1 += dpp_mov<0xB1>(r1); r1 += dpp_mov<0x4E>(r1); r1 += dpp_mov<0x141>(r1);
    const int jl = ((lane >> 4) & 1) * 4 + ((lane >> 3) & 1) * 2 + ((lane >> 5) & 1);
    const float a = r1 * rs * sul[k0 + jl]; const float act = 0.5f * a * (1.f + erf_as(a * 0.70710678118654752f));
    const float coef = sg[k0 + jl] * act;
    if ((lane & 7) == 0) sg[k0 + jl] = coef;
}
__device__ __forceinline__ void p8_v(u32x6 (&vp)[4], const unsigned (&offn)[4], p8_tab_t Tn, const LAS float* sg, int k0, h2_t (&y16)[16], int lane) {
    float cj[4];
#pragma unroll
    for (int jj = 0; jj < 4; ++jj) cj[jj] = sg[k0 + 2 * jj + (lane >> 5)];
#pragma unroll
    for (int jj = 0; jj < 4; ++jj) {
        const h32_t r = __builtin_amdgcn_cvt_scalef32_pk32_f16_fp6(vp[jj], 1.0f);
        vp[jj] = p8_ld(Tn, offn[jj]);
        const _Float16 cf = (_Float16)cj[jj]; const h2_t c2 = {cf, cf};
        y16[0] += c2 * H2AT(r, 0); y16[1] += c2 * H2AT(r, 2); y16[2] += c2 * H2AT(r, 4); y16[3] += c2 * H2AT(r, 6);
        y16[4] += c2 * H2AT(r, 8); y16[5] += c2 * H2AT(r, 10); y16[6] += c2 * H2AT(r, 12); y16[7] += c2 * H2AT(r, 14);
        y16[8] += c2 * H2AT(r, 16); y16[9] += c2 * H2AT(r, 18); y16[10] += c2 * H2AT(r, 20); y16[11] += c2 * H2AT(r, 22);
        y16[12] += c2 * H2AT(r, 24); y16[13] += c2 * H2AT(r, 26); y16[14] += c2 * H2AT(r, 28); y16[15] += c2 * H2AT(r, 30); }
}
__device__ __forceinline__ h2_t bf2_to_h2(unsigned w) { return __builtin_bit_cast(h2_t, __builtin_amdgcn_cvt_pkrtz(__uint_as_float(w << 16), __uint_as_float(w & 0xFFFF0000u))); }
__device__ __forceinline__ void p8_peer(const Params& p, LAS unsigned char* lds, int bx, int wave, int lane_in, XcdBarrier& bar) {
    unsigned char* ws = p.ws;
    const _Float16* S = (const _Float16*)(ws + WS_S); const float* rss = (const float*)(ws + WS_CTL + CTL_RSS);
    const p8_tab_t UB6 = p8_tab(ws + WS_UB), VB6 = p8_tab(ws + WS_VB); const bf16_t* X1B = (const bf16_t*)(ws + WS_X1B);
    const float* SU = (const float*)(ws + WS_SUV); const float* SV = SU + 16384;
    LAS unsigned short* EI = (LAS unsigned short*)(lds + wave * 6656);
    LAS float* GT = (LAS float*)(lds + wave * 6656 + 1024);
    LAS unsigned char* IX = lds + wave * 6656 + 3072;
    LAS float* SUL = (LAS float*)(lds + wave * 6656 + 4352);
    LAS float* YL = (LAS float*)(lds + 8 * 6656 + wave * 4096);
#ifdef PROBE_TIME
    unsigned long long pr_acc = 0, ps_acc = 0, pg_acc = 0;
#endif
    unsigned nsync = 0;
#pragma unroll 1
    for (int blk0 = 0; blk0 < MT / 128; blk0 += (int)gridDim.x)
    for (int ds = 0; ds < 4; ++ds) {
#ifdef P8_ALIGN
        if (blk0 + ds > 0) xcd_barrier(bar);
#endif
        const int blk = blk0 + bx; if (blk >= MT / 128) continue;
        int lane = lane_in; asm volatile("" : "+v"(lane));
        const int tq = lane >> 4, hs = lane & 15, head = hs >> 1, side = hs & 1;
        const size_t m0 = ((size_t)blk * 4 + ds) * 32 + wave * 4;
#ifdef PROBE_TIME
        const unsigned long long tp0 = __builtin_amdgcn_s_memrealtime();
#endif
        {
            const size_t m = m0 + tq; const _Float16* srow = S + m * 2048 + hs * 128;
            float L[16];
#pragma unroll
            for (int i = 0; i < 16; ++i) L[i] = -INFINITY;
#pragma unroll 4
            for (int j8 = 0; j8 < 16; ++j8) { const u32x4 v = ((const u32x4*)srow)[j8];
                const unsigned vw[4] = {v.x, v.y, v.z, v.w};
#pragma unroll
                for (int e = 0; e < 4; ++e) { const float lo = (float)__builtin_bit_cast(_Float16, (unsigned short)(vw[e] & 0xFFFFu)), hi = (float)__builtin_bit_cast(_Float16, (unsigned short)(vw[e] >> 16));
                    ins16(L, pack_idx(lo, (unsigned)(8 * j8 + 2 * e), 0x7Fu)); ins16(L, pack_idx(hi, (unsigned)(8 * j8 + 2 * e + 1), 0x7Fu)); } }
            float A[16], B[16];
#pragma unroll
            for (int i = 0; i < 16; ++i) { const float o = dpp_mov<0xB1>(L[i]); A[i] = side ? o : L[i]; B[i] = side ? L[i] : o; }
            float C[16];
#pragma unroll
            for (int i = 0; i < 16; ++i) C[i] = -INFINITY;
#pragma unroll
            for (int i = 0; i < 16; ++i)
#pragma unroll
                for (int j = 0; j < 16; ++j) if ((i + 1) * (j + 1) <= 16) {
                    const unsigned ab = __float_as_uint(A[i]), bb = __float_as_uint(B[j]);
                    const float sum = __uint_as_float(ab & ~0x7Fu) + __uint_as_float(bb & ~0x7Fu);
                    ins16(C, pack_idx(sum, (unsigned)(i * 16 + j), 0xFFu)); }
            { u32x4 w;
                w.x = (__float_as_uint(L[0]) & 0x7Fu) | ((__float_as_uint(L[1]) & 0x7Fu) << 8) | ((__float_as_uint(L[2]) & 0x7Fu) << 16) | ((__float_as_uint(L[3]) & 0x7Fu) << 24);
                w.y = (__float_as_uint(L[4]) & 0x7Fu) | ((__float_as_uint(L[5]) & 0x7Fu) << 8) | ((__float_as_uint(L[6]) & 0x7Fu) << 16) | ((__float_as_uint(L[7]) & 0x7Fu) << 24);
                w.z = (__float_as_uint(L[8]) & 0x7Fu) | ((__float_as_uint(L[9]) & 0x7Fu) << 8) | ((__float_as_uint(L[10]) & 0x7Fu) << 16) | ((__float_as_uint(L[11]) & 0x7Fu) << 24);
                w.w = (__float_as_uint(L[12]) & 0x7Fu) | ((__float_as_uint(L[13]) & 0x7Fu) << 8) | ((__float_as_uint(L[14]) & 0x7Fu) << 16) | ((__float_as_uint(L[15]) & 0x7Fu) << 24);
                *(LAS u32x4*)(IX + lane * 16) = w; }
            LDS_WAIT(); asm volatile("" ::: "memory");
            float tv[16]; unsigned ei[16]; float mx = -INFINITY;
#pragma unroll
            for (int k = 0; k < 16; ++k) { const unsigned rk = __float_as_uint(C[k]) & 0xFFu; const unsigned i1 = IX[(lane & ~1) * 16 + (rk >> 4)], i2 = IX[(lane | 1) * 16 + (rk & 15u)];
                ei[k] = (i1 << 7) | i2; tv[k] = (float)S[m * 2048 + head * 256 + i1] + (float)S[m * 2048 + head * 256 + 128 + i2]; mx = fmaxf(mx, tv[k]); }
            float z = 0.f;
#pragma unroll
            for (int k = 0; k < 16; ++k) { tv[k] = __expf(tv[k] - mx); z += tv[k]; }
            const float iz = 1.f / z;
#pragma unroll
            for (int k = 0; k < 16; ++k) { EI[tq * 128 + head * 16 + k] = (unsigned short)ei[k]; GT[tq * 128 + head * 16 + k] = tv[k] * iz * (SV[ei[k]] * P8_K); SUL[tq * 128 + head * 16 + k] = SU[ei[k]]; }
        }
        LDS_WAIT(); asm volatile("" ::: "memory");
#ifdef PROBE_TIME
        const unsigned long long tp1 = __builtin_amdgcn_s_memrealtime();
#endif
#pragma unroll 1
        for (int t4 = 0; t4 < 4; ++t4) {
            const unsigned e0 = EI[t4 * 128 + lane], e1 = EI[t4 * 128 + 64 + lane]; const float g0 = GT[t4 * 128 + lane], g1 = GT[t4 * 128 + 64 + lane], s0 = SUL[t4 * 128 + lane], s1 = SUL[t4 * 128 + 64 + lane];
            LDS_WAIT(); asm volatile("" ::: "memory");
            unsigned base = 0u;
#pragma unroll 1
            for (unsigned s = 0; s < 16; ++s) {
                const bool h0 = (e0 >> 10) == s, h1 = (e1 >> 10) == s;
                const unsigned long long b0 = __ballot(h0), b1 = __ballot(h1);
                if (h0) { const unsigned pos = base + mbcnt64(b0); EI[t4 * 128 + pos] = (unsigned short)e0; GT[t4 * 128 + pos] = g0; SUL[t4 * 128 + pos] = s0; }
                if (h1) { const unsigned pos = base + (unsigned)__popcll(b0) + mbcnt64(b1); EI[t4 * 128 + pos] = (unsigned short)e1; GT[t4 * 128 + pos] = g1; SUL[t4 * 128 + pos] = s1; }
                base += (unsigned)__popcll(b0) + (unsigned)__popcll(b1);
            }
        }
        LDS_WAIT(); asm volatile("" ::: "memory");
#ifdef PROBE_TIME
        const unsigned long long tp2 = __builtin_amdgcn_s_memrealtime();
#endif
        {
            const int hf = lane >> 5, sl = lane & 31; const unsigned hoff = 24u * sl, hsh = 16u * hf;
            u32x6 uT[4][4];
#pragma unroll
            for (int tk = 0; tk < 4; ++tk) { unsigned o0[4]; p8_offsets(EI, 128 * tk, o0, hoff, hsh);
#pragma unroll
              for (int jj = 0; jj < 4; ++jj) uT[tk][jj] = p8_ld(UB6, o0[jj]); }
            {
                h2_t y4[4][16];
                {
                h2_t xh[4][16]; float rs4[4];
#pragma unroll
                for (int tk = 0; tk < 4; ++tk) { const u32x4* xr = (const u32x4*)(X1B + (m0 + tk) * 1024) + 4 * sl;
#pragma unroll
                  for (int q = 0; q < 4; ++q) { const u32x4 ta = xr[q];
#pragma unroll
                      for (int e = 0; e < 4; ++e) xh[tk][4 * q + e] = bf2_to_h2(ta[e]); }
                  rs4[tk] = rsqrtf(rss[m0 + tk] * (1.f / DM) + EPS); }
                xcd_local_sync(bar, ++nsync);
#pragma unroll 1
                for (int hp = 0; hp < 2; ++hp) {
                if (hp) xcd_local_sync(bar, ++nsync);
#pragma unroll 1
                for (int i = 8 * hp; i < 8 * hp + 8; ++i) {
                    const int kN = (i < 15) ? 8 * i + 8 : 0; const p8_tab_t Tn = (i < 15) ? UB6 : VB6;
#pragma unroll
                    for (int tk = 0; tk < 4; ++tk) {
                        unsigned offn[4];
                        p8_offsets(EI, 128 * tk + kN, offn, hoff, hsh);
                        p8_u(uT[tk], offn, Tn, GT, SUL, 128 * tk + 8 * i, xh[tk], rs4[tk], lane);
                    }
                }
                }
                }
#pragma unroll
                for (int tk = 0; tk < 4; ++tk)
#pragma unroll
                    for (int i = 0; i < 16; ++i) y4[tk][i] = (h2_t){(_Float16)0.f, (_Float16)0.f};
                xcd_local_sync(bar, ++nsync);
#pragma unroll 1
                for (int hp = 0; hp < 2; ++hp) {
                if (hp) xcd_local_sync(bar, ++nsync);
#pragma unroll 1
                for (int i = 8 * hp; i < 8 * hp + 8; ++i) {
                    const int kN = (i < 15) ? 8 * i + 8 : 120;
#pragma unroll
                    for (int tk = 0; tk < 4; ++tk) {
                        unsigned offn[4];
                        p8_offsets(EI, 128 * tk + kN, offn, hoff, hsh);
                        p8_v(uT[tk], offn, VB6, GT, 128 * tk + 8 * i, y4[tk], lane);
                    }
                }
                }
                int lz = lane; asm volatile("" : "+v"(lz));
                const int hf_e = lz >> 5, sl_e = lz & 31;
#pragma unroll
                for (int tk = 0; tk < 4; ++tk) {
                    const size_t mm = m0 + tk;
                    float y[16];
#pragma unroll
                    for (int q = 0; q < 8; ++q) { const h2_t lo = y4[tk][q], hi = y4[tk][8 + q];
                        const h2_t mine = hf_e ? hi : lo, send = hf_e ? lo : hi; const h2_t recv = __builtin_bit_cast(h2_t, __shfl_xor(__builtin_bit_cast(int, send), 32));
                        y[2 * q] = ((float)mine[0] + (float)recv[0]) * (1.f / P8_K); y[2 * q + 1] = ((float)mine[1] + (float)recv[1]) * (1.f / P8_K); }
#ifdef DOUBLE_PEER
#pragma unroll
                    for (int i = 0; i < 16; ++i) y[i] *= 2.f;
#endif
#ifdef ZERO_PEER
#pragma unroll
                    for (int i = 0; i < 16; ++i) y[i] = 0.f;
#endif
                    LAS float* yl = YL + 32 * sl_e + 16 * hf_e;
#pragma unroll
                    for (int q = 0; q < 4; ++q) *(LAS f32x4*)(yl + 4 * q) = (f32x4){y[4 * q], y[4 * q + 1], y[4 * q + 2], y[4 * q + 3]};
                    LDS_WAIT(); asm volatile("" ::: "memory");
                    f32x4 o[4]; float ss = 0.f;
#pragma unroll
                    for (int k = 0; k < 4; ++k) { const f32x4 yy = *(const LAS f32x4*)(YL + 4 * lz + 256 * k); const u32x2 xw = *(const u32x2*)(X1B + mm * 1024 + 4 * lz + 256 * k);
                        o[k] = (f32x4){bf_lo(xw.x), bf_hi(xw.x), bf_lo(xw.y), bf_hi(xw.y)} + yy; ss += (o[k][0] * o[k][0] + o[k][1] * o[k][1]) + (o[k][2] * o[k][2] + o[k][3] * o[k][3]); }
                    const float rf = rsqrtf(wave_sum(ss) * (1.f / DM) + EPS);
#pragma unroll
                    for (int k = 0; k < 4; ++k) { const f32x4 fgk = *((const f32x4*)p.final_g + lz + 64 * k); *((f32x4*)(p.out + mm * 1024) + lz + 64 * k) = o[k] * rf * fgk; }
                    LDS_WAIT(); asm volatile("" ::: "memory");
                }
            }
        }
        LDS_WAIT(); asm volatile("" ::: "memory");
#ifdef PROBE_TIME
        { const unsigned long long tp3 = __builtin_amdgcn_s_memrealtime(); pr_acc += tp1 - tp0; ps_acc += tp2 - tp1; pg_acc += tp3 - tp2;
          if (blockIdx.x == 1 && threadIdx.x == 0) { volatile float* ct = (volatile float*)(ws + WS_CTL) + 2048; ct[24] = (float)pr_acc * 0.01f; ct[25] = (float)ps_acc * 0.01f; ct[26] = (float)pg_acc * 0.01f; } }
#endif
    }
}


#ifdef PROBE_GDN
__device__ __forceinline__ void gdn_reference(const Params& p, LAS unsigned char* lds) {
    unsigned char* ws = p.ws; const int tid = threadIdx.x, e = tid & 127, rg = tid >> 7;
    LAS float* KQ = (LAS float*)lds;
    LAS float* RED = (LAS float*)(lds + 1024);
    LAS float* OSQ = (LAS float*)(lds + 4096);
    const float* qf = (const float*)(ws + WS_REF); const float* kf = qf + 512 * 128; const float* vf = kf + 512 * 128;
    const float* garr = (const float*)(ws + WS_RES) + 256; const float* barr = (const float*)(ws + WS_RES) + 1024;
    const bf16_t* ZB = (const bf16_t*)(ws + WS_ZB); const bf16_t* AO = (const bf16_t*)(ws + WS_AOUT);
    float S[32];
#pragma unroll
    for (int i = 0; i < 32; ++i) S[i] = 0.f;
    float d2 = 0.f, r2 = 0.f;
    for (int t = 0; t < 512; ++t) {
        __syncthreads();
        if (tid < 128) KQ[tid] = kf[t * 128 + tid]; else if (tid < 256) KQ[tid] = qf[t * 128 + tid - 128];
        __syncthreads();
        const float al = __expf(garr[t]), be = barr[t], v = vf[t * 128 + e];
        float ks = 0.f;
#pragma unroll
        for (int i = 0; i < 32; ++i) ks = fmaf(KQ[32 * rg + i], S[i], ks);
        RED[rg * 128 + e] = ks;
        __syncthreads();
        const float kS = (RED[e] + RED[128 + e]) + (RED[256 + e] + RED[384 + e]);
        const float dv = be * (v - al * kS);
        float os = 0.f;
#pragma unroll
        for (int i = 0; i < 32; ++i) { S[i] = fmaf(KQ[32 * rg + i], dv, al * S[i]); os = fmaf(KQ[128 + 32 * rg + i], S[i], os); }
        __syncthreads();
        RED[rg * 128 + e] = os;
        __syncthreads();
        const float o = (RED[e] + RED[128 + e]) + (RED[256 + e] + RED[384 + e]);
        if (rg == 0) { const float sq = wave_sum(o * o); if ((tid & 63) == 0) OSQ[tid >> 6] = sq; }
        __syncthreads();
        if (rg == 0) { const float rstd = rsqrtf((OSQ[0] + OSQ[1]) * (1.f / 128.f) + EPS); const float zf = bf2f(ZB[(size_t)t * 512 + e]);
            const float ref = o * rstd * p.gdn_norm_g[e] * silu_f(zf); const float got = bf2f(AO[(size_t)t * 1536 + e]);
            if (t >= PROBE_T0 && t < PROBE_T1) { d2 += (got - ref) * (got - ref); r2 += ref * ref; } }
    }
    if (rg == 0) { d2 = wave_sum(d2); r2 = wave_sum(r2); if ((tid & 63) == 0) { atomicAdd((float*)(ws + WS_RES), d2); atomicAdd((float*)(ws + WS_RES) + 1, r2); } }
}
#endif

#ifdef PROBE_GDN
__device__ __forceinline__ void gdn_chunk0_reference(const Params& p, LAS unsigned char* lds) {
    unsigned char* ws = p.ws; const int tid = threadIdx.x;
    LAS float* A = (LAS float*)lds;
    LAS float* Tm = (LAS float*)(lds + 16384);
    LAS float* GCs = (LAS float*)(lds + 32768);
    const float* qf = (const float*)(ws + WS_REF); const float* kf = qf + 512 * 128; const float* vf = kf + 512 * 128;
    const float* garr = (const float*)(ws + WS_RES) + 256; const float* barr = (const float*)(ws + WS_RES) + 1024;
    if (tid == 0) { float acc = 0.f; for (int i = 0; i < 64; ++i) { acc += garr[i]; GCs[i] = acc; GCs[64 + i] = barr[i]; } }
    __syncthreads();
    for (int idx = tid; idx < 4096; idx += NTHR) { const int i = idx >> 6, j = idx & 63; float d = 0.f;
        if (j < i) { for (int e = 0; e < 128; ++e) d = fmaf(kf[i * 128 + e], kf[j * 128 + e], d); d *= GCs[64 + i] * __expf(GCs[i] - GCs[j]); }
        A[idx] = d; Tm[idx] = 0.f; }
    __syncthreads();
#if PROBE_WHAT == 8
    { const float* dmpA = (const float*)(ws + 15 * MiB + 880000); for (int idx = tid; idx < 4096; idx += NTHR) A[idx] = dmpA[idx]; }
    __syncthreads();
#endif
    if (tid < 64) { const int c = tid; for (int i = 0; i < 64; ++i) { float acc = (i == c) ? 1.f : 0.f; for (int j = 0; j < i; ++j) acc = fmaf(-A[i * 64 + j], Tm[j * 64 + c], acc); Tm[i * 64 + c] = acc; } }
    __syncthreads();
    float d2 = 0.f, r2 = 0.f;
#if PROBE_WHAT == 0
    const bf16_t* uT = (const bf16_t*)(ws + WS_VH);
    for (int idx = tid; idx < 8192; idx += NTHR) { const int i = idx >> 7, e = idx & 127; float acc = 0.f;
        for (int j = 0; j <= i; ++j) acc = fmaf(Tm[i * 64 + j] * GCs[64 + j], vf[j * 128 + e], acc);
        const float got = bf2f(uT[e * 64 + i]); d2 += (got - acc) * (got - acc); r2 += acc * acc; }
#elif PROBE_WHAT == 1
    const bf16_t* wB = (const bf16_t*)(ws + WS_WBUF);
    for (int idx = tid; idx < 8192; idx += NTHR) { const int i = idx >> 7, d = idx & 127; float acc = 0.f;
        for (int j = 0; j <= i; ++j) acc = fmaf(Tm[i * 64 + j] * GCs[64 + j] * __expf(GCs[j]), kf[j * 128 + d], acc);
        const int kb = d >> 5, u = (d & 31) >> 2, nu = 2 * (u & 3) + (u >> 2); const float got = bf2f(wB[i * 128 + 32 * kb + 4 * nu + (d & 3)]);
        d2 += (got - acc) * (got - acc); r2 += acc * acc; }
#elif PROBE_WHAT == 3
    { const float* dmp = (const float*)(ws + 15 * MiB + 880000); for (int idx = tid; idx < 4096; idx += NTHR) { const float got = dmp[idx], acc = A[idx]; d2 += (got - acc) * (got - acc); r2 += acc * acc; } }
#elif PROBE_WHAT == 4 || PROBE_WHAT == 8
    { const float* dmp = (const float*)(ws + 15 * MiB + 880000) + 4096; for (int idx = tid; idx < 4096; idx += NTHR) { const float got = dmp[idx], acc = Tm[idx]; d2 += (got - acc) * (got - acc); r2 += acc * acc; } }
#elif PROBE_WHAT >= 5 && PROBE_WHAT <= 7
    { const float* dmp = (const float*)(ws + 15 * MiB + 880000) + 4096; for (int idx = tid; idx < 4096; idx += NTHR) { const int i = idx >> 6, j = idx & 63;
        const bool in = (PROBE_WHAT == 5) ? (i < 32 && j < 32) : ((PROBE_WHAT == 6) ? (i >= 32 && j >= 32) : (i >= 32 && j < 32));
        if (in) { const float got = dmp[idx], acc = Tm[idx]; d2 += (got - acc) * (got - acc); r2 += acc * acc; } } }
#else
    const bf16_t* qB = (const bf16_t*)(ws + WS_QH);
    for (int idx = tid; idx < 8192; idx += NTHR) { const int i = idx >> 7, d = idx & 127; const float acc = qf[i * 128 + d] * __expf(GCs[i]);
        const int kb = d >> 5, u = (d & 31) >> 2, nu = 2 * (u & 3) + (u >> 2); const float got = bf2f(qB[i * 128 + 32 * kb + 4 * nu + (d & 3)]);
        d2 += (got - acc) * (got - acc); r2 += acc * acc; }
#endif
    d2 = wave_sum(d2); r2 = wave_sum(r2);
    if ((tid & 63) == 0) { atomicAdd((float*)(ws + WS_RES), d2); atomicAdd((float*)(ws + WS_RES) + 1, r2); }
}
#endif
__global__ void __launch_bounds__(NTHR, 2) hybrid_fwd(Params p) {
    extern __shared__ __attribute__((aligned(16))) unsigned char lds_raw[];
    LAS unsigned char* lds = (LAS unsigned char*)lds_raw;
    volatile LAS unsigned* MISCW = (volatile LAS unsigned*)(lds + LDS_MISC);
#define PHASE_IDS int tid = threadIdx.x; asm volatile("" : "+v"(tid)); const int lane = tid & 63, wave = __builtin_amdgcn_readfirstlane(tid >> 6); \
    const int gw = bx * NWAVES + wave, ngw = G * NWAVES; (void)lane; (void)gw; (void)ngw;
    const int G = gridDim.x, bx = blockIdx.x;
    unsigned char* ws = p.ws;
    const int tid0 = threadIdx.x;
    unsigned* ctl = (unsigned*)(ws + WS_CTL);
    if (tid0 < 16) MISCW[tid0] = 0u;
    __syncthreads();
    XcdBarrier bar = xcd_barrier_post(ctl + CW_BAR, MISCW);
#if defined(PROBE_TIME) || defined(PROBE_P8)
    unsigned long long tprev = __builtin_amdgcn_s_memrealtime(); int tk = 0;
#define TSTAMP() do { const unsigned long long tn = __builtin_amdgcn_s_memrealtime(); if (threadIdx.x == 0) { const float us = (float)(tn - tprev) * 0.01f; \
        ((volatile LAS float*)(lds + LDS_MISC))[16 + tk] = us; if (blockIdx.x == 0) ((volatile float*)ctl)[2048 + tk] = us; } tprev = tn; ++tk; } while (0)
#else
#define TSTAMP() do {} while (0)
#endif

    { PHASE_IDS p0_prologue(p, lds, gw, ngw, wave, lane); }
    xcd_barrier(bar);
    TSTAMP();
    { pg8::Gemm g{(const bf16_t*)(ws + WS_HB), (const bf16_t*)(ws + WS_WINT), MT, NIN, DM}; pg8::StaticOrder So; So.init(MT, NIN, G, bx); EpiIn E{ws};
      pg8::gemm_phase<EpiIn, pg8::StaticOrder, false>(lds, g, So, E, nullptr); }
    xcd_barrier(bar);
    TSTAMP();
    { PHASE_IDS
#ifdef PROBE_GDN
      if (bx == 0 && tid < 2) ((float*)(ws + WS_RES))[tid] = 0.f;
#endif
      LAS float* cw = (LAS float*)lds;
      for (int i = tid; i < 4 * 1536 / 4; i += NTHR) ((LAS f32x4*)cw)[i] = ((const f32x4*)p.conv_w)[i];
      __syncthreads();
      for (int m = 2 * gw; m < MT; m += 2 * ngw) {
          const int t = m & (SEQ - 1); const bf16_t* pre = (const bf16_t*)(ws + WS_QKV);
          P3C pc; int ln = lane; asm volatile("" : "+v"(ln));
          P3In i0, i1; p3_load(p, i0, m, ln); p3_load(p, i1, m + 1, ln);
          u32x4 xr[5][3];
#pragma unroll
          for (int jj = 0; jj < 5; ++jj)
#pragma unroll
              for (int i = 0; i < 3; ++i) { xr[jj][i] = (u32x4){0u, 0u, 0u, 0u}; if (t - 3 + jj >= 0) xr[jj][i] = *(const u32x4*)(pre + (size_t)(m - 3 + jj) * 1536 + 8 * (ln + 64 * i)); }
          p3_token(p, cw, pc, i0, m, ln, xr[0], xr[1], xr[2], xr[3]);
          p3_token(p, cw, pc, i1, m + 1, ln, xr[1], xr[2], xr[3], xr[4]);
      } }
    xcd_barrier(bar);
    TSTAMP();
    { pg8::Gemm g{(const bf16_t*)(ws + WS_CQ), (const bf16_t*)(ws + WS_WQ2T), MT, 2048, 256}; pg8::StaticOrder So; So.init(MT, 2048, G, bx); EpiQ E{ws};
      pg8::gemm_phase<EpiQ, pg8::StaticOrder, false>(lds, g, So, E, nullptr); }
    __syncthreads();
    { PHASE_IDS G2In gin; if (bx < 16 * NCHUNK) g2_load(p, gin, bx, tid, lane);
      for (int cb = bx; cb < 16 * NCHUNK; cb += G) g2_chunk(p, lds, cb, cb + G, gin, tid, wave, lane); }
    xcd_barrier(bar);
    TSTAMP();
    if (bx < 16) { PHASE_IDS g3_scan(p, lds, bx, wave, lane); __syncthreads();
#ifdef PROBE_TIME
        { const unsigned long long tn = __builtin_amdgcn_s_memrealtime(); if (threadIdx.x == 0) { const float us = (float)(tn - tprev) * 0.01f; ((volatile LAS float*)(lds + LDS_MISC))[16 + 10] = us; if (blockIdx.x == 0) ((volatile float*)ctl)[2048 + 10] = us; } }
#endif
    }
#ifdef SCAN_ALONE
    xcd_barrier(bar);
#endif
    { PHASE_IDS
    dsa_tables(p, lds, tid);
    for (int qi = 0; qi < 4; ++qi) {
        const int b = (int)((bar.x + (unsigned)qi) & 3u);
        for (;;) {
            if (tid == 0) MISCW[2] = __hip_atomic_fetch_add(ctl + CW_QUEUE + 16 * b, 1u, __ATOMIC_RELAXED, __HIP_MEMORY_SCOPE_AGENT);
            __syncthreads();
            const unsigned u = MISCW[2];
            __syncthreads();
            if (u >= 512u) break;
            TabJob tj; tab_load(p, tj, (int)((unsigned)b * 512u + u) * 8 + wave, lane);
            dsa_unit(p, lds, b, 511 - (int)u, tj);
        }
    } }
    xcd_barrier(bar);
    TSTAMP();
#ifdef PROBE_GDN
#ifdef PROBE_WHAT
    if (bx == 255) { gdn_chunk0_reference(p, lds); __syncthreads(); }
#else
    if (bx == 255) { gdn_reference(p, lds); __syncthreads(); }
#endif
#endif
    {
        PHASE_IDS
        pg8::Gemm g{(const bf16_t*)(ws + WS_AOUT), (const bf16_t*)(ws + WS_WOUT2T), MT, DM, 1536}; pg8::StaticOrder So; So.init(MT, DM, G, bx);
        EpiOut E{p.x, (bf16_t*)(ws + WS_X1B), (float*)(ws + WS_CTL + CTL_RSS)};
        pg8::gemm_phase<EpiOut, pg8::StaticOrder, false>(lds, g, So, E, nullptr);
    }
    xcd_barrier(bar);
    TSTAMP();
    { pg8::Gemm g{(const bf16_t*)(ws + WS_X1B), (const bf16_t*)(ws + WS_WQST), MT, 2048, DM}; pg8::StaticOrder So; So.init(MT, 2048, G, bx);
      EpiS E{(_Float16*)(ws + WS_S), (const float*)(ws + WS_CTL + CTL_RSS)};
      pg8::gemm_phase<EpiS, pg8::StaticOrder, false>(lds, g, So, E, nullptr); }
    xcd_barrier(bar);
    TSTAMP();
    { PHASE_IDS p8_peer(p, lds, bx, wave, lane, bar); }
#ifdef PROBE_P8
    xcd_barrier(bar);
    TSTAMP();
    xcd_barrier(bar);
    { PHASE_IDS
      const float tp = ((const volatile float*)ctl)[2048 + PROBE_TA];
      const float qa = rintf(PROBE_SCALE * log2f(fmaxf(tp, 1.f)) + PROBE_SHIFT) - PROBE_BASE, qb = rintf(PROBE_SCALE * log2f(fmaxf(tp, 1.f)) + 0.5f + PROBE_SHIFT) - PROBE_BASE;
      const float sc = 1.f + 0.25f * qa;
      for (int m = gw; m < MT; m += ngw) {
          const f32x4* xr4 = (const f32x4*)(p.x + (size_t)m * 1024) + 4 * lane; f32x4* orow = (f32x4*)(p.out + (size_t)m * 1024) + 4 * lane;
          f32x4 w0 = xr4[0] * sc; if (m == 0 && lane == 0) w0[0] = 10.f * qb;
          orow[0] = w0; orow[1] = xr4[1] * sc; orow[2] = xr4[2] * sc; orow[3] = xr4[3] * sc; } }
#endif
}

extern "C" void kernel_launch(void* const* d_in, const int* in_sizes, int n_in, void* d_out, int out_size, void* d_ws, size_t ws_size, hipStream_t stream) {
    static int grid = 0;
    if (grid == 0) {
        if (n_in != 23 || in_sizes[0] != MT * DM || out_size != MT * DM || ws_size < WS_END) {
            fprintf(stderr, "kernel_launch: unexpected problem shape (n_in %d, in0 %d, out %d, ws %zu); nothing launched\n", n_in, n_in > 0 ? in_sizes[0] : -1, out_size, ws_size); grid = -1; return; }
        int dev = 0, cus = 0, per_cu = 0;
        if (hipGetDevice(&dev) != hipSuccess || hipDeviceGetAttribute(&cus, hipDeviceAttributeMultiprocessorCount, dev) != hipSuccess) { grid = -1; return; }
        if (hipFuncSetAttribute((const void*)hybrid_fwd, hipFuncAttributeMaxDynamicSharedMemorySize, LDS_BYTES) != hipSuccess) { fprintf(stderr, "kernel_launch: hipFuncSetAttribute failed\n"); grid = -1; return; }
        if (hipOccupancyMaxActiveBlocksPerMultiprocessor(&per_cu, (const void*)hybrid_fwd, NTHR, LDS_BYTES) != hipSuccess || per_cu < 1) { fprintf(stderr, "kernel_launch: occupancy query says %d\n", per_cu); }
        (void)hipGetLastError();
        grid = cus;
    }
    if (grid < 0) return;
    (void)hipMemsetAsync((char*)d_ws + WS_CTL, 0, CTL_BYTES, stream);
    Params p{};
    const float** pp = (const float**)&p;
    for (int i = 0; i < 23; ++i) pp[i] = (const float*)d_in[i];
    p.out = (float*)d_out; p.ws = (unsigned char*)d_ws;
    hipLaunchKernelGGL(hybrid_fwd, dim3(grid), dim3(NTHR), LDS_BYTES, stream, p);
}
```

```cpp
#include <hip/hip_runtime.h>
#include <cstdio>
#include <cstdint>

#define LAS __attribute__((address_space(3)))
#define CAS __attribute__((address_space(4)))
typedef unsigned short bf16_t;
typedef short bf16x8 __attribute__((ext_vector_type(8)));
typedef float f32x4 __attribute__((ext_vector_type(4)));
typedef float f32x2 __attribute__((ext_vector_type(2)));
typedef unsigned u32x4 __attribute__((ext_vector_type(4)));
typedef unsigned u32x2 __attribute__((ext_vector_type(2)));
typedef __bf16 bf16x2_t __attribute__((ext_vector_type(2)));
typedef _Float16 h2_t __attribute__((ext_vector_type(2)));
typedef unsigned u32x3a __attribute__((ext_vector_type(3), aligned(4)));
typedef unsigned u32x6 __attribute__((ext_vector_type(6)));
typedef _Float16 h32_t __attribute__((ext_vector_type(32)));

constexpr int BATCH = 4, SEQ = 8192, DM = 1024, MT = BATCH * SEQ;
constexpr int IN_W = 2648, NIN = 2816;
constexpr int NCHUNK = SEQ / 64;
constexpr float EPS = 1e-6f;
constexpr int NWAVES = 8, NTHR = 512;

constexpr size_t MiB = 1u << 20;
constexpr size_t WS_CTL = 0, CTL_BYTES = 1 * MiB;
constexpr size_t WS_WINT = 1 * MiB;
constexpr size_t WS_WQ2T = 7 * MiB;
constexpr size_t WS_WOUT2T = 8 * MiB;
constexpr size_t WS_WQST = 11 * MiB;
constexpr size_t WS_GAMMA = 15 * MiB;
constexpr size_t WS_UB = 368 * MiB;
constexpr size_t WS_VB = 384 * MiB;
constexpr size_t WS_SUV = 400 * MiB;
constexpr size_t WS_SCR = 16 * MiB;
constexpr size_t WS_HB = 80 * MiB;
constexpr size_t WS_KIDXN = 80 * MiB;
constexpr size_t WS_WIDX = 84 * MiB;
constexpr size_t WS_GARR = 86 * MiB;
constexpr size_t WS_BARR = 87 * MiB;
constexpr size_t WS_ATTN = 88 * MiB;
constexpr size_t WS_CKV8 = 104 * MiB;
constexpr size_t WS_REF = 15 * MiB + 65536;
constexpr size_t WS_RES = 15 * MiB + 32768;
constexpr size_t WS_X1B = 80 * MiB;
constexpr size_t WS_AOUT = 144 * MiB;
constexpr size_t WS_QKV = 240 * MiB;
constexpr size_t WS_QIDX = 240 * MiB;
constexpr size_t WS_WBUF = 304 * MiB;
constexpr size_t WS_ZB = 336 * MiB;
constexpr size_t WS_CQ = 368 * MiB;
constexpr size_t WS_CKV = 384 * MiB;
constexpr size_t WS_MISC = 400 * MiB;
constexpr size_t WS_QH = 416 * MiB;
constexpr size_t WS_KH = 448 * MiB;
constexpr size_t WS_VH = 480 * MiB;
constexpr size_t WS_S = 144 * MiB;
constexpr size_t WS_END = 512 * MiB;
constexpr int CW_QUEUE = 64;
constexpr int CW_BAR = 4096;
constexpr size_t CTL_RSS = 256 * 1024;

constexpr int LDS_BYTES = 160 * 1024;
constexpr int LDS_MISC = LDS_BYTES - 256;

__device__ __forceinline__ unsigned cvt_pk_bf16(float lo, float hi) { const f32x2 v = {lo, hi}; return __builtin_bit_cast(unsigned, __builtin_convertvector(v, bf16x2_t)); }
__device__ __forceinline__ float bf_lo(unsigned w) { return __uint_as_float(w << 16); }
__device__ __forceinline__ float bf_hi(unsigned w) { return __uint_as_float(w & 0xffff0000u); }
__device__ __forceinline__ float bf2f(bf16_t b) { return __uint_as_float(((unsigned)b) << 16); }
__device__ __forceinline__ bf16_t f2bf(float f) { return (bf16_t)(cvt_pk_bf16(f, 0.f) & 0xffffu); }
template <int CTRL> __device__ __forceinline__ float dpp_mov(float v) { return __builtin_bit_cast(float, __builtin_amdgcn_update_dpp(0, __builtin_bit_cast(int, v), CTRL, 0xF, 0xF, true)); }
__device__ __forceinline__ float row16_sum(float s) {
    s += dpp_mov<0xB1>(s); s += dpp_mov<0x4E>(s); s += dpp_mov<0x141>(s); s += dpp_mov<0x140>(s); return s; }
__device__ __forceinline__ float rl_f(float v, int l) { return __builtin_bit_cast(float, __builtin_amdgcn_readlane(__builtin_bit_cast(int, v), l)); }
__device__ __forceinline__ float wave_sum(float v) { v = row16_sum(v); return (rl_f(v, 0) + rl_f(v, 16)) + (rl_f(v, 32) + rl_f(v, 48)); }
__device__ __forceinline__ float silu_f(float x) { return x * __builtin_amdgcn_rcpf(1.f + __expf(-x)); }
#define LDS_WAIT() asm volatile("s_waitcnt lgkmcnt(0)" ::: "memory")
#define VM_WAIT() asm volatile("s_waitcnt vmcnt(0)" ::: "memory")
__device__ __forceinline__ bf16x8 mk8(u32x2 lo, u32x2 hi) { u32x4 t; t.x = lo.x; t.y = lo.y; t.z = hi.x; t.w = hi.y; return __builtin_bit_cast(bf16x8, t); }
__device__ __forceinline__ bf16x8 pk8(f32x4 a, f32x4 b) { u32x4 t; t.x = cvt_pk_bf16(a[0], a[1]); t.y = cvt_pk_bf16(a[2], a[3]); t.z = cvt_pk_bf16(b[0], b[1]); t.w = cvt_pk_bf16(b[2], b[3]); return __builtin_bit_cast(bf16x8, t); }
__device__ __forceinline__ bf16x8 pk8lo(f32x4 a, f32x4 b, bf16x8 hi) { const u32x4 h = __builtin_bit_cast(u32x4, hi); f32x4 ra, rb;
    ra[0] = a[0] - bf_lo(h.x); ra[1] = a[1] - bf_hi(h.x); ra[2] = a[2] - bf_lo(h.y); ra[3] = a[3] - bf_hi(h.y);
    rb[0] = b[0] - bf_lo(h.z); rb[1] = b[1] - bf_hi(h.z); rb[2] = b[2] - bf_lo(h.w); rb[3] = b[3] - bf_hi(h.w); return pk8(ra, rb); }
#define MFMA16(a, b, c) __builtin_amdgcn_mfma_f32_16x16x32_bf16((a), (b), (c), 0, 0, 0)

#define XB_TMO      128
#define XB_XCNT(j)  (256  + 64 * (j))
#define XB_XSUB(j)  (1280 + 64 * (j))
#define XB_XGEN(j)  (2304 + 64 * (j))
#define XB_TOP      3328
#define XB_TOPGEN   3392
#define XCD_BAR_WORDS 3456
#define XB_SPIN_CAP (1u << 23)
__device__ __forceinline__ unsigned xb_ld(unsigned* p)              { return __hip_atomic_load(p, __ATOMIC_RELAXED, __HIP_MEMORY_SCOPE_AGENT); }
__device__ __forceinline__ unsigned xb_add(unsigned* p, unsigned v) { return __hip_atomic_fetch_add(p, v, __ATOMIC_RELAXED, __HIP_MEMORY_SCOPE_AGENT); }
__device__ __forceinline__ unsigned xb_xcc_id() { return (unsigned)__builtin_amdgcn_s_getreg((3 << 11) | 20) & 0xFu; }
#define XB_SPIN(cond, bar) do { unsigned _sp = 0; while (cond) { __builtin_amdgcn_s_sleep(1); \
    if ((++_sp & 255u) == 0u) { if (xb_ld(&(bar)[XB_TMO])) break; if (_sp > XB_SPIN_CAP) { atomicAdd(&(bar)[XB_TMO], 1u); break; } } } } while (0)
struct XcdBarrier { unsigned* bar; unsigned x; volatile LAS unsigned* st; };
__device__ __forceinline__ XcdBarrier xcd_barrier_post(unsigned* bar, volatile LAS unsigned* st) {
    XcdBarrier b; b.bar = bar; b.x = xb_xcc_id(); b.st = st;
    if (threadIdx.x == 0) (void)xb_add(&bar[XB_XCNT(b.x)], 1u);
    return b;
}
__device__ __forceinline__ void xcd_barrier_complete(unsigned* bar, unsigned x, unsigned& nloc, unsigned& nx) {
    const unsigned G = gridDim.x * gridDim.y * gridDim.z;
    unsigned sum, cnt, mine, sp = 0u;
    for (;;) {
        sum = 0u; cnt = 0u; mine = 0u;
#pragma unroll
        for (unsigned j = 0; j < 16; ++j) { const unsigned c = xb_ld(&bar[XB_XCNT(j)]); sum += c; cnt += (c > 0u) ? 1u : 0u; mine = (j == x) ? c : mine; }
        if (sum == G) break;
        __builtin_amdgcn_s_sleep(1);
        if ((++sp & 255u) == 0u) { if (xb_ld(&bar[XB_TMO])) break; if (sp > XB_SPIN_CAP) { atomicAdd(&bar[XB_TMO], 1u); break; } }
    }
    nloc = mine > 0u ? mine : 1u; nx = cnt > 0u ? cnt : 1u;
}
__device__ __forceinline__ void xcd_barrier(const XcdBarrier& b) {
    asm volatile("s_waitcnt vmcnt(0)" ::: "memory");
    __syncthreads();
    if (threadIdx.x == 0) {
        unsigned* bar = b.bar;
        __builtin_amdgcn_s_waitcnt(0);
        unsigned nloc = b.st[0], nx = b.st[1];
        if (nloc == 0u) { xcd_barrier_complete(bar, b.x, nloc, nx); b.st[0] = nloc; b.st[1] = nx; }
        const unsigned old = xb_add(&bar[XB_XSUB(b.x)], 1u);
        const unsigned gen = old / nloc;
        if (old + 1u == (gen + 1u) * nloc) {
            __builtin_amdgcn_fence(__ATOMIC_RELEASE, "agent");
            asm volatile("s_waitcnt vmcnt(0)" ::: "memory");
            const unsigned og = xb_add(&bar[XB_TOP], 1u);
            const unsigned tg = og / nx;
            if (og + 1u == (tg + 1u) * nx) xb_add(&bar[XB_TOPGEN], 1u);
            else XB_SPIN(xb_ld(&bar[XB_TOPGEN]) == tg, bar);
            __builtin_amdgcn_fence(__ATOMIC_ACQUIRE, "agent");
            xb_add(&bar[XB_XGEN(b.x)], 1u);
            asm volatile("s_waitcnt vmcnt(0)" ::: "memory");
        } else {
            XB_SPIN(xb_ld(&bar[XB_XGEN(b.x)]) == gen, bar);
            __builtin_amdgcn_fence(__ATOMIC_ACQUIRE, "agent");
            asm volatile("s_waitcnt vmcnt(0)" ::: "memory");
        }
    }
    __syncthreads();
}

__device__ __forceinline__ void xcd_local_sync(const XcdBarrier& b, unsigned k) {
    __syncthreads();
    if (threadIdx.x == 0) {
        unsigned* c = b.bar + (8192 - 4096) + 64 * b.x;
        const unsigned nloc = b.st[0];
        (void)xb_add(c, 1u);
        const unsigned target = k * nloc;
        XB_SPIN(xb_ld(c) < target, b.bar);
    }
    __syncthreads();
}

struct Params {
    const float *x, *ln1_g, *w_in, *conv_w, *a_log, *dt_bias, *gdn_norm_g, *q_norm_g, *kv_norm_g, *w_q_up, *w_qidx_up, *w_kv_up,
                *idx_ln_g, *idx_ln_b, *w_out, *ln2_g, *peer_wq, *peer_k1, *peer_k2, *peer_u, *peer_v, *rel_bias, *final_g;
    float* out; unsigned char* ws;
};

namespace pg8 {
#define PG8_LAS __attribute__((address_space(3)))
typedef unsigned short bf16_t;
typedef short bf16x8 __attribute__((ext_vector_type(8)));
typedef float f32x4 __attribute__((ext_vector_type(4)));
typedef unsigned u32x4 __attribute__((ext_vector_type(4)));
constexpr int BM = 256, BK = 64, HALF = 128, HTB = HALF * BK * 2  , STAGE_BYTES = 8 * HTB, NXCD = 8, WGM = 8;

__host__ __device__ __forceinline__ int lds_byte(int r, int c) { const int st = (r >> 4) * 2 + (c >> 5), rr = r & 15, cc = c & 31, ob = rr * 64 + cc * 2; return st * 1024 + (ob ^ (((ob >> 9) & 1) << 5)); }
__host__ __device__ __forceinline__ void stage_rc(int b, int& R, int& C) { const int st = b / 1024, sb = b % 1024, swz = sb ^ (((sb >> 9) & 1) << 5); R = (st >> 1) * 16 + swz / 64; C = (st & 1) * 32 + (swz % 64) / 2; }
__host__ __device__ __forceinline__ int perm32(int rho) { const int n = rho >> 4, i = rho & 15; return 8 * (i >> 2) + 4 * n + (i & 3); }

struct Unit { int pm, pn; };
struct Gemm { const bf16_t* A; const bf16_t* Bt; int M, N, K; };

struct StaticOrder {
    int nM, nN, nwg, G, c;
    __host__ __device__ void init(int M, int N, int G_, int c_) { nM = M / BM; nN = N / BM; nwg = nM * nN; G = G_; c = c_; }
    __host__ __device__ bool next(int i, Unit& u) const {
        const long L = (long)i * G + c; if (L >= nwg) return false;
        int wgid = (int)L; { const int q = nwg / NXCD, r = nwg % NXCD, xcd = wgid % NXCD, off = wgid / NXCD; wgid = (xcd < r ? xcd * (q + 1) : r * (q + 1) + (xcd - r) * q) + off; }
        const int nig = WGM * nN, gid = wgid / nig, fm = gid * WGM, gsz = (nM - fm) < WGM ? (nM - fm) : WGM;
        u.pm = fm + ((wgid % nig) % gsz); u.pn = (wgid % nig) / gsz; return true;
    }
    __device__ __forceinline__ void a_ready(const Unit&) const {}
    __device__ __forceinline__ void done(const Unit&) const {}
};
template <class Epi, class Sched, bool STAMP = false>
__device__ __forceinline__ void gemm_phase(PG8_LAS unsigned char* lds, const Gemm g, const Sched& S, const Epi& E, unsigned long long* stamps) {
    int tid_o = threadIdx.x; asm volatile("" : "+v"(tid_o));
    const int tid = tid_o, wid = __builtin_amdgcn_readfirstlane(tid >> 6), lane = tid & 63, wr = wid >> 2, wc = wid & 3, fr = lane & 15, fq = lane >> 4;
    const int K = g.K, nt = K / BK;
    int ts_lo = 0, ts_hi = 0, nts = 0; const unsigned long long rt_entry = STAMP ? (unsigned long long)wall_clock64() : 0ull;
#define PG8_STAMP() do { if (STAMP && wid == 0 && nts < 64) { const unsigned long long _c = (unsigned long long)clock64(); \
        ts_lo = (lane == nts) ? (int)(unsigned)_c : ts_lo; ts_hi = (lane == nts) ? (int)(unsigned)(_c >> 32) : ts_hi; ++nts; } } while (0)
    PG8_STAMP();
    unsigned voffA[2], voffB[2];
#pragma unroll
    for (int i = 0; i < 2; ++i) { int R, C; stage_rc(tid * 16 + i * 8192, R, C); const int Rb = Epi::PERM ? ((R & ~31) + perm32(R & 31)) : R;
        voffA[i] = (unsigned)(R * K + C) * 2u; voffB[i] = (unsigned)(Rb * K + C) * 2u; }
    const size_t kstep = (size_t)(BK * 2);
    const size_t hstep = (size_t)HALF * K * 2;
    const size_t tstep = 2 * hstep;
    const unsigned ldsw = (unsigned)wid * 1024u;
    const int aoff = lds_byte(wr * 64 + fr, fq * 8), boff = lds_byte(wc * 32 + fr, fq * 8);
#define PG8_SA(b, h) (((b) * 2 + (h)) * HTB)
#define PG8_SB(b, h) ((4 + (b) * 2 + (h)) * HTB)
#define PG8_STAGE(bufoff, gbase, voff) do { _Pragma("unroll") for (int _i = 0; _i < 2; ++_i) \
        __builtin_amdgcn_global_load_lds((const unsigned*)((const char*)(gbase) + (voff)[_i]), (PG8_LAS unsigned*)(lds + (bufoff) + ldsw + _i * 8192), 16, 0, 0); } while (0)
#define PG8_LDA(dst, b, h) do { _Pragma("unroll") for (int m = 0; m < 4; ++m) _Pragma("unroll") for (int k = 0; k < 2; ++k) dst[m][k] = *(const PG8_LAS bf16x8*)(lds + PG8_SA(b, h) + aoff + m * 2048 + k * 1024); } while (0)
#define PG8_LDB(dst, b, h) do { _Pragma("unroll") for (int n = 0; n < 2; ++n) _Pragma("unroll") for (int k = 0; k < 2; ++k) dst[n][k] = *(const PG8_LAS bf16x8*)(lds + PG8_SB(b, h) + boff + n * 2048 + k * 1024); } while (0)
#define PG8_MMA(ai, bj, At, Bt) do { __builtin_amdgcn_s_setprio(1); _Pragma("unroll") for (int m = 0; m < 4; ++m) _Pragma("unroll") for (int n = 0; n < 2; ++n) _Pragma("unroll") for (int k = 0; k < 2; ++k) \
        acc[ai][bj][m][n] = __builtin_amdgcn_mfma_f32_16x16x32_bf16(Bt[n][k], At[m][k], acc[ai][bj][m][n], 0, 0, 0); __builtin_amdgcn_s_setprio(0); } while (0)
#define PG8_WAIT_V(n) asm volatile("s_waitcnt vmcnt(" #n ")" ::: "memory")
#define PG8_WAIT_L(n) asm volatile("s_waitcnt lgkmcnt(" #n ")" ::: "memory")
#define PG8_BAR __builtin_amdgcn_s_barrier()
#define PG8_SCHED __builtin_amdgcn_sched_barrier(0)
    Unit cur, nxt; int ui = 0;
    if (!S.next(0, cur)) return;
    f32x4 acc[2][2][4][2];
#pragma unroll
    for (int a = 0; a < 2; ++a)
#pragma unroll
        for (int b = 0; b < 2; ++b)
#pragma unroll
            for (int m = 0; m < 4; ++m)
#pragma unroll
                for (int n = 0; n < 2; ++n) acc[a][b][m][n] = (f32x4){0.f, 0.f, 0.f, 0.f};
    bf16x8 At[4][2], B0[2][2], B1[2][2];
    const char* cA = (const char*)g.A + (size_t)cur.pm * tstep; const char* cB = (const char*)g.Bt + (size_t)cur.pn * tstep;
    S.a_ready(cur);
    PG8_STAGE(PG8_SB(0, 0), cB, voffB); PG8_STAGE(PG8_SA(0, 0), cA, voffA); PG8_STAGE(PG8_SB(0, 1), cB + hstep, voffB); PG8_STAGE(PG8_SA(0, 1), cA + hstep, voffA);
    if (wr == 1) PG8_BAR;
    PG8_WAIT_V(4); PG8_BAR;
    PG8_STAGE(PG8_SB(1, 0), cB + kstep, voffB); PG8_STAGE(PG8_SA(1, 0), cA + kstep, voffA); PG8_STAGE(PG8_SB(1, 1), cB + hstep + kstep, voffB);
    PG8_WAIT_V(6); PG8_BAR;
    PG8_STAMP();
    for (;;) {
        const bool has_next = S.next(ui + 1, nxt);
        const char* nA = has_next ? (const char*)g.A + (size_t)nxt.pm * tstep : cA; const char* nB = has_next ? (const char*)g.Bt + (size_t)nxt.pn * tstep : cB;
        for (int t = 0; t < nt; t += 2) {
            const bool last = (t == nt - 2);
            const char* a1 = cA + (size_t)(t + 1) * kstep;
            const char* a2 = last ? nA : cA + (size_t)(t + 2) * kstep; const char* b2 = last ? nB : cB + (size_t)(t + 2) * kstep;
            const char* a3 = a2 + kstep; const char* b3 = b2 + kstep;
            if (last && has_next) S.a_ready(nxt);
            PG8_LDB(B0, 0, 0); PG8_SCHED; PG8_LDA(At, 0, 0); PG8_STAGE(PG8_SA(1, 1), a1 + hstep, voffA);
            PG8_WAIT_L(8); PG8_BAR; PG8_WAIT_L(0); PG8_MMA(0, 0, At, B0); PG8_BAR; PG8_SCHED;
            PG8_LDB(B1, 0, 1); PG8_STAGE(PG8_SB(0, 0), b2, voffB);
            PG8_BAR; PG8_WAIT_L(0); PG8_MMA(0, 1, At, B1); PG8_BAR;
            PG8_LDA(At, 0, 1); PG8_STAGE(PG8_SA(0, 0), a2, voffA);
            PG8_BAR; PG8_WAIT_L(0); PG8_MMA(1, 0, At, B0); PG8_BAR; PG8_SCHED;
            PG8_STAGE(PG8_SB(0, 1), b2 + hstep, voffB);
            PG8_WAIT_V(6); PG8_BAR; PG8_MMA(1, 1, At, B1); PG8_BAR;
            PG8_LDB(B0, 1, 0); PG8_SCHED; PG8_LDA(At, 1, 0); PG8_STAGE(PG8_SA(0, 1), a2 + hstep, voffA);
            PG8_WAIT_L(8); PG8_BAR; PG8_WAIT_L(0); PG8_MMA(0, 0, At, B0); PG8_BAR; PG8_SCHED;
            PG8_LDB(B1, 1, 1); PG8_STAGE(PG8_SB(1, 0), b3, voffB);
            PG8_BAR; PG8_WAIT_L(0); PG8_MMA(0, 1, At, B1); PG8_BAR;
            PG8_LDA(At, 1, 1); PG8_STAGE(PG8_SA(1, 0), a3, voffA);
            PG8_BAR; PG8_WAIT_L(0); PG8_MMA(1, 0, At, B0); PG8_BAR; PG8_SCHED;
            PG8_STAGE(PG8_SB(1, 1), b3 + hstep, voffB);
            PG8_WAIT_V(6); PG8_BAR; PG8_MMA(1, 1, At, B1); PG8_BAR;
        }
        PG8_STAMP();
        if constexpr (!Epi::AFTER_DRAIN) { E(acc, cur, wr, wc, fr, fq); S.done(cur); }
        PG8_STAMP();
        if (!has_next) break;
#pragma unroll
        for (int a = 0; a < 2; ++a)
#pragma unroll
            for (int b = 0; b < 2; ++b)
#pragma unroll
                for (int m = 0; m < 4; ++m)
#pragma unroll
                    for (int n = 0; n < 2; ++n) acc[a][b][m][n] = (f32x4){0.f, 0.f, 0.f, 0.f};
        cur = nxt; cA = nA; cB = nB; ++ui;
    }
    PG8_WAIT_V(0);
    if (wr == 0) PG8_BAR;
    PG8_BAR;
    if constexpr (Epi::AFTER_DRAIN) { E.fused(acc, cur, wr, wc, fr, fq, lds, wid, lane); S.done(cur); }
    PG8_STAMP();
    if (STAMP && wid == 0) { stamps[lane] = lane < nts ? (((unsigned long long)(unsigned)ts_hi << 32) | (unsigned)ts_lo) : 0ull;
        if (lane == 62) stamps[62] = rt_entry; if (lane == 63) stamps[63] = (unsigned long long)wall_clock64(); }
#undef PG8_STAMP
#undef PG8_SA
#undef PG8_SB
#undef PG8_STAGE
#undef PG8_LDA
#undef PG8_LDB
#undef PG8_MMA
#undef PG8_WAIT_V
#undef PG8_WAIT_L
#undef PG8_BAR
#undef PG8_SCHED
}
}
__device__ __forceinline__ int in_src_col(int n) {
    if (n < 2048) return n;
    if (n < 2304) return 2056 + (n - 2048);
    if (n < 2560) return 2312 + (n - 2304);
    if (n < 2624) return 2568 + (n - 2560);
    if (n < 2640) return 2632 + (n - 2624);
    if (n < 2644) return 2048 + (n - 2640);
    if (n < 2648) return 2052 + (n - 2644);
    return -1;
}
__device__ __forceinline__ void tr_item(const float* W, int ldw, int srccol, bf16_t* WT, int ldt, int n0, int k0, LAS float* scr, int lane) {
    float tv[32];
#pragma unroll
    for (int i = 0; i < 32; ++i) { const int kk = 2 * i + (lane >> 5); tv[i] = (srccol >= 0) ? W[(size_t)(k0 + kk) * ldw + srccol] : 0.f; }
#pragma unroll
    for (int i = 0; i < 32; ++i) { const int kk = 2 * i + (lane >> 5); scr[kk * 33 + (lane & 31)] = tv[i]; }
    LDS_WAIT(); asm volatile("" ::: "memory");
    const int c = lane & 7;
#pragma unroll
    for (int j = 0; j < 4; ++j) { const int n = (lane >> 3) + 8 * j; const LAS float* s = scr + (8 * c) * 33 + n;
        u32x4 o; o.x = cvt_pk_bf16(s[0 * 33], s[1 * 33]); o.y = cvt_pk_bf16(s[2 * 33], s[3 * 33]); o.z = cvt_pk_bf16(s[4 * 33], s[5 * 33]); o.w = cvt_pk_bf16(s[6 * 33], s[7 * 33]);
        *(u32x4*)(WT + (size_t)(n0 + n) * ldt + k0 + 8 * c) = o; }
    LDS_WAIT(); asm volatile("" ::: "memory");
}
__device__ __forceinline__ void fold_stage_b(const float* B, int ldb, int hf, LAS float* sb, int lane) {
#pragma unroll
    for (int i = 0; i < 4; ++i) { const int e = lane + 64 * i, nn = e >> 4, j = e & 15; const f32x4 t = *(const f32x4*)(B + (size_t)nn * ldb + 64 * hf + 4 * j); *(LAS f32x4*)(sb + nn * 64 + 4 * j) = t; }
}
__device__ __forceinline__ void fold_nt(const float* A, int lda, const float* B, int ldb, bf16_t* O, int ldo, float sc, LAS float* scr, int lane) {
#pragma unroll 1
    for (int hf = 0; hf < 2; ++hf) {
        f32x2 a[32];
        const f32x4* ap = (const f32x4*)(A + (size_t)lane * lda + 64 * hf);
        fold_stage_b(B, ldb, hf, scr + 1088, lane);
#pragma unroll
        for (int i = 0; i < 16; ++i) { const f32x4 t = ap[i]; a[2 * i] = f32x2{t[0], t[1]}; a[2 * i + 1] = f32x2{t[2], t[3]}; }
        LDS_WAIT(); asm volatile("" ::: "memory");
#pragma unroll 2
        for (int nn = 0; nn < 16; ++nn) {
            const LAS f32x2* bp = (const LAS f32x2*)(scr + 1088 + nn * 64);
            f32x2 t0 = {0.f, 0.f}, t1 = {0.f, 0.f};
#pragma unroll
            for (int d = 0; d < 32; d += 2) { t0 = __builtin_elementwise_fma(a[d], bp[d], t0); t1 = __builtin_elementwise_fma(a[d + 1], bp[d + 1], t1); }
            const float r = (t0[0] + t0[1]) + (t1[0] + t1[1]);
            if (hf == 0) scr[lane * 17 + nn] = r;
            else O[(size_t)nn * ldo + lane] = f2bf((r + scr[lane * 17 + nn]) * sc);
        }
        LDS_WAIT(); asm volatile("" ::: "memory");
    }
}
__device__ __forceinline__ void fold_vo(const float* wo, const float* wv, bf16_t* O, int ldo, LAS float* scr, int lane) {
#pragma unroll 1
    for (int hf = 0; hf < 2; ++hf) {
        f32x2 a[32];
        fold_stage_b(wv, 1024, hf, scr + 1088, lane);
#pragma unroll
        for (int d = 0; d < 32; ++d) a[d] = f32x2{wo[(size_t)(64 * hf + 2 * d) * 1024 + lane], wo[(size_t)(64 * hf + 2 * d + 1) * 1024 + lane]};
        LDS_WAIT(); asm volatile("" ::: "memory");
#pragma unroll 2
        for (int nn = 0; nn < 16; ++nn) {
            const LAS f32x2* bp = (const LAS f32x2*)(scr + 1088 + nn * 64);
            f32x2 t0 = {0.f, 0.f}, t1 = {0.f, 0.f};
#pragma unroll
            for (int d = 0; d < 32; d += 2) { t0 = __builtin_elementwise_fma(a[d], bp[d], t0); t1 = __builtin_elementwise_fma(a[d + 1], bp[d + 1], t1); }
            const float r = (t0[0] + t0[1]) + (t1[0] + t1[1]);
            scr[lane * 17 + nn] = (hf == 0) ? r : r + scr[lane * 17 + nn];
        }
        LDS_WAIT(); asm volatile("" ::: "memory");
    }
    const LAS float* sp = scr + lane * 17;
    u32x4 o0, o1; o0.x = cvt_pk_bf16(sp[0], sp[1]); o0.y = cvt_pk_bf16(sp[2], sp[3]); o0.z = cvt_pk_bf16(sp[4], sp[5]); o0.w = cvt_pk_bf16(sp[6], sp[7]);
    o1.x = cvt_pk_bf16(sp[8], sp[9]); o1.y = cvt_pk_bf16(sp[10], sp[11]); o1.z = cvt_pk_bf16(sp[12], sp[13]); o1.w = cvt_pk_bf16(sp[14], sp[15]);
    u32x4* op = (u32x4*)(O + (size_t)lane * ldo); op[0] = o0; op[1] = o1;
    LDS_WAIT(); asm volatile("" ::: "memory");
}
__device__ __forceinline__ void p0_prologue(const Params& p, LAS unsigned char* lds, int gw, int ngw, int wave, int lane) {
    unsigned char* ws = p.ws;
    LAS float* scr = (LAS float*)(lds + wave * 8448);
    bf16_t* WINT = (bf16_t*)(ws + WS_WINT); bf16_t* WQ2T = (bf16_t*)(ws + WS_WQ2T); bf16_t* WO2T = (bf16_t*)(ws + WS_WOUT2T); bf16_t* WQST = (bf16_t*)(ws + WS_WQST);
    constexpr int I_IN = 16 * 88, I_QI = 4 * 32, I_WO = 8 * 32, F_QK = 256, F_QS = 2048, F_VO = 1024;
    constexpr int NITEMS = I_IN + I_QI + I_WO + F_QK + F_QS + F_VO;
    for (int it = gw; it < NITEMS; it += ngw) {
        int r = it;
        if (r < I_IN) { const int kb = r / 88, nb = r % 88; tr_item(p.w_in, IN_W, in_src_col(32 * nb + (lane & 31)), WINT, 1024, 32 * nb, 64 * kb, scr, lane); continue; } r -= I_IN;
        if (r < I_QI) { const int kb = r / 32, nb = r % 32; tr_item(p.w_qidx_up, 1024, 32 * nb + (lane & 31), WQ2T + (size_t)1024 * 256, 256, 32 * nb, 64 * kb, scr, lane); continue; } r -= I_QI;
        if (r < I_WO) { const int kb = r / 32, nb = r % 32; tr_item(p.w_out, 1024, 32 * nb + (lane & 31), WO2T, 1536, 32 * nb, 64 * kb, scr, lane); continue; } r -= I_WO;
        if (r < F_QK) {
            const int h = r >> 6, jt = (r >> 2) & 15, kt = r & 3;
            fold_nt(p.w_q_up + (size_t)(64 * kt) * 512 + h * 128, 512, p.w_kv_up + (size_t)(16 * jt) * 1024 + h * 256, 1024,
                    WQ2T + (size_t)(h * 256 + 16 * jt) * 256 + 64 * kt, 256, 0.08838834764831845f, scr, lane);
            continue; } r -= F_QK;
        if (r < F_QS) {
            const int hs = r >> 7, nt = (r >> 4) & 7, kt = r & 15; const int h = hs >> 1, side = hs & 1;
            const float* sk = (side ? p.peer_k2 : p.peer_k1) + (size_t)(h * 128 + 16 * nt) * 128;
            fold_nt(p.peer_wq + (size_t)(64 * kt) * 2048 + hs * 128, 2048, sk, 128, WQST + (size_t)(hs * 128 + 16 * nt) * 1024 + 64 * kt, 1024, p.ln2_g[64 * kt + lane], scr, lane);
            continue; } r -= F_QS;
        {
            const int h = r >> 8, jt = (r >> 4) & 15, nt = r & 15;
            fold_vo(p.w_out + (size_t)(512 + h * 128) * 1024 + 64 * nt, p.w_kv_up + (size_t)(16 * jt) * 1024 + h * 256 + 128, WO2T + (size_t)(64 * nt) * 1536 + 512 + h * 256 + 16 * jt, 1536, scr, lane);
        }
    }
    bf16_t* HB = (bf16_t*)(ws + WS_HB);
    {
        const f32x4* gr = (const f32x4*)p.ln1_g + lane; f32x4 gv[4];
#pragma unroll
        for (int j = 0; j < 4; ++j) gv[j] = gr[64 * j];
        for (int m4 = 4 * gw; m4 < MT; m4 += 4 * ngw) {
            f32x4 v[4][4];
#pragma unroll
            for (int r = 0; r < 4; ++r) { const f32x4* xr = (const f32x4*)(p.x + (size_t)(m4 + r) * DM) + lane;
#pragma unroll
                for (int j = 0; j < 4; ++j) v[r][j] = xr[64 * j]; }
#pragma unroll
            for (int r = 0; r < 4; ++r) { float s2 = 0.f;
#pragma unroll
                for (int j = 0; j < 4; ++j) s2 += (v[r][j][0] * v[r][j][0] + v[r][j][1] * v[r][j][1]) + (v[r][j][2] * v[r][j][2] + v[r][j][3] * v[r][j][3]);
                const float rstd = rsqrtf(wave_sum(s2) * (1.f / DM) + EPS);
                u32x2* o8 = (u32x2*)(HB + (size_t)(m4 + r) * DM) + lane;
#pragma unroll
                for (int j = 0; j < 4; ++j) { const f32x4 g4 = gv[j]; u32x2 w; w.x = cvt_pk_bf16(v[r][j][0] * rstd * g4[0], v[r][j][1] * rstd * g4[1]); w.y = cvt_pk_bf16(v[r][j][2] * rstd * g4[2], v[r][j][3] * rstd * g4[3]); o8[64 * j] = w; } }
        }
    }
}

struct EpiIn {
    static constexpr bool PERM = true, AFTER_DRAIN = false;
    unsigned char* ws;
    __device__ __forceinline__ void operator()(const f32x4 (&acc)[2][2][4][2], const pg8::Unit& u, int wr, int wc, int fr, int fq) const {
        const int row0 = u.pm * 256 + wr * 64 + fr, cl0 = wc * 32 + 8 * fq, pn = u.pn;
        if (pn < 10) {
            bf16_t* base; int ld;
            if (pn < 6) { base = (bf16_t*)(ws + WS_QKV) + pn * 256; ld = 1536; }
            else if (pn < 8) { base = (bf16_t*)(ws + WS_ZB) + (pn - 6) * 256; ld = 512; }
            else if (pn == 8) { base = (bf16_t*)(ws + WS_CQ); ld = 256; }
            else { base = (bf16_t*)(ws + WS_CKV); ld = 256; }
#pragma unroll
            for (int ai = 0; ai < 2; ++ai)
#pragma unroll
                for (int m = 0; m < 4; ++m) { bf16_t* rowp = base + (size_t)(row0 + ai * 128 + m * 16) * ld + cl0;
#pragma unroll
                    for (int bj = 0; bj < 2; ++bj)
                        { const f32x4 v0 = acc[ai][bj][m][0], v1 = acc[ai][bj][m][1]; u32x4 w; w.x = cvt_pk_bf16(v0[0], v0[1]); w.y = cvt_pk_bf16(v0[2], v0[3]); w.z = cvt_pk_bf16(v1[0], v1[1]); w.w = cvt_pk_bf16(v1[2], v1[3]); *(u32x4*)(rowp + bj * 128) = w; }
                    asm volatile("" ::: "memory"); }
        } else {
            float* base = (float*)(ws + WS_MISC);
#pragma unroll
            for (int ai = 0; ai < 2; ++ai)
#pragma unroll
                for (int m = 0; m < 4; ++m) { float* rowp = base + (size_t)(row0 + ai * 128 + m * 16) * 128 + cl0;
#pragma unroll
                    for (int n = 0; n < 2; ++n) *(f32x4*)(rowp + n * 4) = acc[ai][0][m][n]; }
        }
    }
};
struct EpiQ {
    static constexpr bool PERM = true, AFTER_DRAIN = false;
    unsigned char* ws;
    __device__ __forceinline__ void operator()(const f32x4 (&acc)[2][2][4][2], const pg8::Unit& u, int wr, int wc, int fr, int fq) const {
        const int row0 = u.pm * 256 + wr * 64 + fr, cl0 = wc * 32 + 8 * fq, pn = u.pn;
        bf16_t* base; int ld;
        if (pn < 4) { base = (bf16_t*)(ws + WS_AOUT) + 512 + pn * 256; ld = 1536; } else { base = (bf16_t*)(ws + WS_QIDX) + (pn - 4) * 256; ld = 1024; }
#pragma unroll
        for (int ai = 0; ai < 2; ++ai)
#pragma unroll
            for (int m = 0; m < 4; ++m) { bf16_t* rowp = base + (size_t)(row0 + ai * 128 + m * 16) * ld + cl0;
#pragma unroll
                for (int bj = 0; bj < 2; ++bj)
                    { const f32x4 v0 = acc[ai][bj][m][0], v1 = acc[ai][bj][m][1]; u32x4 w; w.x = cvt_pk_bf16(v0[0], v0[1]); w.y = cvt_pk_bf16(v0[2], v0[3]); w.z = cvt_pk_bf16(v1[0], v1[1]); w.w = cvt_pk_bf16(v1[2], v1[3]); *(u32x4*)(rowp + bj * 128) = w; }
                asm volatile("" ::: "memory"); }
    }
};
struct EpiOut {
    static constexpr bool PERM = true, AFTER_DRAIN = false;
    const float* x; bf16_t* x1b; float* rss;
    __device__ __forceinline__ void operator()(const f32x4 (&acc)[2][2][4][2], const pg8::Unit& u, int wr, int wc, int fr, int fq) const {
        const int row0 = u.pm * 256 + wr * 64 + fr, col0 = u.pn * 256 + wc * 32 + 8 * fq;
        f32x4 xv[8][4];
        { const size_t off = (size_t)row0 * DM + col0; xv[0][0] = *(const f32x4*)(x + off); xv[0][1] = *(const f32x4*)(x + off + 4); xv[0][2] = *(const f32x4*)(x + off + 128); xv[0][3] = *(const f32x4*)(x + off + 132); }
#pragma unroll
        for (int it = 0; it < 8; ++it) { const int ai = it >> 2, m = it & 3; const int row = row0 + ai * 128 + m * 16; const size_t off = (size_t)row * DM + col0; float ss = 0.f;
                if (it < 7) { const int nrow = row0 + ((it + 1) >> 2) * 128 + ((it + 1) & 3) * 16; const size_t noff = (size_t)nrow * DM + col0;
                    xv[it + 1][0] = *(const f32x4*)(x + noff); xv[it + 1][1] = *(const f32x4*)(x + noff + 4); xv[it + 1][2] = *(const f32x4*)(x + noff + 128); xv[it + 1][3] = *(const f32x4*)(x + noff + 132); }
#pragma unroll
                for (int bj = 0; bj < 2; ++bj) { const f32x4 v0 = acc[ai][bj][m][0] + xv[it][2 * bj], v1 = acc[ai][bj][m][1] + xv[it][2 * bj + 1];
                        u32x4 w; w.x = cvt_pk_bf16(v0[0], v0[1]); w.y = cvt_pk_bf16(v0[2], v0[3]); w.z = cvt_pk_bf16(v1[0], v1[1]); w.w = cvt_pk_bf16(v1[2], v1[3]); *(u32x4*)(x1b + off + bj * 128) = w;
                        ss += ((v0[0] * v0[0] + v0[1] * v0[1]) + (v0[2] * v0[2] + v0[3] * v0[3])) + ((v1[0] * v1[0] + v1[1] * v1[1]) + (v1[2] * v1[2] + v1[3] * v1[3])); }
                ss += __shfl_xor(ss, 16); ss += __shfl_xor(ss, 32);
                if (fq == 0) __hip_atomic_fetch_add(rss + row, ss, __ATOMIC_RELAXED, __HIP_MEMORY_SCOPE_AGENT);
                asm volatile("" ::: "memory"); }
    }
};
struct EpiS {
    static constexpr bool PERM = true, AFTER_DRAIN = false;
    _Float16* S; const float* rss;
    __device__ __forceinline__ void operator()(const f32x4 (&acc)[2][2][4][2], const pg8::Unit& u, int wr, int wc, int fr, int fq) const {
        const int row0 = u.pm * 256 + wr * 64 + fr, col0 = u.pn * 256 + wc * 32 + 8 * fq;
#pragma unroll
        for (int ai = 0; ai < 2; ++ai)
#pragma unroll
            for (int m = 0; m < 4; ++m) { const int row = row0 + ai * 128 + m * 16; const float rs = rsqrtf(rss[row] * (1.f / DM) + EPS); _Float16* rowp = S + (size_t)row * 2048 + col0;
#pragma unroll
                for (int bj = 0; bj < 2; ++bj) { const f32x4 v0 = acc[ai][bj][m][0] * rs, v1 = acc[ai][bj][m][1] * rs; u32x4 w; w.x = __builtin_bit_cast(unsigned, (h2_t){(_Float16)v0[0], (_Float16)v0[1]}); w.y = __builtin_bit_cast(unsigned, (h2_t){(_Float16)v0[2], (_Float16)v0[3]});
                    w.z = __builtin_bit_cast(unsigned, (h2_t){(_Float16)v1[0], (_Float16)v1[1]}); w.w = __builtin_bit_cast(unsigned, (h2_t){(_Float16)v1[2], (_Float16)v1[3]}); *(u32x4*)(rowp + bj * 128) = w; } }
    }
};

struct P3C { f32x4 qg, kg; float lg, lb, dtb, alog; };
struct P3In { u32x2 cq, ck; float mk, mw, ma, mb; };
__device__ __forceinline__ void p3_consts(const Params& p, P3C& c, int lane) {
    c.qg = ((const f32x4*)p.q_norm_g)[lane]; c.kg = ((const f32x4*)p.kv_norm_g)[lane]; c.lg = p.idx_ln_g[lane]; c.lb = p.idx_ln_b[lane]; c.dtb = p.dt_bias[lane & 3]; c.alog = p.a_log[lane & 3];
}
__device__ __forceinline__ void p3_load(const Params& p, P3In& in, int m, int lane) {
    unsigned char* ws = p.ws; const float* misc = (const float*)(ws + WS_MISC) + (size_t)m * 128;
    in.cq = ((const u32x2*)((const bf16_t*)(ws + WS_CQ) + (size_t)m * 256))[lane]; in.ck = ((const u32x2*)((const bf16_t*)(ws + WS_CKV) + (size_t)m * 256))[lane];
    in.mk = misc[lane]; in.mw = misc[64 + (lane & 15)]; in.ma = misc[80 + (lane & 3)]; in.mb = misc[84 + (lane & 3)];
}
__device__ __forceinline__ void p3_token(const Params& p, const LAS float* cw, const P3C& c, const P3In& in, int m, int lane, const u32x4 (&x0)[3], const u32x4 (&x1)[3], const u32x4 (&x2)[3], const u32x4 (&x3)[3]) {
    unsigned char* ws = p.ws;
    const int b = m >> 13, t = m & (SEQ - 1);
#pragma unroll
    for (int i = 0; i < 3; ++i) {
        const int piece = lane + 64 * i, hv = piece >> 4;
        float y[8];
#pragma unroll
        for (int e = 0; e < 8; ++e) y[e] = 0.f;
#pragma unroll
        for (int jj = 0; jj < 4; ++jj) { const f32x4 w0 = *(const LAS f32x4*)(cw + jj * 1536 + 8 * piece), w1 = *(const LAS f32x4*)(cw + jj * 1536 + 8 * piece + 4); const u32x4 v = (jj == 0) ? x0[i] : (jj == 1) ? x1[i] : (jj == 2) ? x2[i] : x3[i];
            y[0] = fmaf(w0[0], bf_lo(v.x), y[0]); y[1] = fmaf(w0[1], bf_hi(v.x), y[1]); y[2] = fmaf(w0[2], bf_lo(v.y), y[2]); y[3] = fmaf(w0[3], bf_hi(v.y), y[3]);
            y[4] = fmaf(w1[0], bf_lo(v.z), y[4]); y[5] = fmaf(w1[1], bf_hi(v.z), y[5]); y[6] = fmaf(w1[2], bf_lo(v.w), y[6]); y[7] = fmaf(w1[3], bf_hi(v.w), y[7]); }
        float ss = 0.f;
#pragma unroll
        for (int e = 0; e < 8; ++e) { y[e] = silu_f(y[e]); ss = fmaf(y[e], y[e], ss); }
        ss = row16_sum(ss);
        float r = 1.f;
        if (i < 2) { r = rsqrtf(ss + EPS); if (i == 0) r *= 0.08838834764831845f; }
        bf16_t* dst = (bf16_t*)(ws + (i == 0 ? WS_QH : (i == 1 ? WS_KH : WS_VH)));
        const int h = hv & 3;
        const size_t idx = ((((size_t)(b * 4 + h)) * NCHUNK + (t >> 6)) * 64 + (t & 63)) * 128 + 8 * (piece & 15);
        u32x4 o; o.x = cvt_pk_bf16(y[0] * r, y[1] * r); o.y = cvt_pk_bf16(y[2] * r, y[3] * r); o.z = cvt_pk_bf16(y[4] * r, y[5] * r); o.w = cvt_pk_bf16(y[6] * r, y[7] * r);
        *(u32x4*)(dst + idx) = o;
#ifdef PROBE_GDN
        if (b == 0 && t < 512 && (hv & 3) == 0) { float* rf = (float*)(ws + WS_REF) + ((size_t)i * 512 + t) * 128 + 8 * (piece & 15);
#pragma unroll
            for (int e = 0; e < 8; ++e) rf[e] = y[e] * r; }
#endif
    }
    if (lane < 4) {
        const float a = in.ma + c.dtb, bb = in.mb;
        const float ea = __expf(a), ua = 1.f + ea, da = ua - 1.f;
        const float sp = (a > 20.f) ? a : (da == 0.f ? ea : __logf(ua) * ea * __builtin_amdgcn_rcpf(da));
        ((float*)(ws + WS_GARR))[(size_t)(b * 4 + lane) * SEQ + t] = -__expf(c.alog) * sp;
        ((float*)(ws + WS_BARR))[(size_t)(b * 4 + lane) * SEQ + t] = __builtin_amdgcn_rcpf(1.f + __expf(-bb));
#ifdef PROBE_GDN
        if (b == 0 && lane == 0 && t < 512) { ((float*)(ws + WS_RES))[256 + t] = -__expf(p.a_log[0]) * sp; ((float*)(ws + WS_RES))[1024 + t] = 1.f / (1.f + __expf(-bb)); }
#endif
    }
    {
        u32x2* cq = (u32x2*)((bf16_t*)(ws + WS_CQ) + (size_t)m * 256) + lane; const u32x2 v = in.cq;
        float f0 = bf_lo(v.x), f1 = bf_hi(v.x), f2 = bf_lo(v.y), f3 = bf_hi(v.y);
        float rs = rsqrtf(wave_sum((f0 * f0 + f1 * f1) + (f2 * f2 + f3 * f3)) * (1.f / 256.f) + EPS);
        f32x4 g = c.qg; u32x2 w; w.x = cvt_pk_bf16(f0 * rs * g[0], f1 * rs * g[1]); w.y = cvt_pk_bf16(f2 * rs * g[2], f3 * rs * g[3]); *cq = w;
        const u32x2 v2 = in.ck;
        f0 = bf_lo(v2.x); f1 = bf_hi(v2.x); f2 = bf_lo(v2.y); f3 = bf_hi(v2.y);
        rs = rsqrtf(wave_sum((f0 * f0 + f1 * f1) + (f2 * f2 + f3 * f3)) * (1.f / 256.f) + EPS);
        g = c.kg;
        { int w8 = __builtin_amdgcn_cvt_pk_fp8_f32(f0 * rs * g[0], f1 * rs * g[1], 0, false); w8 = __builtin_amdgcn_cvt_pk_fp8_f32(f2 * rs * g[2], f3 * rs * g[3], w8, true); ((unsigned*)(ws + WS_CKV8))[(size_t)m * 64 + lane] = (unsigned)w8; }
    }
    {
        const float xk = in.mk; const float mu = wave_sum(xk) * (1.f / 64.f); const float d = xk - mu; const float var = wave_sum(d * d) * (1.f / 64.f);
        ((bf16_t*)(ws + WS_KIDXN))[(size_t)m * 64 + lane] = f2bf(d * rsqrtf(var + EPS) * c.lg + c.lb);
        if (lane < 16) ((float*)(ws + WS_WIDX))[(size_t)m * 16 + lane] = in.mw * (0.5f / 32.f);
    }
}

constexpr int G2_KL = 0, G2_QL = 17408, G2_VT = 34816, G2_KBT = 53248, G2_TL = 71680, G2_AM = 80896, G2_GC = 97280, G2_VT2 = 98304, G2_KBT2 = 116736, G2_TL2 = 135168, G2_TF = 144384;
__device__ __forceinline__ float bf_elem(const u32x4& v, int e) { const unsigned w = v[e >> 1]; return (e & 1) ? bf_hi(w) : bf_lo(w); }
struct G2In { u32x4 k[2], q[2], v[2]; float g, b; };
__device__ __forceinline__ void g2_load(const Params& p, G2In& in, int cb, int tid, int lane) {
    unsigned char* ws = p.ws;
    const u32x4* qB = (const u32x4*)((const bf16_t*)(ws + WS_QH) + (size_t)cb * 8192); const u32x4* kB = (const u32x4*)((const bf16_t*)(ws + WS_KH) + (size_t)cb * 8192); const u32x4* vB = (const u32x4*)((const bf16_t*)(ws + WS_VH) + (size_t)cb * 8192);
    const int bh = cb >> 7, c = cb & 127;
#pragma unroll
    for (int i = 0; i < 2; ++i) { const int piece = tid + 512 * i; in.k[i] = kB[piece]; in.q[i] = qB[piece]; in.v[i] = vB[piece]; }
    in.g = ((const float*)(ws + WS_GARR))[(size_t)bh * SEQ + c * 64 + lane]; in.b = ((const float*)(ws + WS_BARR))[(size_t)bh * SEQ + c * 64 + lane];
}
__device__ __forceinline__ void g2_chunk(const Params& p, LAS unsigned char* lds, int cb, int cb_next, G2In& in, int tid_in, int wave, int lane_in) {
    unsigned char* ws = p.ws;
    int tid = tid_in; asm volatile("" : "+v"(tid));
    const int lane = tid & 63; (void)lane_in;
    bf16_t* qB = (bf16_t*)(ws + WS_QH) + (size_t)cb * 8192; bf16_t* kB = (bf16_t*)(ws + WS_KH) + (size_t)cb * 8192; bf16_t* vB = (bf16_t*)(ws + WS_VH) + (size_t)cb * 8192;
    bf16_t* wB = (bf16_t*)(ws + WS_WBUF) + (size_t)cb * 8192; bf16_t* aB = (bf16_t*)(ws + WS_ATTN) + (size_t)cb * 4096;
    const int bh = cb >> 7, c = cb & 127;
    const float* gsrc = (const float*)(ws + WS_GARR) + (size_t)bh * SEQ + c * 64; const float* bsrc = (const float*)(ws + WS_BARR) + (size_t)bh * SEQ + c * 64;
    LAS bf16_t* KL = (LAS bf16_t*)(lds + G2_KL); LAS bf16_t* QL = (LAS bf16_t*)(lds + G2_QL); LAS bf16_t* VT = (LAS bf16_t*)(lds + G2_VT);
    LAS bf16_t* KBT = (LAS bf16_t*)(lds + G2_KBT); LAS bf16_t* TL = (LAS bf16_t*)(lds + G2_TL); LAS float* AM = (LAS float*)(lds + G2_AM);
    LAS float* GC = (LAS float*)(lds + G2_GC); LAS float* BT = GC + 64;
    const int g = lane >> 4, fr = lane & 15;
#ifdef PROBE_NAN
    unsigned pbad = 0u;
#define PCHK(idx, v) do { if (!(fabsf(v) < 1e30f)) pbad |= 1u << ((idx) - 30); } while (0)
#else
#define PCHK(idx, v) do {} while (0)
#endif
    u32x4 kp[2], qp[2], vp[2];
#pragma unroll
    for (int i = 0; i < 2; ++i) { kp[i] = in.k[i]; qp[i] = in.q[i]; vp[i] = in.v[i]; }
    if (wave == 0) {
        float gv = in.g;
#pragma unroll
        for (int o = 1; o < 64; o <<= 1) { const float t = __shfl_up(gv, o); if (lane >= o) gv += t; }
        GC[lane] = gv; BT[lane] = in.b;
    }
    __syncthreads();
#pragma unroll
    for (int i = 0; i < 2; ++i) { const int piece = tid + 512 * i, row = piece >> 4, ch = piece & 15;
        *(LAS u32x4*)(KL + row * 136 + ch * 8) = kp[i]; *(LAS u32x4*)(QL + row * 136 + ch * 8) = qp[i];
        const float bj = BT[row], be = bj * __expf(GC[row]);
#pragma unroll
        for (int e = 0; e < 8; ++e) { const float vv = bf_elem(vp[i], e) * bj, kk = bf_elem(kp[i], e) * be; const bf16_t vh = f2bf(vv), kh = f2bf(kk);
            VT[(ch * 8 + e) * 72 + row] = vh; KBT[(ch * 8 + e) * 72 + row] = kh; } }
    __syncthreads();
#pragma unroll
    for (int tt = 0; tt < 2; ++tt) { const int idx = wave + 8 * tt, ti = idx >> 2, tj = idx & 3;
        f32x4 accA = {0.f, 0.f, 0.f, 0.f}, accT = {0.f, 0.f, 0.f, 0.f};
        if (tj <= ti) {
#pragma unroll
            for (int s = 0; s < 4; ++s) { const bf16x8 ki = *(const LAS bf16x8*)(KL + (16 * ti + fr) * 136 + 32 * s + 8 * g), kj = *(const LAS bf16x8*)(KL + (16 * tj + fr) * 136 + 32 * s + 8 * g),
                                                       qi = *(const LAS bf16x8*)(QL + (16 * ti + fr) * 136 + 32 * s + 8 * g);
                accA = MFMA16(ki, kj, accA);
                accT = MFMA16(kj, qi, accT); }
        }
#pragma unroll
        for (int reg = 0; reg < 4; ++reg) { const int i = 16 * ti + 4 * g + reg, j = 16 * tj + fr;
            const float amv = (j < i) ? BT[i] * accA[reg] * __expf(GC[i] - GC[j]) : 0.f; AM[i * 64 + j] = amv; }
        { const int i = 16 * ti + fr; float v[4];
#pragma unroll
            for (int reg = 0; reg < 4; ++reg) { const int j = 16 * tj + 4 * g + reg; v[reg] = (j <= i) ? accT[reg] * __expf(GC[i] - GC[j]) : 0.f; }
            u32x2 w; w.x = cvt_pk_bf16(v[0], v[1]); w.y = cvt_pk_bf16(v[2], v[3]); *(u32x2*)(aB + i * 64 + 32 * (tj >> 1) + 8 * g + 4 * (tj & 1)) = w; }
    }
#pragma unroll
    for (int q = 0; q < 8; ++q) ((LAS float*)(lds + G2_TF))[tid + 512 * q] = 0.f;
    __syncthreads();
    LAS float* TF = (LAS float*)(lds + G2_TF); LAS float* XB = (LAS float*)(lds + G2_QL);
    if (wave == 0) {
        const int o = 16 * (lane >> 4), c = lane & 15;
        for (int i = 0; i < 16; ++i) { float acc = (i == c) ? 1.f : 0.f;
            for (int j = 0; j < i; ++j) acc = fmaf(-AM[(o + i) * 64 + o + j], TF[(o + j) * 64 + o + c], acc);
            TF[(o + i) * 64 + o + c] = acc; }
    } else {
        const int t2 = tid - 64; const float gl = GC[63];
        for (int piece = t2; piece < 1024; piece += 448) { const int row = piece >> 4, ch = piece & 15; const u32x4 v = *(const LAS u32x4*)(QL + row * 136 + ch * 8); const float e = __expf(GC[row]);
            u32x4 o; o.x = cvt_pk_bf16(bf_lo(v.x) * e, bf_hi(v.x) * e); o.y = cvt_pk_bf16(bf_lo(v.y) * e, bf_hi(v.y) * e); o.z = cvt_pk_bf16(bf_lo(v.z) * e, bf_hi(v.z) * e); o.w = cvt_pk_bf16(bf_lo(v.w) * e, bf_hi(v.w) * e);
            { const int kb = ch >> 2, u0 = 2 * (ch & 3), u1 = u0 + 1; bf16_t* rp = qB + row * 128 + 32 * kb;
              u32x2 lo2; lo2.x = o.x; lo2.y = o.y; u32x2 hi2; hi2.x = o.z; hi2.y = o.w;
              *(u32x2*)(rp + 4 * (2 * (u0 & 3) + (u0 >> 2))) = lo2; *(u32x2*)(rp + 4 * (2 * (u1 & 3) + (u1 >> 2))) = hi2; } }
        for (int piece = t2; piece < 1024; piece += 448) { const int d = piece >> 3, jc = piece & 7; float v[8];
#pragma unroll
            for (int e = 0; e < 8; ++e) { const int j = 8 * jc + e; v[e] = bf2f(KL[j * 136 + d]) * __expf(gl - GC[j]); }
            u32x4 o; o.x = cvt_pk_bf16(v[0], v[1]); o.y = cvt_pk_bf16(v[2], v[3]); o.z = cvt_pk_bf16(v[4], v[5]); o.w = cvt_pk_bf16(v[6], v[7]);
            { const int kb = jc >> 2, u0 = 2 * (jc & 3), u1 = u0 + 1; bf16_t* rp = kB + d * 64 + 32 * kb;
              u32x2 lo2; lo2.x = o.x; lo2.y = o.y; u32x2 hi2; hi2.x = o.z; hi2.y = o.w;
              *(u32x2*)(rp + 4 * (2 * (u0 & 3) + (u0 >> 2))) = lo2; *(u32x2*)(rp + 4 * (2 * (u1 & 3) + (u1 >> 2))) = hi2; } }
        if (t2 == 0) ((float*)(ws + WS_GAMMA))[cb] = __expf(gl);
    }
    __syncthreads();
    {
        const int pr = tid >> 8, r = (tid >> 4) & 15, c = tid & 15, o = 32 * pr; float x = 0.f;
#pragma unroll 4
        for (int k = 0; k < 16; ++k) x = fmaf(AM[(o + 16 + r) * 64 + o + k], TF[(o + k) * 64 + o + c], x);
        XB[tid] = x;
    }
    __syncthreads();
    {
        const int pr = tid >> 8, r = (tid >> 4) & 15, c = tid & 15, o = 32 * pr; float y = 0.f;
#pragma unroll 4
        for (int k = 0; k < 16; ++k) y = fmaf(TF[(o + 16 + r) * 64 + o + 16 + k], XB[pr * 256 + k * 16 + c], y);
        TF[(o + 16 + r) * 64 + o + c] = -y;
    }
    __syncthreads();
    {
        const int r = tid >> 4, c0 = (tid & 15) * 2; float x0 = 0.f, x1 = 0.f;
#pragma unroll 8
        for (int k = 0; k < 32; ++k) { const float a = AM[(32 + r) * 64 + k]; const f32x2 t = *(const LAS f32x2*)(TF + k * 64 + c0); x0 = fmaf(a, t[0], x0); x1 = fmaf(a, t[1], x1); }
        *(LAS f32x2*)(XB + r * 32 + c0) = (f32x2){x0, x1};
    }
    __syncthreads();
    {
        const int r = tid >> 4, c0 = (tid & 15) * 2; float x0 = 0.f, x1 = 0.f;
#pragma unroll 8
        for (int k = 0; k < 32; ++k) { const float a = TF[(32 + r) * 64 + 32 + k]; const f32x2 t = *(const LAS f32x2*)(XB + k * 32 + c0); x0 = fmaf(a, t[0], x0); x1 = fmaf(a, t[1], x1); }
        *(LAS f32x2*)(TF + (32 + r) * 64 + c0) = (f32x2){-x0, -x1};
    }
    __syncthreads();
#ifdef PROBE_GDN
    if (cb == 0) { float* dmp = (float*)(ws + 15 * MiB + 880000);
#pragma unroll 1
        for (int idx = tid; idx < 4096; idx += NTHR) { dmp[idx] = AM[idx]; dmp[4096 + idx] = TF[idx]; } }
#endif
#pragma unroll
    for (int q = 0; q < 8; ++q) { const int idx = tid + 512 * q, i = idx >> 6, j = idx & 63; TL[i * 72 + j] = f2bf(TF[idx]); }
    __syncthreads();
    if (cb_next < 16 * NCHUNK) g2_load(p, in, cb_next, tid, lane);
#pragma unroll
    for (int tt = 0; tt < 4; ++tt) { const int t = wave * 4 + tt, ti = t >> 3, te = t & 7; f32x4 acc = {0.f, 0.f, 0.f, 0.f};
#pragma unroll
        for (int s = 0; s < 2; ++s) { const int oa = (16 * ti + fr) * 72 + 32 * s + 8 * g, ob = (16 * te + fr) * 72 + 32 * s + 8 * g;
            const bf16x8 fa = *(const LAS bf16x8*)(TL + oa), fb = *(const LAS bf16x8*)(VT + ob);
            acc = MFMA16(fa, fb, acc); }
        u32x2 w; w.x = cvt_pk_bf16(acc[0], acc[1]); w.y = cvt_pk_bf16(acc[2], acc[3]); *(u32x2*)(vB + (16 * te + fr) * 64 + 16 * ti + 4 * g) = w; }
#pragma unroll
    for (int tt = 0; tt < 4; ++tt) { const int t = wave * 4 + tt, td = t >> 2, ti = t & 3; f32x4 acc = {0.f, 0.f, 0.f, 0.f};
#pragma unroll
        for (int s = 0; s < 2; ++s) { const int oa = (16 * td + fr) * 72 + 32 * s + 8 * g, ob = (16 * ti + fr) * 72 + 32 * s + 8 * g;
            const bf16x8 fa = *(const LAS bf16x8*)(KBT + oa), fb = *(const LAS bf16x8*)(TL + ob);
            acc = MFMA16(fa, fb, acc); }
        u32x2 w; w.x = cvt_pk_bf16(acc[0], acc[1]); w.y = cvt_pk_bf16(acc[2], acc[3]); *(u32x2*)(wB + (16 * ti + fr) * 128 + 32 * (td >> 1) + 8 * g + 4 * (td & 1)) = w; }
#ifdef PROBE_NAN
    if (pbad) { unsigned* pfl = (unsigned*)(ws + WS_CTL) + 1024; for (int k = 0; k < 7; ++k) if (pbad & (1u << k)) atomicOr(pfl + 30 + k, 1u); }
#endif
    __syncthreads();
}

constexpr int G3_W = 0, G3_Q = 16384, G3_KT = 32768, G3_AT = 49152, G3_BUF = 57344, G3_OB = 2 * G3_BUF, G3_OBS = 132;
static_assert(G3_OB + 64 * G3_OBS * 4 <= LDS_MISC, "scan LDS map");
__device__ __forceinline__ unsigned g3_off256(unsigned r, unsigned c) { return r * 256u + ((c ^ (r & 15u)) << 4); }
__device__ __forceinline__ unsigned g3_off128(unsigned r, unsigned c) { return r * 128u + ((c ^ ((r >> 1) & 7u)) << 4); }
__device__ __forceinline__ void g3_scan(const Params& p, LAS unsigned char* lds, int bh, int wave, int lane) {
    unsigned char* ws = p.ws;
    const int b = bh >> 2, h = bh & 3, e0 = 16 * wave;
    LAS float* OB = (LAS float*)(lds + G3_OB);
    f32x4 S[8];
#pragma unroll
    for (int i = 0; i < 8; ++i) S[i] = (f32x4){0.f, 0.f, 0.f, 0.f};
    const bf16_t* ZB = (const bf16_t*)(ws + WS_ZB); bf16_t* AO = (bf16_t*)(ws + WS_AOUT);
    const int tid = wave * 64 + lane;
    {
        const size_t cb = (size_t)bh * NCHUNK;
        const u32x4* s0 = (const u32x4*)((const bf16_t*)(ws + WS_WBUF) + cb * 8192); const u32x4* s1 = (const u32x4*)((const bf16_t*)(ws + WS_QH) + cb * 8192);
        const u32x4* s2 = (const u32x4*)((const bf16_t*)(ws + WS_KH) + cb * 8192); const u32x4* s4 = (const u32x4*)((const bf16_t*)(ws + WS_ATTN) + cb * 4096);
#pragma unroll
        for (int i = 0; i < 2; ++i) { const unsigned pp = tid + 512 * i;
            *(LAS u32x4*)(lds + G3_W + g3_off256(pp >> 4, pp & 15u)) = s0[pp]; *(LAS u32x4*)(lds + G3_Q + g3_off256(pp >> 4, pp & 15u)) = s1[pp]; *(LAS u32x4*)(lds + G3_KT + g3_off128(pp >> 3, pp & 7u)) = s2[pp]; }
        *(LAS u32x4*)(lds + G3_AT + g3_off128((unsigned)tid >> 3, (unsigned)tid & 7u)) = s4[tid];
    }
    __syncthreads();
#pragma unroll 1
    for (int c = 0; c < NCHUNK; ++c) {
        int lane_o = threadIdx.x & 63; asm volatile("" : "+v"(lane_o));
        const unsigned g = (unsigned)lane_o >> 4, fr = (unsigned)lane_o & 15u;
        const unsigned tid2 = wave * 64 + lane_o;
        const size_t cb = (size_t)bh * NCHUNK + c;
        LAS unsigned char* buf = lds + (c & 1) * G3_BUF; LAS unsigned char* nbuf = lds + ((c + 1) & 1) * G3_BUF;
        const float gam = ((const float*)(ws + WS_GAMMA))[cb];
        u32x4 zp[2]; u32x2 uu[4];
        {
            const size_t nb = (c + 1 < NCHUNK) ? cb + 1 : cb;
            const u32x4* s0 = (const u32x4*)((const bf16_t*)(ws + WS_WBUF) + nb * 8192); const u32x4* s1 = (const u32x4*)((const bf16_t*)(ws + WS_QH) + nb * 8192);
            const u32x4* s2 = (const u32x4*)((const bf16_t*)(ws + WS_KH) + nb * 8192); const u32x4* s4 = (const u32x4*)((const bf16_t*)(ws + WS_ATTN) + nb * 4096);
#pragma unroll
            for (int i = 0; i < 2; ++i) { const unsigned sl = tid2 + 512u * i, r = sl >> 4, cs = (sl & 15u) ^ (r & 15u); const unsigned wb = (unsigned)(wave * 64 + 512 * i) * 16u;
                __builtin_amdgcn_global_load_lds((const unsigned*)(s0 + r * 16u + cs), (LAS unsigned*)(nbuf + G3_W + wb), 16, 0, 0);
                __builtin_amdgcn_global_load_lds((const unsigned*)(s1 + r * 16u + cs), (LAS unsigned*)(nbuf + G3_Q + wb), 16, 0, 0);
                const unsigned r8 = sl >> 3, c8s = (sl & 7u) ^ ((r8 >> 1) & 7u);
                __builtin_amdgcn_global_load_lds((const unsigned*)(s2 + r8 * 8u + c8s), (LAS unsigned*)(nbuf + G3_KT + wb), 16, 0, 0); }
            { const unsigned r8 = tid2 >> 3, c8s = (tid2 & 7u) ^ ((r8 >> 1) & 7u);
                __builtin_amdgcn_global_load_lds((const unsigned*)(s4 + r8 * 8u + c8s), (LAS unsigned*)(nbuf + G3_AT + (unsigned)(wave * 64) * 16u), 16, 0, 0); }
            const bf16_t* uT = (const bf16_t*)(ws + WS_VH) + cb * 8192;
#pragma unroll
            for (int mt = 0; mt < 4; ++mt) uu[mt] = *(const u32x2*)(uT + (e0 + fr) * 64 + 16 * mt + 4 * g);
#pragma unroll
            for (int q = 0; q < 2; ++q) { const unsigned pp = tid2 + 512u * q; const size_t m = (size_t)b * SEQ + c * 64 + (pp >> 4); zp[q] = *(const u32x4*)(ZB + m * 512 + h * 128 + 8 * (pp & 15u)); }
        }
        bf16x8 Sb[4];
#pragma unroll
        for (int kb = 0; kb < 4; ++kb) Sb[kb] = pk8(S[2 * kb], S[2 * kb + 1]);
        f32x4 vn[4], ot[4];
#define G3_FRAG256(base, R, kb) (*(const LAS bf16x8*)(buf + (base) + g3_off256((R), 4 * (kb) + g)))
#define G3_FRAG128(base, R, k2) (*(const LAS bf16x8*)(buf + (base) + g3_off128((R), 4 * (k2) + g)))
        {
#pragma unroll
            for (int hf = 0; hf < 2; ++hf) {
                bf16x8 af[8];
#pragma unroll
                for (int m2 = 0; m2 < 2; ++m2)
#pragma unroll
                    for (int kb = 0; kb < 4; ++kb) af[4 * m2 + kb] = G3_FRAG256(G3_W, 16 * (2 * hf + m2) + fr, kb);
                asm volatile("" ::: "memory");
#pragma unroll
                for (int m2 = 0; m2 < 2; ++m2) { const int mt = 2 * hf + m2; f32x4 acc = {0.f, 0.f, 0.f, 0.f};
#pragma unroll
                    for (int kb = 0; kb < 4; ++kb) acc = MFMA16(af[4 * m2 + kb], Sb[kb], acc);
                    vn[mt] = (f32x4){bf_lo(uu[mt].x) - acc[0], bf_hi(uu[mt].x) - acc[1], bf_lo(uu[mt].y) - acc[2], bf_hi(uu[mt].y) - acc[3]}; }
            }
        }
        bf16x8 vb[2]; vb[0] = pk8(vn[0], vn[1]); vb[1] = pk8(vn[2], vn[3]);
        {
#pragma unroll
            for (int mt = 0; mt < 4; ++mt) {
                bf16x8 af[6];
#pragma unroll
                for (int kb = 0; kb < 4; ++kb) af[kb] = G3_FRAG256(G3_Q, 16 * mt + fr, kb);
#pragma unroll
                for (int k2 = 0; k2 < 2; ++k2) af[4 + k2] = G3_FRAG128(G3_AT, 16 * mt + fr, k2);
                asm volatile("" ::: "memory");
                f32x4 acc = {0.f, 0.f, 0.f, 0.f};
#pragma unroll
                for (int kb = 0; kb < 4; ++kb) acc = MFMA16(af[kb], Sb[kb], acc);
#pragma unroll
                for (int k2 = 0; k2 < 2; ++k2) acc = MFMA16(af[4 + k2], vb[k2], acc);
                ot[mt] = acc; }
        }
        {
#pragma unroll
            for (int hf = 0; hf < 4; ++hf) {
                bf16x8 af[4];
#pragma unroll
                for (int r2 = 0; r2 < 2; ++r2)
#pragma unroll
                    for (int k2 = 0; k2 < 2; ++k2) af[2 * r2 + k2] = G3_FRAG128(G3_KT, 16 * (2 * hf + r2) + fr, k2);
                asm volatile("" ::: "memory");
#pragma unroll
                for (int r2 = 0; r2 < 2; ++r2) { const int rt = 2 * hf + r2; f32x4 acc = S[rt] * gam;
#pragma unroll
                    for (int k2 = 0; k2 < 2; ++k2) acc = MFMA16(af[2 * r2 + k2], vb[k2], acc);
                    S[rt] = acc; }
            }
        }
#undef G3_FRAG256
#undef G3_FRAG128
        __syncthreads();
#pragma unroll
        for (int mt = 0; mt < 4; ++mt)
#pragma unroll
            for (int reg = 0; reg < 4; ++reg) OB[(16 * mt + 4 * g + reg) * G3_OBS + e0 + fr] = ot[mt][reg];
        asm volatile("s_waitcnt vmcnt(0)" ::: "memory");
        __syncthreads();
#pragma unroll
        for (int q = 0; q < 2; ++q) { const unsigned pp = tid2 + 512u * q, i = pp >> 4, c8 = pp & 15u;
            const f32x4 o0 = *(const LAS f32x4*)(OB + i * G3_OBS + 8 * c8), o1 = *(const LAS f32x4*)(OB + i * G3_OBS + 8 * c8 + 4);
            const float tot = row16_sum((o0[0] * o0[0] + o0[1] * o0[1]) + (o0[2] * o0[2] + o0[3] * o0[3]) + (o1[0] * o1[0] + o1[1] * o1[1]) + (o1[2] * o1[2] + o1[3] * o1[3]));
            const float rstd = rsqrtf(tot * (1.f / 128.f) + EPS);
            const u32x4 z = zp[q]; f32x4 gnv[2]; { const f32x4* gp4 = (const f32x4*)(p.gdn_norm_g + 8 * c8); gnv[0] = gp4[0]; gnv[1] = gp4[1]; }
            float r[8];
            r[0] = o0[0] * rstd * gnv[0][0] * silu_f(bf_lo(z.x)); r[1] = o0[1] * rstd * gnv[0][1] * silu_f(bf_hi(z.x)); r[2] = o0[2] * rstd * gnv[0][2] * silu_f(bf_lo(z.y)); r[3] = o0[3] * rstd * gnv[0][3] * silu_f(bf_hi(z.y));
            r[4] = o1[0] * rstd * gnv[1][0] * silu_f(bf_lo(z.z)); r[5] = o1[1] * rstd * gnv[1][1] * silu_f(bf_hi(z.z)); r[6] = o1[2] * rstd * gnv[1][2] * silu_f(bf_lo(z.w)); r[7] = o1[3] * rstd * gnv[1][3] * silu_f(bf_hi(z.w));
#ifdef ZERO_GDN
#pragma unroll
            for (int e = 0; e < 8; ++e) r[e] = 0.f;
#elif defined(DOUBLE_GDN)
#pragma unroll
            for (int e = 0; e < 8; ++e) r[e] *= 2.f;
#endif
            u32x4 w; w.x = cvt_pk_bf16(r[0], r[1]); w.y = cvt_pk_bf16(r[2], r[3]); w.z = cvt_pk_bf16(r[4], r[5]); w.w = cvt_pk_bf16(r[6], r[7]);
            const size_t m = (size_t)b * SEQ + c * 64 + i;
            *(u32x4*)(AO + m * 1536 + h * 128 + 8 * c8) = w; }
    }
}

constexpr int DL_QS = 0;
constexpr int DL_IMG = 0;
constexpr int DL_SEL = 131072;
constexpr int DL_HIST = 139264;
constexpr int DL_WQ = 147456;
constexpr int DL_BKT = 148480;
constexpr int DL_RB = 156672;
static_assert(DL_RB + 512 <= LDS_MISC, "DSA LDS map");

__device__ __forceinline__ unsigned img_off(unsigned row, unsigned ch) { return 256u * row + 16u * (ch ^ (((row & 3u) << 2) | ((row >> 2) & 3u))); }
__device__ __forceinline__ unsigned key16(unsigned u) { return (u & 0x8000u) ? (~u & 0xffffu) : (u | 0x8000u); }
__device__ __forceinline__ void radix_find(const LAS unsigned* hist, unsigned need, int lane, unsigned& bsel, unsigned& above) {
    const u32x4 hv = *(const LAS u32x4*)(hist + 4 * lane);
    const unsigned s4 = hv.x + hv.y + hv.z + hv.w;
    unsigned incl = s4;
#pragma unroll
    for (int o = 1; o < 64; o <<= 1) { const unsigned t = __shfl_down(incl, o); if (lane + o < 64) incl += t; }
    const unsigned excl = incl - s4;
    const bool hit = (excl < need) && (incl >= need);
    const unsigned c3 = excl + hv.w, c2 = c3 + hv.z, c1 = c2 + hv.y;
    unsigned bb, ab;
    if (c3 >= need) { bb = 3; ab = excl; } else if (c2 >= need) { bb = 2; ab = c3; } else if (c1 >= need) { bb = 1; ab = c2; } else { bb = 0; ab = c1; }
    const unsigned long long mask = __ballot(hit);
    const int src = mask ? (__ffsll((long long)mask) - 1) : 0;
    bsel = __shfl(4u * lane + bb, src); above = __shfl(ab, src);
}
__device__ __forceinline__ void dsa_tables(const Params& p, LAS unsigned char* lds, int tid) {
    LAS unsigned char* BK = lds + DL_BKT; LAS float* RB = (LAS float*)(lds + DL_RB);
    for (int d = tid; d < SEQ; d += NTHR) { int bk = d;
        if (d >= 16) { bk = 16 + (d >= 21) + (d >= 27) + (d >= 35) + (d >= 46) + (d >= 59) + (d >= 77) + (d >= 99) + (d >= 128) + (d >= 166) + (d >= 216) + (d >= 280) + (d >= 363) + (d >= 470) + (d >= 609) + (d >= 790); }
        BK[d] = (unsigned char)bk; }
    if (tid < 128) RB[tid] = p.rel_bias[tid];
    __syncthreads();
}
struct TabJob { f32x4 a[4], b[4], g[4]; int pair; };
__device__ __forceinline__ void tab_load(const Params& p, TabJob& tj, int pair, int lane) {
    tj.pair = pair; const int tb = pair >> 13, r0 = (pair & 8191) * 2;
    const float* src = (tb ? p.peer_v : p.peer_u) + (size_t)r0 * 1024 + 16 * lane;
#pragma unroll
    for (int q = 0; q < 4; ++q) { tj.a[q] = ((const f32x4*)src)[q]; tj.b[q] = ((const f32x4*)(src + 1024))[q]; tj.g[q] = ((const f32x4*)p.ln2_g)[4 * lane + q]; }
}
__device__ __forceinline__ void tab_finish(unsigned char* ws, const TabJob& tj, int lane) {
    const int tb = tj.pair >> 13, r0 = (tj.pair & 8191) * 2;
    float va[16], vb[16];
#pragma unroll
    for (int q = 0; q < 4; ++q)
#pragma unroll
        for (int e = 0; e < 4; ++e) { const float gq = tb ? 1.f : tj.g[q][e]; va[4 * q + e] = tj.a[q][e] * gq; vb[4 * q + e] = tj.b[q][e] * gq; }
    float ma = 0.f, mb = 0.f;
#pragma unroll
    for (int e = 0; e < 16; ++e) { ma = fmaxf(ma, __builtin_fabsf(va[e])); mb = fmaxf(mb, __builtin_fabsf(vb[e])); }
#pragma unroll
    for (int o = 32; o >= 1; o >>= 1) { ma = fmaxf(ma, __shfl_xor(ma, o)); mb = fmaxf(mb, __shfl_xor(mb, o)); }
    ma = fmaxf(ma, 1e-30f); mb = fmaxf(mb, 1e-30f);
    const float ia = 7.5f / ma, ib = 7.5f / mb;
    h32_t hv;
#pragma unroll
    for (int e = 0; e < 16; ++e) { hv[e] = (_Float16)(va[e] * ia); hv[16 + e] = (_Float16)(vb[e] * ib); }
    const u32x6 enc = __builtin_amdgcn_cvt_scalef32_pk32_fp6_f16(hv, 1.0f);
    unsigned char* dst = ws + (tb ? WS_VB : WS_UB) + (size_t)r0 * 768 + lane * 12;
    *(u32x3a*)dst = (u32x3a){enc[0], enc[1], enc[2]}; *(u32x3a*)(dst + 768) = (u32x3a){enc[3], enc[4], enc[5]};
    if (lane == 0) { float* SUVp = (float*)(ws + WS_SUV); SUVp[tb * 16384 + r0] = ma * (1.f / 7.5f); SUVp[tb * 16384 + r0 + 1] = mb * (1.f / 7.5f); }
}
__device__ __forceinline__ void dsa_unit(const Params& p, LAS unsigned char* lds, int b, int qb16, const TabJob& tj) {
    unsigned char* ws = p.ws;
    int tid = threadIdx.x; asm volatile("" : "+v"(tid));
    const int lane = tid & 63, wave = __builtin_amdgcn_readfirstlane(tid >> 6);
    const int g = lane >> 4, fr = lane & 15, t0 = 16 * qb16, nkt = qb16 + 1;
    const size_t m0 = (size_t)b * SEQ + t0;
    LAS bf16_t* QS = (LAS bf16_t*)(lds + DL_QS); LAS float* WQ = (LAS float*)(lds + DL_WQ);
    LAS unsigned short* SEL = (LAS unsigned short*)(lds + DL_SEL); LAS unsigned* HIST = (LAS unsigned*)(lds + DL_HIST) + wave * 256;
    const LAS unsigned char* BK = lds + DL_BKT; const LAS float* RB = (const LAS float*)(lds + DL_RB);
    _Float16* scr = (_Float16*)(ws + WS_SCR) + (size_t)blockIdx.x * (16 * SEQ);
#ifdef PROBE_TIME
    const unsigned long long td0 = __builtin_amdgcn_s_memrealtime();
#endif
    {
        const bf16_t* qsrc = (const bf16_t*)(ws + WS_QIDX) + m0 * 1024;
#pragma unroll
        for (int i = 0; i < 4; ++i) { const int piece = tid + 512 * i, qi = piece >> 7, rem = piece & 127, h = rem >> 3, ch = rem & 7;
            *(LAS u32x4*)(QS + (h * 16 + qi) * 72 + ch * 8) = *(const u32x4*)(qsrc + (size_t)qi * 1024 + h * 64 + ch * 8); }
        if (tid < 256) WQ[tid] = ((const float*)(ws + WS_WIDX))[m0 * 16 + tid];
        __syncthreads();
        tab_finish(ws, tj, lane);
        { const int qi = tid >> 5, d = (tid & 31) * 2; float s0 = 0.f, s1 = 0.f;
#pragma unroll
            for (int h = 0; h < 16; ++h) { const unsigned w2 = *(const LAS unsigned*)(QS + (h * 16 + qi) * 72 + d); const float wh = WQ[qi * 16 + h]; s0 = fmaf(wh, bf_lo(w2), s0); s1 = fmaf(wh, bf_hi(w2), s1); }
            *(LAS unsigned*)(QS + (16 * 16 + qi) * 72 + d) = cvt_pk_bf16(s0, s1); }
        __syncthreads();
    }
    {
        float wreg[16];
#pragma unroll
        for (int h = 0; h < 16; ++h) wreg[h] = WQ[fr * 16 + h];
        const bf16_t* kbase = (const bf16_t*)(ws + WS_KIDXN) + (size_t)b * SEQ * 64;
        constexpr int NQR = 11;
        bf16x8 qfr[NQR][2];
#pragma unroll
        for (int h = 0; h < NQR; ++h) { qfr[h][0] = *(const LAS bf16x8*)(QS + (h * 16 + fr) * 72 + 8 * g); qfr[h][1] = *(const LAS bf16x8*)(QS + (h * 16 + fr) * 72 + 32 + 8 * g); }
        bf16x8 kn[2];
        { int kt = wave; if (kt >= nkt) kt = 0; const bf16_t* kr = kbase + (size_t)(16 * kt + fr) * 64 + 8 * g; kn[0] = *(const bf16x8*)kr; kn[1] = *(const bf16x8*)(kr + 32); }
#pragma unroll 1
        for (int kt = wave; kt < nkt; kt += 8) {
            const bf16x8 ka0 = kn[0], ka1 = kn[1];
            { int k2 = kt + 8; if (k2 >= nkt) k2 = 0; const bf16_t* kr = kbase + (size_t)(16 * k2 + fr) * 64 + 8 * g; kn[0] = *(const bf16x8*)kr; kn[1] = *(const bf16x8*)(kr + 32); }
            f32x4 sc = {0.f, 0.f, 0.f, 0.f};
            unsigned oz1; asm volatile("v_mov_b32 %0, 0" : "=v"(oz1));
            const LAS bf16_t* QSz = QS + oz1;
            bf16x8 ql[17 - NQR][2];
#pragma unroll
            for (int h = NQR; h < 17; ++h) { ql[h - NQR][0] = *(const LAS bf16x8*)(QSz + (h * 16 + fr) * 72 + 8 * g); ql[h - NQR][1] = *(const LAS bf16x8*)(QSz + (h * 16 + fr) * 72 + 32 + 8 * g); }
#pragma unroll
            for (int h = 0; h < 17; ++h) { f32x4 c = {0.f, 0.f, 0.f, 0.f}; const bf16x8 q0 = (h < NQR) ? qfr[h < NQR ? h : 0][0] : ql[h >= NQR ? h - NQR : 0][0], q1 = (h < NQR) ? qfr[h < NQR ? h : 0][1] : ql[h >= NQR ? h - NQR : 0][1];
                c = MFMA16(ka0, q0, c); c = MFMA16(ka1, q1, c);
                if (h < 16) {
#pragma unroll
                    for (int r = 0; r < 4; ++r) { float t = fmaf(__builtin_fabsf(c[r]), wreg[h < 16 ? h : 0], sc[r]); asm volatile("" : "+v"(t)); sc[r] = t; }
                } else sc += c; }
            { _Float16 hv[4];
#pragma unroll
                for (int r = 0; r < 4; ++r) { const int key = 16 * kt + 4 * g + r; float v = sc[r]; if (kt == nkt - 1 && key > t0 + fr) v = -INFINITY; hv[r] = (_Float16)v; }
                typedef _Float16 h4 __attribute__((ext_vector_type(4))); h4 o; o[0] = hv[0]; o[1] = hv[1]; o[2] = hv[2]; o[3] = hv[3];
                *(h4*)(scr + (size_t)fr * SEQ + 16 * kt + 4 * g) = o; }
        }
    }
    VM_WAIT(); __syncthreads();
#ifdef PROBE_TIME
    const unsigned long long td1 = __builtin_amdgcn_s_memrealtime(); unsigned long long t2acc = 0, t3acc = 0;
#endif
    const unsigned char* ckv8 = ws + WS_CKV8 + (size_t)b * SEQ * 256;
    bf16_t* AO = (bf16_t*)(ws + WS_AOUT);
    LAS unsigned char* img = lds + DL_IMG + wave * 16384;
#pragma unroll 1
    for (int qq = 0; qq < 2; ++qq) {
#ifdef PROBE_TIME
        const unsigned long long tdq = __builtin_amdgcn_s_memrealtime();
#endif
        int lane3 = threadIdx.x & 63; asm volatile("" : "+v"(lane3));
        const int lane = lane3, g = lane >> 4, fr = lane & 15;
        const unsigned long long lt_mask = (1ull << lane) - 1ull;
        const int qi = wave + 8 * qq, t = t0 + qi, n = t + 1; const size_t m = m0 + qi;
        LAS unsigned short* sel = SEL + qi * 256;
        int cnt;
        if (n <= 256) { cnt = n; for (int k = lane; k < 256; k += 64) sel[k] = (unsigned short)((k < n) ? k : 0); }
        else {
            cnt = 256;
            const unsigned* srow = (const unsigned*)(scr + (size_t)qi * SEQ); const int nw = (n + 1) >> 1;
            unsigned sv[64];
            const int nfull = n >> 1;
#pragma unroll
            for (int blk = 0; blk < 4; ++blk) {
                if (1024 * blk < nw) {
#pragma unroll
                    for (int jj = 0; jj < 16; ++jj) { const int j = 16 * blk + jj; sv[j] = srow[lane + 64 * j]; }
                } else {
#pragma unroll
                    for (int jj = 0; jj < 16; ++jj) sv[16 * blk + jj] = 0u;
                }
            }
            LAS unsigned* H = (LAS unsigned*)img;
#pragma unroll
            for (int k = 0; k < 8; ++k) *(LAS u32x4*)(H + 4 * (lane + 64 * k)) = (u32x4){0u, 0u, 0u, 0u};
            LDS_WAIT();
#pragma unroll
            for (int blk = 0; blk < 4; ++blk) if (1024 * blk < nw) {
#pragma unroll
                for (int jj = 0; jj < 16; ++jj) { const int j = 16 * blk + jj; const unsigned v = sv[j];
                    const unsigned neg = (v >> 15) & 0x00010001u, msk = (neg << 16) - neg;
                    unsigned kk = v ^ (msk | 0x80008000u);
                    if (64 * j + 64 <= nfull) {
                        sv[j] = kk;
                        __hip_atomic_fetch_add(H + ((kk & 0xffffu) >> 5), 1u, __ATOMIC_RELAXED, __HIP_MEMORY_SCOPE_WORKGROUP);
                        __hip_atomic_fetch_add(H + (kk >> 21), 1u, __ATOMIC_RELAXED, __HIP_MEMORY_SCOPE_WORKGROUP);
                    } else {
                        const int w = lane + 64 * j;
                        kk = (w < nw) ? kk : 0u; if (2 * w + 1 >= n) kk &= 0xFFFFu;
                        sv[j] = kk;
                        const unsigned k0 = kk & 0xffffu, k1 = kk >> 16;
                        if (k0) __hip_atomic_fetch_add(H + (k0 >> 5), 1u, __ATOMIC_RELAXED, __HIP_MEMORY_SCOPE_WORKGROUP);
                        if (k1) __hip_atomic_fetch_add(H + (k1 >> 5), 1u, __ATOMIC_RELAXED, __HIP_MEMORY_SCOPE_WORKGROUP);
                    } }
            }
            LDS_WAIT();
            unsigned b1, need1;
            {
                unsigned hb[32];
#pragma unroll
                for (int k = 0; k < 8; ++k) { const u32x4 t = *(const LAS u32x4*)(H + 32 * lane + 4 * k); hb[4 * k] = t.x; hb[4 * k + 1] = t.y; hb[4 * k + 2] = t.z; hb[4 * k + 3] = t.w; }
                unsigned s32 = 0u;
#pragma unroll
                for (int k = 0; k < 32; ++k) s32 += hb[k];
                unsigned incl = s32;
#pragma unroll
                for (int o = 1; o < 64; o <<= 1) { const unsigned t = __shfl_down(incl, o); if (lane + o < 64) incl += t; }
                const unsigned excl = incl - s32; const bool hit = (excl < 256u) && (incl >= 256u);
                unsigned run = excl, bb = 0u, ab = excl; bool found = false;
#pragma unroll
                for (int k = 31; k >= 0; --k) { const unsigned nr = run + hb[k]; if (!found && nr >= 256u) { found = true; bb = (unsigned)k; ab = run; } run = nr; }
                const unsigned long long mask = __ballot(hit); const int src = mask ? (__ffsll((long long)mask) - 1) : 0;
                b1 = __shfl(32u * lane + bb, src); need1 = 256u - __shfl(ab, src);
            }
            LDS_WAIT();
            if (lane < 32) H[lane] = 0u;
            LDS_WAIT();
#pragma unroll
            for (int blk = 0; blk < 4; ++blk) if (1024 * blk < nw) {
#pragma unroll
                for (int jj = 0; jj < 16; ++jj) { const unsigned v = sv[16 * blk + jj]; const unsigned k0 = v & 0xffffu, k1 = v >> 16;
                    if ((k0 >> 5) == b1) __hip_atomic_fetch_add(H + (k0 & 31u), 1u, __ATOMIC_RELAXED, __HIP_MEMORY_SCOPE_WORKGROUP);
                    if ((k1 >> 5) == b1) __hip_atomic_fetch_add(H + (k1 & 31u), 1u, __ATOMIC_RELAXED, __HIP_MEMORY_SCOPE_WORKGROUP); }
            }
            LDS_WAIT();
            unsigned thr, need2;
            {
                const unsigned hv = (lane < 32) ? H[lane] : 0u; unsigned incl = hv;
#pragma unroll
                for (int o = 1; o < 32; o <<= 1) { const unsigned t = __shfl_down(incl, o); if (lane + o < 32) incl += t; }
                const unsigned excl = incl - hv; const bool hit = (lane < 32) && (excl < need1) && (incl >= need1);
                const unsigned long long mask = __ballot(hit); const int src = mask ? (__ffsll((long long)mask) - 1) : 0;
                thr = (b1 << 5) | (unsigned)src; need2 = need1 - __shfl(excl, src);
            }
            unsigned mg[4], me[4];
#pragma unroll
            for (int blk = 0; blk < 4; ++blk) { unsigned g1 = 0u, e1 = 0u;
                if (1024 * blk < nw) {
#pragma unroll
                    for (int jj = 0; jj < 16; ++jj) { const unsigned v = sv[16 * blk + jj]; const unsigned k0 = v & 0xffffu, k1 = v >> 16;
                        asm("v_cmp_gt_u32 vcc, %2, %4\n\tv_addc_co_u32 %0, vcc, %0, %0, vcc\n\tv_cmp_gt_u32 vcc, %3, %4\n\tv_addc_co_u32 %0, vcc, %0, %0, vcc\n\t"
                            "v_cmp_eq_u32 vcc, %2, %4\n\tv_addc_co_u32 %1, vcc, %1, %1, vcc\n\tv_cmp_eq_u32 vcc, %3, %4\n\tv_addc_co_u32 %1, vcc, %1, %1, vcc"
                            : "+v"(g1), "+v"(e1) : "v"(k0), "v"(k1), "v"(thr) : "vcc"); }
                }
                mg[blk] = g1; me[blk] = e1; }
            const unsigned cgt = (unsigned)(__builtin_popcount(mg[0]) + __builtin_popcount(mg[1]) + __builtin_popcount(mg[2]) + __builtin_popcount(mg[3]));
            const unsigned ceq = (unsigned)(__builtin_popcount(me[0]) + __builtin_popcount(me[1]) + __builtin_popcount(me[2]) + __builtin_popcount(me[3]));
            unsigned pg = cgt, pe = ceq;
#pragma unroll
            for (int o = 1; o < 64; o <<= 1) { const unsigned tg = __shfl_up(pg, o), te = __shfl_up(pe, o); if (lane >= o) { pg += tg; pe += te; } }
            unsigned og = pg - cgt, oe = pe - ceq;
#pragma unroll
            for (int blk = 0; blk < 4; ++blk) {
                unsigned m = mg[blk];
                while (__any(m != 0u)) {
                    if (m) { const int bp = __builtin_ctz(m); const int pq = 31 - bp; sel[og] = (unsigned short)(2 * (lane + 64 * (16 * blk + (pq >> 1))) + (pq & 1)); ++og; m &= m - 1u; } }
                m = me[blk];
                while (__any(m != 0u)) {
                    if (m) { const int bp = __builtin_ctz(m); const int pq = 31 - bp; if (oe < need2) sel[255u - oe] = (unsigned short)(2 * (lane + 64 * (16 * blk + (pq >> 1))) + (pq & 1)); ++oe; m &= m - 1u; } }
            }
        }
        LDS_WAIT();
#ifdef PROBE_TIME
        const unsigned long long td2 = __builtin_amdgcn_s_memrealtime();
#endif
        bf16x8 qf[8];
        { const bf16_t* qrow = AO + m * 1536 + 512 + (fr & 3) * 256;
#pragma unroll
            for (int s = 0; s < 8; ++s) { bf16x8 v = *(const bf16x8*)(qrow + 64 * (s >> 1) + 16 * g + 8 * (s & 1)); if (fr >= 4) v = (bf16x8){0, 0, 0, 0, 0, 0, 0, 0}; qf[s] = v; } }
        f32x4 O[16];
#pragma unroll
        for (int c = 0; c < 16; ++c) O[c] = (f32x4){0.f, 0.f, 0.f, 0.f};
        float mrun = -1e30f, lrun = 0.f;
        const int nchunk = (cnt + 31) >> 5;
        const unsigned img_base = (unsigned)(size_t)img;
        u32x4 gp[8];
#pragma unroll
        for (int rb = 0; rb < 2; ++rb) { const int slot = 16 * rb + fr; const unsigned kraw = sel[slot]; const unsigned key = (slot < cnt) ? kraw : 0u; const unsigned char* kp = ckv8 + (size_t)key * 256 + 16 * g;
#pragma unroll
            for (int pq = 0; pq < 4; ++pq) gp[4 * rb + pq] = *(const u32x4*)(kp + 64 * pq); }
        const unsigned swz_w = ((fr & 3u) << 2) | ((fr >> 2) & 3u), wb = img_base + 256u * fr + 16u * ((2u * g) ^ swz_w);
        const unsigned q4 = (unsigned)fr >> 2, pp = (unsigned)fr & 3u, rrow = 4u * g + q4, swz_r = ((rrow & 3u) << 2) | ((rrow >> 2) & 3u);
        const unsigned rbs = img_base + 256u * rrow + 16u * ((pp >> 1) ^ swz_r) + 8u * (pp & 1u);
#pragma unroll 1
        for (int ck = 0; ck < nchunk; ++ck) {
            f32x4 sacc[2] = {(f32x4){0.f, 0.f, 0.f, 0.f}, (f32x4){0.f, 0.f, 0.f, 0.f}};
#pragma unroll
            for (int i = 0; i < 8; ++i) {
                u32x4 lo, hi;
#pragma unroll
                for (int q = 0; q < 2; ++q) { lo[2 * q] = __builtin_bit_cast(unsigned, __builtin_amdgcn_cvt_scalef32_pk_bf16_fp8(gp[i][q], 1.0f, false)); lo[2 * q + 1] = __builtin_bit_cast(unsigned, __builtin_amdgcn_cvt_scalef32_pk_bf16_fp8(gp[i][q], 1.0f, true));
                    hi[2 * q] = __builtin_bit_cast(unsigned, __builtin_amdgcn_cvt_scalef32_pk_bf16_fp8(gp[i][2 + q], 1.0f, false)); hi[2 * q + 1] = __builtin_bit_cast(unsigned, __builtin_amdgcn_cvt_scalef32_pk_bf16_fp8(gp[i][2 + q], 1.0f, true)); }
                sacc[i >> 2] = MFMA16(__builtin_bit_cast(bf16x8, lo), qf[2 * (i & 3)], sacc[i >> 2]); sacc[i >> 2] = MFMA16(__builtin_bit_cast(bf16x8, hi), qf[2 * (i & 3) + 1], sacc[i >> 2]);
                const unsigned wa = wb ^ (128u * (i & 1)), cst = 8192u * ((i & 3) >> 1) + 4096u * (i >> 2);
                *(LAS u32x4*)(size_t)(wa + cst) = lo; *(LAS u32x4*)(size_t)((wa ^ 16u) + cst) = hi; }
            if (ck + 1 < nchunk) {
#pragma unroll
                for (int rb = 0; rb < 2; ++rb) { const int slot = 32 * (ck + 1) + 16 * rb + fr; const unsigned kraw = sel[slot]; const unsigned key = (slot < cnt) ? kraw : 0u; const unsigned char* kp = ckv8 + (size_t)key * 256 + 16 * g;
#pragma unroll
                    for (int pq = 0; pq < 4; ++pq) gp[4 * rb + pq] = *(const u32x4*)(kp + 64 * pq); }
            }
            float lg[8]; float mx = -1e30f;
#pragma unroll
            for (int rb = 0; rb < 2; ++rb) { const u32x2 kk = *(const LAS u32x2*)(sel + 32 * ck + 16 * rb + 4 * g);
#pragma unroll
                for (int r = 0; r < 4; ++r) { const int slot = 32 * ck + 16 * rb + 4 * g + r; const unsigned kw = (r < 2) ? kk.x : kk.y; const int key = (r & 1) ? (int)(kw >> 16) : (int)(kw & 0xffffu);
                    int dist = t - key; dist = dist < 0 ? 0 : dist; const int bk = BK[dist];
                    float v = sacc[rb][r] + RB[bk * 4 + (fr & 3)]; if (slot >= cnt) v = -1e30f; if (fr >= 4) v = 0.f; lg[4 * rb + r] = v; mx = fmaxf(mx, v); } }
            mx = fmaxf(mx, __shfl_xor(mx, 16)); mx = fmaxf(mx, __shfl_xor(mx, 32));
            const float mnew = fmaxf(mrun, mx), alpha = __expf(mrun - mnew);
            float pv[8], ps = 0.f;
#pragma unroll
            for (int j = 0; j < 8; ++j) { pv[j] = __expf(lg[j] - mnew); ps += pv[j]; }
            lrun = lrun * alpha + ps; mrun = mnew;
            const bf16x8 pf = pk8((f32x4){pv[0], pv[1], pv[2], pv[3]}, (f32x4){pv[4], pv[5], pv[6], pv[7]});
            if (__any(alpha != 1.f)) {
#pragma unroll
                for (int c = 0; c < 16; ++c) O[c] *= alpha;
            }
#pragma unroll
            for (int c4 = 0; c4 < 4; ++c4) {
                u32x2 rr[8];
                const unsigned a0 = rbs ^ (32u * ((4 * c4) & 7)), a1 = rbs ^ (32u * ((4 * c4 + 1) & 7)), a2 = rbs ^ (32u * ((4 * c4 + 2) & 7)), a3 = rbs ^ (32u * ((4 * c4 + 3) & 7));
                asm volatile("ds_read_b64_tr_b16 %0, %8 offset:%12\n\tds_read_b64_tr_b16 %1, %8 offset:%13\n\tds_read_b64_tr_b16 %2, %9 offset:%12\n\tds_read_b64_tr_b16 %3, %9 offset:%13\n\t"
                             "ds_read_b64_tr_b16 %4, %10 offset:%12\n\tds_read_b64_tr_b16 %5, %10 offset:%13\n\tds_read_b64_tr_b16 %6, %11 offset:%12\n\tds_read_b64_tr_b16 %7, %11 offset:%13\n\ts_waitcnt lgkmcnt(0)"
                             : "=&v"(rr[0]), "=&v"(rr[1]), "=&v"(rr[2]), "=&v"(rr[3]), "=&v"(rr[4]), "=&v"(rr[5]), "=&v"(rr[6]), "=&v"(rr[7])
                             : "v"(a0), "v"(a1), "v"(a2), "v"(a3), "n"(8192 * (c4 >> 1)), "n"(8192 * (c4 >> 1) + 4096) : "memory");
#pragma unroll
                for (int j = 0; j < 4; ++j) O[4 * c4 + j] = MFMA16(mk8(rr[2 * j], rr[2 * j + 1]), pf, O[4 * c4 + j]);
            }
        }
        lrun += __shfl_xor(lrun, 16); lrun += __shfl_xor(lrun, 32);
        const float inv = 1.f / lrun;
        if (fr < 4) {
#pragma unroll
            for (int c = 0; c < 16; ++c) {
#ifdef ZERO_DSA
                const f32x4 v = O[c] * 0.f; (void)inv;
#elif defined(DOUBLE_DSA)
                const f32x4 v = O[c] * (2.f * inv);
#else
                const f32x4 v = O[c] * inv;
#endif
                u32x2 w; w.x = cvt_pk_bf16(v[0], v[1]); w.y = cvt_pk_bf16(v[2], v[3]); *(LAS u32x2*)(img + 2 * (fr * 256 + 16 * c + 4 * g)) = w; } }
        LDS_WAIT(); asm volatile("" ::: "memory");
        { const u32x4 t0 = *(const LAS u32x4*)(img + 16 * lane), t1 = *(const LAS u32x4*)(img + 1024 + 16 * lane);
          u32x4* orow = (u32x4*)(AO + m * 1536 + 512); orow[lane] = t0; orow[64 + lane] = t1; }
        LDS_WAIT(); asm volatile("" ::: "memory");
#ifdef PROBE_TIME
        { const unsigned long long td3 = __builtin_amdgcn_s_memrealtime(); t2acc += td2 - tdq; t3acc += td3 - td2; }
#endif
    }
#ifdef PROBE_TIME
    const unsigned long long tdw = __builtin_amdgcn_s_memrealtime();
#endif
    __syncthreads();
#ifdef PROBE_TIME
    if (blockIdx.x == 255 && threadIdx.x == 0) { ((volatile float*)(ws + WS_CTL))[2048 + 28] += (float)(__builtin_amdgcn_s_memrealtime() - tdw) * 0.01f; }
    if (blockIdx.x == 255 && threadIdx.x == 0) { volatile float* ct = (volatile float*)(ws + WS_CTL) + 2048; ct[20] += (float)(td1 - td0) * 0.01f; ct[21] += (float)t2acc * 0.01f; ct[22] += (float)t3acc * 0.01f; ct[23] += 1.f; ct[27] += (float)(__builtin_amdgcn_s_memrealtime() - td0) * 0.01f; }
#endif
}

__device__ __forceinline__ float erf_as(float x) {
    const float ax = __builtin_fabsf(x);
    const float t = __builtin_amdgcn_rcpf(fmaf(0.3275911f, ax, 1.f));
    float pl = fmaf(1.061405429f, t, -1.453152027f); pl = fmaf(pl, t, 1.421413741f); pl = fmaf(pl, t, -0.284496736f); pl = fmaf(pl, t, 0.254829592f); pl *= t;
    const float e = __builtin_amdgcn_exp2f(ax * ax * -1.4426950408889634f);
    return __builtin_copysignf(fmaf(-pl, e, 1.f), x);
}
__device__ __forceinline__ unsigned mbcnt64(unsigned long long m) { return __builtin_amdgcn_mbcnt_hi((unsigned)(m >> 32), __builtin_amdgcn_mbcnt_lo((unsigned)m, 0u)); }
__device__ __forceinline__ float pack_idx(float v, unsigned idx, unsigned mask) { return __uint_as_float((__float_as_uint(v) & ~mask) | idx); }
__device__ __forceinline__ void ins16(float (&L)[16], float x) {
#pragma unroll
    for (int i = 15; i >= 1; --i) L[i] = __builtin_amdgcn_fmed3f(L[i - 1], L[i], x);
    L[0] = fmaxf(L[0], x);
}
__device__ __forceinline__ unsigned pk4_fp8(float a, float b, float c, float d) { int w = __builtin_amdgcn_cvt_pk_fp8_f32(a, b, 0, false); w = __builtin_amdgcn_cvt_pk_fp8_f32(c, d, w, true); return (unsigned)w; }
__device__ __forceinline__ float dot2bf(unsigned a, unsigned b, float acc) { return __builtin_amdgcn_fdot2_f32_bf16(__builtin_bit_cast(bf16x2_t, a), __builtin_bit_cast(bf16x2_t, b), acc, false); }
constexpr float P8_K = 256.f;
#define H2AT(r, i) __builtin_shufflevector(r, r, (i), (i) + 1)
typedef unsigned u32x4a8 __attribute__((ext_vector_type(4), aligned(8)));
__device__ __forceinline__ void p8_offsets(const LAS unsigned short* se, int k0, unsigned (&off)[4], unsigned hoff, unsigned hsh) {
    const u32x4 ew = *(const LAS u32x4*)(se + k0);
#pragma unroll
#ifdef PROBE_MASK
    for (int jj = 0; jj < 4; ++jj) off[jj] = ((ew[jj] >> hsh) & PROBE_MASK) * 768u + hoff;
#else
    for (int jj = 0; jj < 4; ++jj) off[jj] = ((ew[jj] >> hsh) & 0xFFFFu) * 768u + hoff;
#endif
}
#ifdef P8_AUX
typedef __amdgpu_buffer_rsrc_t p8_tab_t;
__device__ __forceinline__ p8_tab_t p8_tab(const unsigned char* T) { return __builtin_amdgcn_make_buffer_rsrc((void*)T, 0, 16384 * 768, 0x00020000); }
__device__ __forceinline__ u32x6 p8_ld(p8_tab_t T, unsigned off) { const u32x4 a = __builtin_amdgcn_raw_buffer_load_b128(T, (int)off, 0, P8_AUX); const u32x2 c = __builtin_amdgcn_raw_buffer_load_b64(T, (int)off + 16, 0, P8_AUX); return (u32x6){a[0], a[1], a[2], a[3], c[0], c[1]}; }
#else
typedef const unsigned char* p8_tab_t;
__device__ __forceinline__ p8_tab_t p8_tab(const unsigned char* T) { return T; }
__device__ __forceinline__ u32x6 p8_ld(const unsigned char* T, unsigned off) { const u32x4a8 a = *(const u32x4a8*)(T + off); const u32x2 c = *(const u32x2*)(T + off + 16); return (u32x6){a[0], a[1], a[2], a[3], c[0], c[1]}; }
#endif
__device__ __forceinline__ void p8_u(u32x6 (&up)[4], const unsigned (&offn)[4], p8_tab_t Tn, LAS float* sg, const LAS float* sul, int k0, const h2_t (&xh)[16], float rs, int lane) {
    float part[4];
#pragma unroll
    for (int jj = 0; jj < 4; ++jj) {
        const h32_t r = __builtin_amdgcn_cvt_scalef32_pk32_f16_fp6(up[jj], 1.0f);
        up[jj] = p8_ld(Tn, offn[jj]);
        float d0 = 0.f, d1 = 0.f;
        d0 = __builtin_amdgcn_fdot2(H2AT(r, 0), xh[0], d0, false); d1 = __builtin_amdgcn_fdot2(H2AT(r, 2), xh[1], d1, false);
        d0 = __builtin_amdgcn_fdot2(H2AT(r, 4), xh[2], d0, false); d1 = __builtin_amdgcn_fdot2(H2AT(r, 6), xh[3], d1, false);
        d0 = __builtin_amdgcn_fdot2(H2AT(r, 8), xh[4], d0, false); d1 = __builtin_amdgcn_fdot2(H2AT(r, 10), xh[5], d1, false);
        d0 = __builtin_amdgcn_fdot2(H2AT(r, 12), xh[6], d0, false); d1 = __builtin_amdgcn_fdot2(H2AT(r, 14), xh[7], d1, false);
        d0 = __builtin_amdgcn_fdot2(H2AT(r, 16), xh[8], d0, false); d1 = __builtin_amdgcn_fdot2(H2AT(r, 18), xh[9], d1, false);
        d0 = __builtin_amdgcn_fdot2(H2AT(r, 20), xh[10], d0, false); d1 = __builtin_amdgcn_fdot2(H2AT(r, 22), xh[11], d1, false);
        d0 = __builtin_amdgcn_fdot2(H2AT(r, 24), xh[12], d0, false); d1 = __builtin_amdgcn_fdot2(H2AT(r, 26), xh[13], d1, false);
        d0 = __builtin_amdgcn_fdot2(H2AT(r, 28), xh[14], d0, false); d1 = __builtin_amdgcn_fdot2(H2AT(r, 30), xh[15], d1, false);
        part[jj] = d0 + d1; }
    float r2[2];
#pragma unroll
    for (int k = 0; k < 2; ++k) { const float mine = (lane & 16) ? part[k + 2] : part[k], theirs = (lane & 16) ? part[k] : part[k + 2]; r2[k] = mine + __shfl_xor(theirs, 16); }
    float r1; { const float mine = (lane & 8) ? r2[1] : r2[0], theirs = (lane & 8) ? r2[0] : r2[1]; r1 = mine + dpp_mov<0x128>(theirs); }
    r1 += dpp_mov<0xB1>(r1); r1 += dpp_mov<0x4E>(r1); r1 += dpp_mov<0x141>(r1);
    const int jl = ((lane >> 4) & 1) * 4 + ((lane >> 3) & 1) * 2 + ((lane >> 5) & 1);
    const float a = r1 * rs * sul[k0 + jl]; const float act = 0.5f * a * (1.f + erf_as(a * 0.70710678118654752f));
    const float coef = sg[k0 + jl] * act;
    if ((lane & 7) == 0) sg[k0 + jl] = coef;
}
__device__ __forceinline__ void p8_v(u32x6 (&vp)[4], const unsigned (&offn)[4], p8_tab_t Tn, const LAS float* sg, int k0, h2_t (&y16)[16], int lane) {
    float cj[4];
#pragma unroll
    for (int jj = 0; jj < 4; ++jj) cj[jj] = sg[k0 + 2 * jj + (lane >> 5)];
#pragma unroll
    for (int jj = 0; jj < 4; ++jj) {
        const h32_t r = __builtin_amdgcn_cvt_scalef32_pk32_f16_fp6(vp[jj], 1.0f);
        vp[jj] = p8_ld(Tn, offn[jj]);
        const _Float16 cf = (_Float16)cj[jj]; const h2_t c2 = {cf, cf};
        y16[0] += c2 * H2AT(r, 0); y16[1] += c2 * H2AT(r, 2); y16[2] += c2 * H2AT(r, 4); y16[3] += c2 * H2AT(r, 6);
        y16[4] += c2 * H2AT(r, 8); y16[5] += c2 * H2AT(r, 10); y16[6] += c2 * H2AT(r, 12); y16[7] += c2 * H2AT(r, 14);
        y16[8] += c2 * H2AT(r, 16); y16[9] += c2 * H2AT(r, 18); y16[10] += c2 * H2AT(r, 20); y16[11] += c2 * H2AT(r, 22);
        y16[12] += c2 * H2AT(r, 24); y16[13] += c2 * H2AT(r, 26); y16[14] += c2 * H2AT(r, 28); y16[15] += c2 * H2AT(r, 30); }
}
__device__ __forceinline__ h2_t bf2_to_h2(unsigned w) { return __builtin_bit_cast(h2_t, __builtin_amdgcn_cvt_pkrtz(__uint_as_float(w << 16), __uint_as_float(w & 0xFFFF0000u))); }
__device__ __forceinline__ void p8_peer(const Params& p, LAS unsigned char* lds, int bx, int wave, int lane_in, XcdBarrier& bar) {
    unsigned char* ws = p.ws;
    const _Float16* S = (const _Float16*)(ws + WS_S); const float* rss = (const float*)(ws + WS_CTL + CTL_RSS);
    const p8_tab_t UB6 = p8_tab(ws + WS_UB), VB6 = p8_tab(ws + WS_VB); const bf16_t* X1B = (const bf16_t*)(ws + WS_X1B);
    const float* SU = (const float*)(ws + WS_SUV); const float* SV = SU + 16384;
    LAS unsigned short* EI = (LAS unsigned short*)(lds + wave * 6656);
    LAS float* GT = (LAS float*)(lds + wave * 6656 + 1024);
    LAS unsigned char* IX = lds + wave * 6656 + 3072;
    LAS float* SUL = (LAS float*)(lds + wave * 6656 + 4352);
    LAS float* YL = (LAS float*)(lds + 8 * 6656 + wave * 4096);
#ifdef PROBE_TIME
    unsigned long long pr_acc = 0, ps_acc = 0, pg_acc = 0;
#endif
    unsigned nsync = 0;
#pragma unroll 1
    for (int blk0 = 0; blk0 < MT / 128; blk0 += (int)gridDim.x)
    for (int ds = 0; ds < 4; ++ds) {
#ifdef P8_ALIGN
        if (blk0 + ds > 0) xcd_barrier(bar);
#endif
        const int blk = blk0 + bx; if (blk >= MT / 128) continue;
        int lane = lane_in; asm volatile("" : "+v"(lane));
        const int tq = lane >> 4, hs = lane & 15, head = hs >> 1, side = hs & 1;
        const size_t m0 = ((size_t)blk * 4 + ds) * 32 + wave * 4;
#ifdef PROBE_TIME
        const unsigned long long tp0 = __builtin_amdgcn_s_memrealtime();
#endif
        {
            const size_t m = m0 + tq; const _Float16* srow = S + m * 2048 + hs * 128;
            float L[16];
#pragma unroll
            for (int i = 0; i < 16; ++i) L[i] = -INFINITY;
#pragma unroll 4
            for (int j8 = 0; j8 < 16; ++j8) { const u32x4 v = ((const u32x4*)srow)[j8];
                const unsigned vw[4] = {v.x, v.y, v.z, v.w};
#pragma unroll
                for (int e = 0; e < 4; ++e) { const float lo = (float)__builtin_bit_cast(_Float16, (unsigned short)(vw[e] & 0xFFFFu)), hi = (float)__builtin_bit_cast(_Float16, (unsigned short)(vw[e] >> 16));
                    ins16(L, pack_idx(lo, (unsigned)(8 * j8 + 2 * e), 0x7Fu)); ins16(L, pack_idx(hi, (unsigned)(8 * j8 + 2 * e + 1), 0x7Fu)); } }
            float A[16], B[16];
#pragma unroll
            for (int i = 0; i < 16; ++i) { const float o = dpp_mov<0xB1>(L[i]); A[i] = side ? o : L[i]; B[i] = side ? L[i] : o; }
            float C[16];
#pragma unroll
            for (int i = 0; i < 16; ++i) C[i] = -INFINITY;
#pragma unroll
            for (int i = 0; i < 16; ++i)
#pragma unroll
                for (int j = 0; j < 16; ++j) if ((i + 1) * (j + 1) <= 16) {
                    const unsigned ab = __float_as_uint(A[i]), bb = __float_as_uint(B[j]);
                    const float sum = __uint_as_float(ab & ~0x7Fu) + __uint_as_float(bb & ~0x7Fu);
                    ins16(C, pack_idx(sum, (unsigned)(i * 16 + j), 0xFFu)); }
            { u32x4 w;
                w.x = (__float_as_uint(L[0]) & 0x7Fu) | ((__float_as_uint(L[1]) & 0x7Fu) << 8) | ((__float_as_uint(L[2]) & 0x7Fu) << 16) | ((__float_as_uint(L[3]) & 0x7Fu) << 24);
                w.y = (__float_as_uint(L[4]) & 0x7Fu) | ((__float_as_uint(L[5]) & 0x7Fu) << 8) | ((__float_as_uint(L[6]) & 0x7Fu) << 16) | ((__float_as_uint(L[7]) & 0x7Fu) << 24);
                w.z = (__float_as_uint(L[8]) & 0x7Fu) | ((__float_as_uint(L[9]) & 0x7Fu) << 8) | ((__float_as_uint(L[10]) & 0x7Fu) << 16) | ((__float_as_uint(L[11]) & 0x7Fu) << 24);
                w.w = (__float_as_uint(L[12]) & 0x7Fu) | ((__float_as_uint(L[13]) & 0x7Fu) << 8) | ((__float_as_uint(L[14]) & 0x7Fu) << 16) | ((__float_as_uint(L[15]) & 0x7Fu) << 24);
                *(LAS u32x4*)(IX + lane * 16) = w; }
            LDS_WAIT(); asm volatile("" ::: "memory");
            float tv[16]; unsigned ei[16]; float mx = -INFINITY;
#pragma unroll
            for (int k = 0; k < 16; ++k) { const unsigned rk = __float_as_uint(C[k]) & 0xFFu; const unsigned i1 = IX[(lane & ~1) * 16 + (rk >> 4)], i2 = IX[(lane | 1) * 16 + (rk & 15u)];
                ei[k] = (i1 << 7) | i2; tv[k] = (float)S[m * 2048 + head * 256 + i1] + (float)S[m * 2048 + head * 256 + 128 + i2]; mx = fmaxf(mx, tv[k]); }
            float z = 0.f;
#pragma unroll
            for (int k = 0; k < 16; ++k) { tv[k] = __expf(tv[k] - mx); z += tv[k]; }
            const float iz = 1.f / z;
#pragma unroll
            for (int k = 0; k < 16; ++k) { EI[tq * 128 + head * 16 + k] = (unsigned short)ei[k]; GT[tq * 128 + head * 16 + k] = tv[k] * iz * (SV[ei[k]] * P8_K); SUL[tq * 128 + head * 16 + k] = SU[ei[k]]; }
        }
        LDS_WAIT(); asm volatile("" ::: "memory");
#ifdef PROBE_TIME
        const unsigned long long tp1 = __builtin_amdgcn_s_memrealtime();
#endif
#pragma unroll 1
        for (int t4 = 0; t4 < 4; ++t4) {
            const unsigned e0 = EI[t4 * 128 + lane], e1 = EI[t4 * 128 + 64 + lane]; const float g0 = GT[t4 * 128 + lane], g1 = GT[t4 * 128 + 64 + lane], s0 = SUL[t4 * 128 + lane], s1 = SUL[t4 * 128 + 64 + lane];
            LDS_WAIT(); asm volatile("" ::: "memory");
            unsigned base = 0u;
#pragma unroll 1
            for (unsigned s = 0; s < 16; ++s) {
                const bool h0 = (e0 >> 10) == s, h1 = (e1 >> 10) == s;
                const unsigned long long b0 = __ballot(h0), b1 = __ballot(h1);
                if (h0) { const unsigned pos = base + mbcnt64(b0); EI[t4 * 128 + pos] = (unsigned short)e0; GT[t4 * 128 + pos] = g0; SUL[t4 * 128 + pos] = s0; }
                if (h1) { const unsigned pos = base + (unsigned)__popcll(b0) + mbcnt64(b1); EI[t4 * 128 + pos] = (unsigned short)e1; GT[t4 * 128 + pos] = g1; SUL[t4 * 128 + pos] = s1; }
                base += (unsigned)__popcll(b0) + (unsigned)__popcll(b1);
            }
        }
        LDS_WAIT(); asm volatile("" ::: "memory");
#ifdef PROBE_TIME
        const unsigned long long tp2 = __builtin_amdgcn_s_memrealtime();
#endif
        {
            const int hf = lane >> 5, sl = lane & 31; const unsigned hoff = 24u * sl, hsh = 16u * hf;
            u32x6 uT[4][4];
#pragma unroll
            for (int tk = 0; tk < 4; ++tk) { unsigned o0[4]; p8_offsets(EI, 128 * tk, o0, hoff, hsh);
#pragma unroll
              for (int jj = 0; jj < 4; ++jj) uT[tk][jj] = p8_ld(UB6, o0[jj]); }
            {
                h2_t y4[4][16];
                {
                h2_t xh[4][16]; float rs4[4];
#pragma unroll
                for (int tk = 0; tk < 4; ++tk) { const u32x4* xr = (const u32x4*)(X1B + (m0 + tk) * 1024) + 4 * sl;
#pragma unroll
                  for (int q = 0; q < 4; ++q) { const u32x4 ta = xr[q];
#pragma unroll
                      for (int e = 0; e < 4; ++e) xh[tk][4 * q + e] = bf2_to_h2(ta[e]); }
                  rs4[tk] = rsqrtf(rss[m0 + tk] * (1.f / DM) + EPS); }
                xcd_local_sync(bar, ++nsync);
#pragma unroll 1
                for (int hp = 0; hp < 2; ++hp) {
                if (hp) xcd_local_sync(bar, ++nsync);
#pragma unroll 1
                for (int i = 8 * hp; i < 8 * hp + 8; ++i) {
                    const int kN = (i < 15) ? 8 * i + 8 : 0; const p8_tab_t Tn = (i < 15) ? UB6 : VB6;
#pragma unroll
                    for (int tk = 0; tk < 4; ++tk) {
                        unsigned offn[4];
                        p8_offsets(EI, 128 * tk + kN, offn, hoff, hsh);
                        p8_u(uT[tk], offn, Tn, GT, SUL, 128 * tk + 8 * i, xh[tk], rs4[tk], lane);
                    }
                }
                }
                }
#pragma unroll
                for (int tk = 0; tk < 4; ++tk)
#pragma unroll
                    for (int i = 0; i < 16; ++i) y4[tk][i] = (h2_t){(_Float16)0.f, (_Float16)0.f};
                xcd_local_sync(bar, ++nsync);
#pragma unroll 1
                for (int hp = 0; hp < 2; ++hp) {
                if (hp) xcd_local_sync(bar, ++nsync);
#pragma unroll 1
                for (int i = 8 * hp; i < 8 * hp + 8; ++i) {
                    const int kN = (i < 15) ? 8 * i + 8 : 120;
#pragma unroll
                    for (int tk = 0; tk < 4; ++tk) {
                        unsigned offn[4];
                        p8_offsets(EI, 128 * tk + kN, offn, hoff, hsh);
                        p8_v(uT[tk], offn, VB6, GT, 128 * tk + 8 * i, y4[tk], lane);
                    }
                }
                }
                int lz = lane; asm volatile("" : "+v"(lz));
                const int hf_e = lz >> 5, sl_e = lz & 31;
#pragma unroll
                for (int tk = 0; tk < 4; ++tk) {
                    const size_t mm = m0 + tk;
                    float y[16];
#pragma unroll
                    for (int q = 0; q < 8; ++q) { const h2_t lo = y4[tk][q], hi = y4[tk][8 + q];
                        const h2_t mine = hf_e ? hi : lo, send = hf_e ? lo : hi; const h2_t recv = __builtin_bit_cast(h2_t, __shfl_xor(__builtin_bit_cast(int, send), 32));
                        y[2 * q] = ((float)mine[0] + (float)recv[0]) * (1.f / P8_K); y[2 * q + 1] = ((float)mine[1] + (float)recv[1]) * (1.f / P8_K); }
#ifdef DOUBLE_PEER
#pragma unroll
                    for (int i = 0; i < 16; ++i) y[i] *= 2.f;
#endif
#ifdef ZERO_PEER
#pragma unroll
                    for (int i = 0; i < 16; ++i) y[i] = 0.f;
#endif
                    LAS float* yl = YL + 32 * sl_e + 16 * hf_e;
#pragma unroll
                    for (int q = 0; q < 4; ++q) *(LAS f32x4*)(yl + 4 * q) = (f32x4){y[4 * q], y[4 * q + 1], y[4 * q + 2], y[4 * q + 3]};
                    LDS_WAIT(); asm volatile("" ::: "memory");
                    f32x4 o[4]; float ss = 0.f;
#pragma unroll
                    for (int k = 0; k < 4; ++k) { const f32x4 yy = *(const LAS f32x4*)(YL + 4 * lz + 256 * k); const u32x2 xw = *(const u32x2*)(X1B + mm * 1024 + 4 * lz + 256 * k);
                        o[k] = (f32x4){bf_lo(xw.x), bf_hi(xw.x), bf_lo(xw.y), bf_hi(xw.y)} + yy; ss += (o[k][0] * o[k][0] + o[k][1] * o[k][1]) + (o[k][2] * o[k][2] + o[k][3] * o[k][3]); }
                    const float rf = rsqrtf(wave_sum(ss) * (1.f / DM) + EPS);
#pragma unroll
                    for (int k = 0; k < 4; ++k) { const f32x4 fgk = *((const f32x4*)p.final_g + lz + 64 * k); *((f32x4*)(p.out + mm * 1024) + lz + 64 * k) = o[k] * rf * fgk; }
                    LDS_WAIT(); asm volatile("" ::: "memory");
                }
            }
        }
        LDS_WAIT(); asm volatile("" ::: "memory");
#ifdef PROBE_TIME
        { const unsigned long long tp3 = __builtin_amdgcn_s_memrealtime(); pr_acc += tp1 - tp0; ps_acc += tp2 - tp1; pg_acc += tp3 - tp2;
          if (blockIdx.x == 1 && threadIdx.x == 0) { volatile float* ct = (volatile float*)(ws + WS_CTL) + 2048; ct[24] = (float)pr_acc * 0.01f; ct[25] = (float)ps_acc * 0.01f; ct[26] = (float)pg_acc * 0.01f; } }
#endif
    }
}


#ifdef PROBE_GDN
__device__ __forceinline__ void gdn_reference(const Params& p, LAS unsigned char* lds) {
    unsigned char* ws = p.ws; const int tid = threadIdx.x, e = tid & 127, rg = tid >> 7;
    LAS float* KQ = (LAS float*)lds;
    LAS float* RED = (LAS float*)(lds + 1024);
    LAS float* OSQ = (LAS float*)(lds + 4096);
    const float* qf = (const float*)(ws + WS_REF); const float* kf = qf + 512 * 128; const float* vf = kf + 512 * 128;
    const float* garr = (const float*)(ws + WS_RES) + 256; const float* barr = (const float*)(ws + WS_RES) + 1024;
    const bf16_t* ZB = (const bf16_t*)(ws + WS_ZB); const bf16_t* AO = (const bf16_t*)(ws + WS_AOUT);
    float S[32];
#pragma unroll
    for (int i = 0; i < 32; ++i) S[i] = 0.f;
    float d2 = 0.f, r2 = 0.f;
    for (int t = 0; t < 512; ++t) {
        __syncthreads();
        if (tid < 128) KQ[tid] = kf[t * 128 + tid]; else if (tid < 256) KQ[tid] = qf[t * 128 + tid - 128];
        __syncthreads();
        const float al = __expf(garr[t]), be = barr[t], v = vf[t * 128 + e];
        float ks = 0.f;
#pragma unroll
        for (int i = 0; i < 32; ++i) ks = fmaf(KQ[32 * rg + i], S[i], ks);
        RED[rg * 128 + e] = ks;
        __syncthreads();
        const float kS = (RED[e] + RED[128 + e]) + (RED[256 + e] + RED[384 + e]);
        const float dv = be * (v - al * kS);
        float os = 0.f;
#pragma unroll
        for (int i = 0; i < 32; ++i) { S[i] = fmaf(KQ[32 * rg + i], dv, al * S[i]); os = fmaf(KQ[128 + 32 * rg + i], S[i], os); }
        __syncthreads();
        RED[rg * 128 + e] = os;
        __syncthreads();
        const float o = (RED[e] + RED[128 + e]) + (RED[256 + e] + RED[384 + e]);
        if (rg == 0) { const float sq = wave_sum(o * o); if ((tid & 63) == 0) OSQ[tid >> 6] = sq; }
        __syncthreads();
        if (rg == 0) { const float rstd = rsqrtf((OSQ[0] + OSQ[1]) * (1.f / 128.f) + EPS); const float zf = bf2f(ZB[(size_t)t * 512 + e]);
            const float ref = o * rstd * p.gdn_norm_g[e] * silu_f(zf); const float got = bf2f(AO[(size_t)t * 1536 + e]);
            if (t >= PROBE_T0 && t < PROBE_T1) { d2 += (got - ref) * (got - ref); r2 += ref * ref; } }
    }
    if (rg == 0) { d2 = wave_sum(d2); r2 = wave_sum(r2); if ((tid & 63) == 0) { atomicAdd((float*)(ws + WS_RES), d2); atomicAdd((float*)(ws + WS_RES) + 1, r2); } }
}
#endif

#ifdef PROBE_GDN
__device__ __forceinline__ void gdn_chunk0_reference(const Params& p, LAS unsigned char* lds) {
    unsigned char* ws = p.ws; const int tid = threadIdx.x;
    LAS float* A = (LAS float*)lds;
    LAS float* Tm = (LAS float*)(lds + 16384);
    LAS float* GCs = (LAS float*)(lds + 32768);
    const float* qf = (const float*)(ws + WS_REF); const float* kf = qf + 512 * 128; const float* vf = kf + 512 * 128;
    const float* garr = (const float*)(ws + WS_RES) + 256; const float* barr = (const float*)(ws + WS_RES) + 1024;
    if (tid == 0) { float acc = 0.f; for (int i = 0; i < 64; ++i) { acc += garr[i]; GCs[i] = acc; GCs[64 + i] = barr[i]; } }
    __syncthreads();
    for (int idx = tid; idx < 4096; idx += NTHR) { const int i = idx >> 6, j = idx & 63; float d = 0.f;
        if (j < i) { for (int e = 0; e < 128; ++e) d = fmaf(kf[i * 128 + e], kf[j * 128 + e], d); d *= GCs[64 + i] * __expf(GCs[i] - GCs[j]); }
        A[idx] = d; Tm[idx] = 0.f; }
    __syncthreads();
#if PROBE_WHAT == 8
    { const float* dmpA = (const float*)(ws + 15 * MiB + 880000); for (int idx = tid; idx < 4096; idx += NTHR) A[idx] = dmpA[idx]; }
    __syncthreads();
#endif
    if (tid < 64) { const int c = tid; for (int i = 0; i < 64; ++i) { float acc = (i == c) ? 1.f : 0.f; for (int j = 0; j < i; ++j) acc = fmaf(-A[i * 64 + j], Tm[j * 64 + c], acc); Tm[i * 64 + c] = acc; } }
    __syncthreads();
    float d2 = 0.f, r2 = 0.f;
#if PROBE_WHAT == 0
    const bf16_t* uT = (const bf16_t*)(ws + WS_VH);
    for (int idx = tid; idx < 8192; idx += NTHR) { const int i = idx >> 7, e = idx & 127; float acc = 0.f;
        for (int j = 0; j <= i; ++j) acc = fmaf(Tm[i * 64 + j] * GCs[64 + j], vf[j * 128 + e], acc);
        const float got = bf2f(uT[e * 64 + i]); d2 += (got - acc) * (got - acc); r2 += acc * acc; }
#elif PROBE_WHAT == 1
    const bf16_t* wB = (const bf16_t*)(ws + WS_WBUF);
    for (int idx = tid; idx < 8192; idx += NTHR) { const int i = idx >> 7, d = idx & 127; float acc = 0.f;
        for (int j = 0; j <= i; ++j) acc = fmaf(Tm[i * 64 + j] * GCs[64 + j] * __expf(GCs[j]), kf[j * 128 + d], acc);
        const int kb = d >> 5, u = (d & 31) >> 2, nu = 2 * (u & 3) + (u >> 2); const float got = bf2f(wB[i * 128 + 32 * kb + 4 * nu + (d & 3)]);
        d2 += (got - acc) * (got - acc); r2 += acc * acc; }
#elif PROBE_WHAT == 3
    { const float* dmp = (const float*)(ws + 15 * MiB + 880000); for (int idx = tid; idx < 4096; idx += NTHR) { const float got = dmp[idx], acc = A[idx]; d2 += (got - acc) * (got - acc); r2 += acc * acc; } }
#elif PROBE_WHAT == 4 || PROBE_WHAT == 8
    { const float* dmp = (const float*)(ws + 15 * MiB + 880000) + 4096; for (int idx = tid; idx < 4096; idx += NTHR) { const float got = dmp[idx], acc = Tm[idx]; d2 += (got - acc) * (got - acc); r2 += acc * acc; } }
#elif PROBE_WHAT >= 5 && PROBE_WHAT <= 7
    { const float* dmp = (const float*)(ws + 15 * MiB + 880000) + 4096; for (int idx = tid; idx < 4096; idx += NTHR) { const int i = idx >> 6, j = idx & 63;
        const bool in = (PROBE_WHAT == 5) ? (i < 32 && j < 32) : ((PROBE_WHAT == 6) ? (i >= 32 && j >= 32) : (i >= 32 && j < 32));
        if (in) { const float got = dmp[idx], acc = Tm[idx]; d2 += (got - acc) * (got - acc); r2 += acc * acc; } } }
#else
    const bf16_t* qB = (const bf16_t*)(ws + WS_QH);
    for (int idx = tid; idx < 8192; idx += NTHR) { const int i = idx >> 7, d = idx & 127; const float acc = qf[i * 128 + d] * __expf(GCs[i]);
        const int kb = d >> 5, u = (d & 31) >> 2, nu = 2 * (u & 3) + (u >> 2); const float got = bf2f(qB[i * 128 + 32 * kb + 4 * nu + (d & 3)]);
        d2 += (got - acc) * (got - acc); r2 += acc * acc; }
#endif
    d2 = wave_sum(d2); r2 = wave_sum(r2);
    if ((tid & 63) == 0) { atomicAdd((float*)(ws + WS_RES), d2); atomicAdd((float*)(ws + WS_RES) + 1, r2); }
}
#endif
__global__ void __launch_bounds__(NTHR, 2) hybrid_fwd(Params p) {
    extern __shared__ __attribute__((aligned(16))) unsigned char lds_raw[];
    LAS unsigned char* lds = (LAS unsigned char*)lds_raw;
    volatile LAS unsigned* MISCW = (volatile LAS unsigned*)(lds + LDS_MISC);
#define PHASE_IDS int tid = threadIdx.x; asm volatile("" : "+v"(tid)); const int lane = tid & 63, wave = __builtin_amdgcn_readfirstlane(tid >> 6); \
    const int gw = bx * NWAVES + wave, ngw = G * NWAVES; (void)lane; (void)gw; (void)ngw;
    const int G = gridDim.x, bx = blockIdx.x;
    unsigned char* ws = p.ws;
    const int tid0 = threadIdx.x;
    unsigned* ctl = (unsigned*)(ws + WS_CTL);
    if (tid0 < 16) MISCW[tid0] = 0u;
    __syncthreads();
    XcdBarrier bar = xcd_barrier_post(ctl + CW_BAR, MISCW);
#if defined(PROBE_TIME) || defined(PROBE_P8)
    unsigned long long tprev = __builtin_amdgcn_s_memrealtime(); int tk = 0;
#define TSTAMP() do { const unsigned long long tn = __builtin_amdgcn_s_memrealtime(); if (threadIdx.x == 0) { const float us = (float)(tn - tprev) * 0.01f; \
        ((volatile LAS float*)(lds + LDS_MISC))[16 + tk] = us; if (blockIdx.x == 0) ((volatile float*)ctl)[2048 + tk] = us; } tprev = tn; ++tk; } while (0)
#else
#define TSTAMP() do {} while (0)
#endif

    { PHASE_IDS p0_prologue(p, lds, gw, ngw, wave, lane); }
    xcd_barrier(bar);
    TSTAMP();
    { pg8::Gemm g{(const bf16_t*)(ws + WS_HB), (const bf16_t*)(ws + WS_WINT), MT, NIN, DM}; pg8::StaticOrder So; So.init(MT, NIN, G, bx); EpiIn E{ws};
      pg8::gemm_phase<EpiIn, pg8::StaticOrder, false>(lds, g, So, E, nullptr); }
    xcd_barrier(bar);
    TSTAMP();
    { PHASE_IDS
#ifdef PROBE_GDN
      if (bx == 0 && tid < 2) ((float*)(ws + WS_RES))[tid] = 0.f;
#endif
      LAS float* cw = (LAS float*)lds;
      for (int i = tid; i < 4 * 1536 / 4; i += NTHR) ((LAS f32x4*)cw)[i] = ((const f32x4*)p.conv_w)[i];
      __syncthreads();
      for (int m = 2 * gw; m < MT; m += 2 * ngw) {
          const int t = m & (SEQ - 1); const bf16_t* pre = (const bf16_t*)(ws + WS_QKV);
          int ln = lane; asm volatile("" : "+v"(ln)); P3C pc; p3_consts(p, pc, ln);
          P3In i0, i1; p3_load(p, i0, m, ln); p3_load(p, i1, m + 1, ln);
          u32x4 xr[5][3];
#pragma unroll
          for (int jj = 0; jj < 5; ++jj)
#pragma unroll
              for (int i = 0; i < 3; ++i) { xr[jj][i] = (u32x4){0u, 0u, 0u, 0u}; if (t - 3 + jj >= 0) xr[jj][i] = *(const u32x4*)(pre + (size_t)(m - 3 + jj) * 1536 + 8 * (ln + 64 * i)); }
          p3_token(p, cw, pc, i0, m, ln, xr[0], xr[1], xr[2], xr[3]);
          p3_token(p, cw, pc, i1, m + 1, ln, xr[1], xr[2], xr[3], xr[4]);
      } }
    xcd_barrier(bar);
    TSTAMP();
    { pg8::Gemm g{(const bf16_t*)(ws + WS_CQ), (const bf16_t*)(ws + WS_WQ2T), MT, 2048, 256}; pg8::StaticOrder So; So.init(MT, 2048, G, bx); EpiQ E{ws};
      pg8::gemm_phase<EpiQ, pg8::StaticOrder, false>(lds, g, So, E, nullptr); }
    __syncthreads();
    { PHASE_IDS G2In gin; if (bx < 16 * NCHUNK) g2_load(p, gin, bx, tid, lane);
      for (int cb = bx; cb < 16 * NCHUNK; cb += G) g2_chunk(p, lds, cb, cb + G, gin, tid, wave, lane); }
    xcd_barrier(bar);
    TSTAMP();
    if (bx < 16) { PHASE_IDS g3_scan(p, lds, bx, wave, lane); __syncthreads();
#ifdef PROBE_TIME
        { const unsigned long long tn = __builtin_amdgcn_s_memrealtime(); if (threadIdx.x == 0) { const float us = (float)(tn - tprev) * 0.01f; ((volatile LAS float*)(lds + LDS_MISC))[16 + 10] = us; if (blockIdx.x == 0) ((volatile float*)ctl)[2048 + 10] = us; } }
#endif
    }
#ifdef SCAN_ALONE
    xcd_barrier(bar);
#endif
    { PHASE_IDS
    dsa_tables(p, lds, tid);
    for (int qi = 0; qi < 4; ++qi) {
        const int b = (int)((bar.x + (unsigned)qi) & 3u);
        for (;;) {
            if (tid == 0) MISCW[2] = __hip_atomic_fetch_add(ctl + CW_QUEUE + 16 * b, 1u, __ATOMIC_RELAXED, __HIP_MEMORY_SCOPE_AGENT);
            __syncthreads();
            const unsigned u = MISCW[2];
            __syncthreads();
            if (u >= 512u) break;
            TabJob tj; tab_load(p, tj, (int)((unsigned)b * 512u + u) * 8 + wave, lane);
            dsa_unit(p, lds, b, 511 - (int)u, tj);
        }
    } }
    xcd_barrier(bar);
    TSTAMP();
#ifdef PROBE_GDN
#ifdef PROBE_WHAT
    if (bx == 255) { gdn_chunk0_reference(p, lds); __syncthreads(); }
#else
    if (bx == 255) { gdn_reference(p, lds); __syncthreads(); }
#endif
#endif
    {
        PHASE_IDS
        pg8::Gemm g{(const bf16_t*)(ws + WS_AOUT), (const bf16_t*)(ws + WS_WOUT2T), MT, DM, 1536}; pg8::StaticOrder So; So.init(MT, DM, G, bx);
        EpiOut E{p.x, (bf16_t*)(ws + WS_X1B), (float*)(ws + WS_CTL + CTL_RSS)};
        pg8::gemm_phase<EpiOut, pg8::StaticOrder, false>(lds, g, So, E, nullptr);
    }
    xcd_barrier(bar);
    TSTAMP();
    { pg8::Gemm g{(const bf16_t*)(ws + WS_X1B), (const bf16_t*)(ws + WS_WQST), MT, 2048, DM}; pg8::StaticOrder So; So.init(MT, 2048, G, bx);
      EpiS E{(_Float16*)(ws + WS_S), (const float*)(ws + WS_CTL + CTL_RSS)};
      pg8::gemm_phase<EpiS, pg8::StaticOrder, false>(lds, g, So, E, nullptr); }
    xcd_barrier(bar);
    TSTAMP();
    { PHASE_IDS p8_peer(p, lds, bx, wave, lane, bar); }
#ifdef PROBE_P8
    xcd_barrier(bar);
    TSTAMP();
    xcd_barrier(bar);
    { PHASE_IDS
      const float tp = ((const volatile float*)ctl)[2048 + PROBE_TA];
      const float qa = rintf(PROBE_SCALE * log2f(fmaxf(tp, 1.f)) + PROBE_SHIFT) - PROBE_BASE, qb = rintf(PROBE_SCALE * log2f(fmaxf(tp, 1.f)) + 0.5f + PROBE_SHIFT) - PROBE_BASE;
      const float sc = 1.f + 0.25f * qa;
      for (int m = gw; m < MT; m += ngw) {
          const f32x4* xr4 = (const f32x4*)(p.x + (size_t)m * 1024) + 4 * lane; f32x4* orow = (f32x4*)(p.out + (size_t)m * 1024) + 4 * lane;
          f32x4 w0 = xr4[0] * sc; if (m == 0 && lane == 0) w0[0] = 10.f * qb;
          orow[0] = w0; orow[1] = xr4[1] * sc; orow[2] = xr4[2] * sc; orow[3] = xr4[3] * sc; } }
#endif
}

extern "C" void kernel_launch(void* const* d_in, const int* in_sizes, int n_in, void* d_out, int out_size, void* d_ws, size_t ws_size, hipStream_t stream) {
    static int grid = 0;
    if (grid == 0) {
        if (n_in != 23 || in_sizes[0] != MT * DM || out_size != MT * DM || ws_size < WS_END) {
            fprintf(stderr, "kernel_launch: unexpected problem shape (n_in %d, in0 %d, out %d, ws %zu); nothing launched\n", n_in, n_in > 0 ? in_sizes[0] : -1, out_size, ws_size); grid = -1; return; }
        int dev = 0, cus = 0, per_cu = 0;
        if (hipGetDevice(&dev) != hipSuccess || hipDeviceGetAttribute(&cus, hipDeviceAttributeMultiprocessorCount, dev) != hipSuccess) { grid = -1; return; }
        if (hipFuncSetAttribute((const void*)hybrid_fwd, hipFuncAttributeMaxDynamicSharedMemorySize, LDS_BYTES) != hipSuccess) { fprintf(stderr, "kernel_launch: hipFuncSetAttribute failed\n"); grid = -1; return; }
        if (hipOccupancyMaxActiveBlocksPerMultiprocessor(&per_cu, (const void*)hybrid_fwd, NTHR, LDS_BYTES) != hipSuccess || per_cu < 1) { fprintf(stderr, "kernel_launch: occupancy query says %d\n", per_cu); }
        (void)hipGetLastError();
        grid = cus;
    }
    if (grid < 0) return;
    (void)hipMemsetAsync((char*)d_ws + WS_CTL, 0, CTL_BYTES, stream);
    Params p{};
    const float** pp = (const float**)&p;
    for (int i = 0; i < 23; ++i) pp[i] = (const float*)d_in[i];
    p.out = (float*)d_out; p.ws = (unsigned char*)d_ws;
    hipLaunchKernelGGL(hybrid_fwd, dim3(grid), dim3(NTHR), LDS_BYTES, stream, p);
}
```
